# Optimizing an MI355X kernel written in HIP

```python
import jax, jax.numpy as jnp
from jax import lax
import numpy as np

D_MODEL = 1024
BATCH = 8
SEQ = 4096
DEPTH = 1

N_SUBLAYERS = 3
N_MOD = 3
D_FF = 2816
FFN_RES = 0.5
MLA_HEADS = 8
MLA_Q_LORA = 256
MLA_KV_LORA = 128
MLA_NOPE = 64
MLA_ROPE = 32
MLA_V = 64
MLA_THETA = 10000.0
Q_BLOCK = 128
DIL_PATTERNS = ((128, 1), (512, 4), (2048, 16))
N_DIL_GROUPS = 3
DIL_HEADS_PER_GROUP = 4
DIL_HEAD_DIM = 64
ROPE_THETA = 500000.0
ROPE_PART = DIL_HEAD_DIM // 4
DIL_QKV = 3 * N_DIL_GROUPS * DIL_HEADS_PER_GROUP * DIL_HEAD_DIM
IN_SPLITS = (MLA_Q_LORA, MLA_KV_LORA, MLA_ROPE, DIL_QKV, D_MODEL, D_MODEL)
D_IN = MLA_Q_LORA + MLA_KV_LORA + MLA_ROPE + DIL_QKV + 2 * D_MODEL
NORM_EPS = 1e-6
NEG_INF = -1e30

kernel_name = 'hybrid_mla_dilated_macaron_block'


def rms_norm(x, g):
    xf = x.astype(jnp.float32)
    y = xf * lax.rsqrt(jnp.mean(xf * xf, axis=-1, keepdims=True) + NORM_EPS)
    return (y * g.astype(jnp.float32)).astype(x.dtype)


def modulate(x, shift, scale):
    return x * (1 + scale[:, None, :]) + shift[:, None, :]


def rope_cos_sin(positions, dim, theta):
    inv = theta ** (-jnp.arange(0, dim, 2, dtype=jnp.float32) / dim)
    ang = positions.astype(jnp.float32)[..., None] * inv
    return jnp.cos(ang), jnp.sin(ang)


def apply_rope(t, cos, sin):
    half = t.shape[-1] // 2
    t1 = t[..., :half].astype(jnp.float32)
    t2 = t[..., half:].astype(jnp.float32)
    return jnp.concatenate([t1 * cos - t2 * sin, t2 * cos + t1 * sin], axis=-1).astype(t.dtype)


def partial_rope(t, cos, sin):
    return jnp.concatenate([apply_rope(t[..., :ROPE_PART], cos, sin), t[..., ROPE_PART:]], axis=-1)


def swiglu(h, w_gate, w_up, w_down):
    return (jax.nn.silu(h @ w_gate) * (h @ w_up)) @ w_down


def mla_attention(q_nope, q_rope, k_nope, k_rope, v):
    B, S, H, _ = q_nope.shape
    nblk = S // Q_BLOCK
    scale = (MLA_NOPE + MLA_ROPE) ** -0.5

    def to_blocks(t):
        return jnp.moveaxis(t.reshape((B, nblk, Q_BLOCK) + t.shape[2:]), 1, 0)

    def block(qs):
        qn, qr = qs
        s = jnp.einsum('bqhe,bkhe->bhqk', qn, k_nope) + jnp.einsum('bqhr,bkr->bhqk', qr, k_rope)
        p = jax.nn.softmax(s.astype(jnp.float32) * scale, axis=-1).astype(v.dtype)
        return jnp.einsum('bhqk,bkhe->bqhe', p, v)

    o = lax.map(block, (to_blocks(q_nope), to_blocks(q_rope)))
    return jnp.moveaxis(o, 0, 1).reshape(B, S, H * MLA_V)


def dilated_window_attention(q, k, v, dilation, n_side):
    B, S, H, E = q.shape
    L = S // dilation
    W = n_side
    nb = -(-L // W)
    Lp = nb * W

    def stride_split(t):
        t = t.reshape(B, L, dilation, H, E).transpose(0, 2, 1, 3, 4)
        return jnp.pad(t, ((0, 0), (0, 0), (0, Lp - L), (0, 0), (0, 0)))

    def band(t):
        tp = jnp.pad(t, ((0, 0), (0, 0), (W, W), (0, 0), (0, 0))).reshape(B, dilation, nb + 2, W, H, E)
        return jnp.concatenate([tp[:, :, :-2], tp[:, :, 1:-1], tp[:, :, 2:]], axis=3)

    qb = stride_split(q).reshape(B, dilation, nb, W, H, E)
    kb = band(stride_split(k))
    vb = band(stride_split(v))
    s = jnp.einsum('bdnqhe,bdnkhe->bdnhqk', qb, kb).astype(jnp.float32) * (E ** -0.5)
    qi = jnp.arange(W)[:, None]
    kj = jnp.arange(3 * W)[None, :]
    rel = kj - W - qi
    t_k = (jnp.arange(nb)[:, None, None] - 1) * W + kj[None]
    valid = (jnp.abs(rel)[None] <= n_side) & (t_k >= 0) & (t_k < L)
    s = jnp.where(valid[:, None], s, NEG_INF)
    lse = jax.nn.logsumexp(s, axis=-1)
    p = jnp.exp(s - lse[..., None]).astype(v.dtype)
    o = jnp.einsum('bdnhqk,bdnkhe->bdnqhe', p, vb)
    o = o.reshape(B, dilation, Lp, H, E)[:, :, :L].transpose(0, 2, 1, 3, 4).reshape(B, S, H, E)
    lse = jnp.moveaxis(lse, 3, -1).reshape(B, dilation, Lp, H)[:, :, :L].transpose(0, 2, 1, 3).reshape(B, S, H)
    return o, lse


def token_mixer(u, cos_m, sin_m, cos_p, sin_p, w_in, g_cq, w_uq, g_ckv, w_ukv, w_o_mla, w_o_dil, w_out):
    B, S, _ = u.shape
    proj = u @ w_in
    offs = np.cumsum(IN_SPLITS)[:-1].tolist()
    c_q, c_kv, k_rope, qkv, gate_a, gate_b = jnp.split(proj, offs, axis=-1)

    q = (rms_norm(c_q, g_cq) @ w_uq).reshape(B, S, MLA_HEADS, MLA_NOPE + MLA_ROPE)
    q_nope = q[..., :MLA_NOPE]
    q_rope = apply_rope(q[..., MLA_NOPE:], cos_m[:, :, None], sin_m[:, :, None])
    kv = (rms_norm(c_kv, g_ckv) @ w_ukv).reshape(B, S, MLA_HEADS, MLA_NOPE + MLA_V)
    k_nope, v_mla = kv[..., :MLA_NOPE], kv[..., MLA_NOPE:]
    k_rope = apply_rope(k_rope, cos_m, sin_m)
    o_mla = mla_attention(q_nope, q_rope, k_nope, k_rope, v_mla)

    qkv = qkv.reshape(B, S, 3, N_DIL_GROUPS, DIL_HEADS_PER_GROUP, DIL_HEAD_DIM)
    cp, sp = cos_p[:, :, None], sin_p[:, :, None]
    outs, lses = [], []
    for g, (window, dil) in enumerate(DIL_PATTERNS):
        qg = partial_rope(qkv[:, :, 0, g], cp, sp)
        kg = partial_rope(qkv[:, :, 1, g], cp, sp)
        o, l = dilated_window_attention(qg, kg, qkv[:, :, 2, g], dil, window // (2 * dil))
        outs.append(o)
        lses.append(l)
    wts = jax.nn.softmax(jnp.stack(lses), axis=0).astype(u.dtype)
    o_dil = jnp.einsum('gbsh,gbshe->bshe', wts, jnp.stack(outs)).reshape(B, S, DIL_HEADS_PER_GROUP * DIL_HEAD_DIM)

    merged = jax.nn.sigmoid(gate_a) * (o_mla @ w_o_mla) + jax.nn.sigmoid(gate_b) * (o_dil @ w_o_dil)
    return merged @ w_out


def ffn_sublayer(x, shift, scale, gate, g_pre, w_gate, w_up, w_down, g_post):
    h = modulate(rms_norm(x, g_pre), shift, scale)
    y = rms_norm(swiglu(h, w_gate, w_up, w_down), g_post)
    return x + FFN_RES * gate[:, None, :] * y


def setup_inputs(seed: int = 0) -> dict:
    key = jax.random.key(seed)
    keys = jax.random.split(key, 25)
    f32 = jnp.float32

    def dense(k, shape, gain=1.0):
        return jax.random.normal(k, (DEPTH,) + shape, f32) * (gain * shape[0] ** -0.5)

    def gain_vec(k, dim):
        return 1.0 + 0.1 * jax.random.normal(k, (DEPTH, dim), f32)

    x = jax.random.normal(keys[0], (BATCH, SEQ, D_MODEL), f32)
    c = jax.random.normal(keys[1], (BATCH, D_MODEL), f32)
    positions = (jax.random.randint(keys[2], (BATCH, 1), 0, 2048, dtype=jnp.int32)
                 + jnp.arange(SEQ, dtype=jnp.int32)[None, :]).astype(jnp.int32)
    n_ada = N_SUBLAYERS * N_MOD * D_MODEL
    return {
        'x': x,
        'c': c,
        'positions': positions,
        'w_ada': dense(keys[3], (D_MODEL, n_ada), 0.5),
        'b_ada': 0.02 * jax.random.normal(keys[4], (DEPTH, n_ada), f32),
        'g_pre_ff1': gain_vec(keys[5], D_MODEL),
        'w_gate1': dense(keys[6], (D_MODEL, D_FF)),
        'w_up1': dense(keys[7], (D_MODEL, D_FF)),
        'w_down1': dense(keys[8], (D_FF, D_MODEL)),
        'g_post_ff1': gain_vec(keys[9], D_MODEL),
        'g_pre_mix': gain_vec(keys[10], D_MODEL),
        'w_in': dense(keys[11], (D_MODEL, D_IN)),
        'g_cq': gain_vec(keys[12], MLA_Q_LORA),
        'w_uq': dense(keys[13], (MLA_Q_LORA, MLA_HEADS * (MLA_NOPE + MLA_ROPE))),
        'g_ckv': gain_vec(keys[14], MLA_KV_LORA),
        'w_ukv': dense(keys[15], (MLA_KV_LORA, MLA_HEADS * (MLA_NOPE + MLA_V))),
        'w_o_mla': dense(keys[16], (MLA_HEADS * MLA_V, D_MODEL)),
        'w_o_dil': dense(keys[17], (DIL_HEADS_PER_GROUP * DIL_HEAD_DIM, D_MODEL)),
        'w_out': dense(keys[18], (D_MODEL, D_MODEL)),
        'g_post_mix': gain_vec(keys[19], D_MODEL),
        'g_pre_ff2': gain_vec(keys[20], D_MODEL),
        'w_gate2': dense(keys[21], (D_MODEL, D_FF)),
        'w_up2': dense(keys[22], (D_MODEL, D_FF)),
        'w_down2': dense(keys[23], (D_FF, D_MODEL)),
        'g_post_ff2': gain_vec(keys[24], D_MODEL),
    }


def reference(x, c, positions, w_ada, b_ada, g_pre_ff1, w_gate1, w_up1, w_down1, g_post_ff1,
              g_pre_mix, w_in, g_cq, w_uq, g_ckv, w_ukv, w_o_mla, w_o_dil, w_out, g_post_mix,
              g_pre_ff2, w_gate2, w_up2, w_down2, g_post_ff2):
    B = x.shape[0]
    cos_m, sin_m = rope_cos_sin(positions, MLA_ROPE, MLA_THETA)
    cos_p, sin_p = rope_cos_sin(positions, ROPE_PART, ROPE_THETA)
    cond = jax.nn.silu(c)
    for l in range(DEPTH):
        ada = (cond @ w_ada[l] + b_ada[l]).reshape(B, N_SUBLAYERS, N_MOD, D_MODEL)
        x = ffn_sublayer(x, ada[:, 0, 0], ada[:, 0, 1], ada[:, 0, 2],
                         g_pre_ff1[l], w_gate1[l], w_up1[l], w_down1[l], g_post_ff1[l])
        u = modulate(rms_norm(x, g_pre_mix[l]), ada[:, 1, 0], ada[:, 1, 1])
        y = token_mixer(u, cos_m, sin_m, cos_p, sin_p, w_in[l], g_cq[l], w_uq[l], g_ckv[l], w_ukv[l],
                        w_o_mla[l], w_o_dil[l], w_out[l])
        x = x + ada[:, 1, 2][:, None, :] * rms_norm(y, g_post_mix[l])
        x = ffn_sublayer(x, ada[:, 2, 0], ada[:, 2, 1], ada[:, 2, 2],
                         g_pre_ff2[l], w_gate2[l], w_up2[l], w_down2[l], g_post_ff2[l])
    return x
```

```cpp
#include <hip/hip_runtime.h>
#include <hip/hip_bf16.h>
#include <cstdio>
#include <cstdint>
#include <cmath>
namespace pg8 {
#define PG8_LAS __attribute__((address_space(3)))
typedef unsigned short bf16_t;
typedef short bf16x8 __attribute__((ext_vector_type(8)));
typedef float f32x4 __attribute__((ext_vector_type(4)));
typedef unsigned u32x4 __attribute__((ext_vector_type(4)));
constexpr int BM = 256, BK = 64, HALF = 128, HTB = HALF * BK * 2  , STAGE_BYTES = 8 * HTB, NXCD = 8, WGM = 8;

__host__ __device__ __forceinline__ int lds_byte(int r, int c) { const int st = (r >> 4) * 2 + (c >> 5), rr = r & 15, cc = c & 31, ob = rr * 64 + cc * 2; return st * 1024 + (ob ^ (((ob >> 9) & 1) << 5)); }
__host__ __device__ __forceinline__ void stage_rc(int b, int& R, int& C) { const int st = b / 1024, sb = b % 1024, swz = sb ^ (((sb >> 9) & 1) << 5); R = (st >> 1) * 16 + swz / 64; C = (st & 1) * 32 + (swz % 64) / 2; }
__host__ __device__ __forceinline__ int perm32(int rho) { const int n = rho >> 4, i = rho & 15; return 8 * (i >> 2) + 4 * n + (i & 3); }

struct Unit { int pm, pn; };
struct Gemm { const bf16_t* A; const bf16_t* Bt; int M, N, K; };

struct StaticOrder {
    int nM, nN, nwg, G, c;
    __host__ __device__ void init(int M, int N, int G_, int c_) { nM = M / BM; nN = N / BM; nwg = nM * nN; G = G_; c = c_; }
    __host__ __device__ bool next(int i, Unit& u) const {
        const long L = (long)i * G + c; if (L >= nwg) return false;
        int wgid = (int)L; { const int q = nwg / NXCD, r = nwg % NXCD, xcd = wgid % NXCD, off = wgid / NXCD; wgid = (xcd < r ? xcd * (q + 1) : r * (q + 1) + (xcd - r) * q) + off; }
        const int nig = WGM * nN, gid = wgid / nig, fm = gid * WGM, gsz = (nM - fm) < WGM ? (nM - fm) : WGM;
        u.pm = fm + ((wgid % nig) % gsz); u.pn = (wgid % nig) / gsz; return true;
    }
    __device__ __forceinline__ void a_ready(const Unit&) const {}
    __device__ __forceinline__ void done(const Unit&) const {}
};

__device__ __forceinline__ unsigned cvt_pk_bf16(float lo, float hi) { unsigned r; asm volatile("v_cvt_pk_bf16_f32 %0, %1, %2" : "=v"(r) : "v"(lo), "v"(hi)); return r; }
__device__ __forceinline__ float bf_lo(unsigned w) { return __uint_as_float(w << 16); }
__device__ __forceinline__ float bf_hi(unsigned w) { return __uint_as_float(w & 0xffff0000u); }
__device__ __forceinline__ float sigmoid_f(float x) { return __builtin_amdgcn_rcpf(1.0f + __builtin_amdgcn_exp2f(-1.4426950408889634f * x)); }

struct EpiBf16 {
    static constexpr bool PERM = true, AFTER_DRAIN = false;
    bf16_t* O; int ldc;
    __device__ __forceinline__ void operator()(const f32x4 (&acc)[2][2][4][2], const Unit& u, int wr, int wc, int fr, int fq) const {
        const int row0 = u.pm * BM + wr * 64 + fr; const int col0 = u.pn * BM + wc * 32 + 8 * fq;
#pragma unroll
        for (int ai = 0; ai < 2; ++ai)
#pragma unroll
            for (int m = 0; m < 4; ++m) { bf16_t* rowp = O + (size_t)(row0 + ai * HALF + m * 16) * ldc + col0;
#pragma unroll
                for (int bj = 0; bj < 2; ++bj) { const f32x4 v0 = acc[ai][bj][m][0], v1 = acc[ai][bj][m][1];
                    u32x4 w; w.x = cvt_pk_bf16(v0[0], v0[1]); w.y = cvt_pk_bf16(v0[2], v0[3]); w.z = cvt_pk_bf16(v1[0], v1[1]); w.w = cvt_pk_bf16(v1[2], v1[3]);
                    *(u32x4*)(rowp + bj * HALF) = w; } }
    }
};
struct EpiSwiGLU {
    static constexpr bool PERM = true, AFTER_DRAIN = false;
    bf16_t* O; int ldc;
    __device__ __forceinline__ void operator()(const f32x4 (&acc)[2][2][4][2], const Unit& u, int wr, int wc, int fr, int fq) const {
        const int row0 = u.pm * BM + wr * 64 + fr; const int col0 = u.pn * HALF + wc * 32 + 8 * fq;
#pragma unroll
        for (int ai = 0; ai < 2; ++ai)
#pragma unroll
            for (int m = 0; m < 4; ++m) { bf16_t* rowp = O + (size_t)(row0 + ai * HALF + m * 16) * ldc + col0;
                float h[8];
#pragma unroll
                for (int n = 0; n < 2; ++n)
#pragma unroll
                    for (int j = 0; j < 4; ++j) { const float g = acc[ai][0][m][n][j], up = acc[ai][1][m][n][j]; h[n * 4 + j] = g * sigmoid_f(g) * up; }
                u32x4 w; w.x = cvt_pk_bf16(h[0], h[1]); w.y = cvt_pk_bf16(h[2], h[3]); w.z = cvt_pk_bf16(h[4], h[5]); w.w = cvt_pk_bf16(h[6], h[7]);
                *(u32x4*)rowp = w; }
    }
};
struct EpiMerge {
    static constexpr bool PERM = true, AFTER_DRAIN = false;
    bf16_t* O; int ldc; const bf16_t* G; int ldg; int goff;
    __device__ __forceinline__ void operator()(const f32x4 (&acc)[2][2][4][2], const Unit& u, int wr, int wc, int fr, int fq) const {
        const int row0 = u.pm * BM + wr * 64 + fr; const int col0 = u.pn * HALF + wc * 32 + 8 * fq;
#pragma unroll
        for (int ai = 0; ai < 2; ++ai)
#pragma unroll
            for (int m = 0; m < 4; ++m) { const size_t row = (size_t)(row0 + ai * HALF + m * 16);
                const u32x4 ga = *(const u32x4*)(G + row * ldg + col0), gb = *(const u32x4*)(G + row * ldg + goff + col0);
                float h[8];
#pragma unroll
                for (int q = 0; q < 4; ++q) { const int n = q >> 1, j = (q & 1) * 2;
                    h[2 * q]     = sigmoid_f(bf_lo(ga[q])) * acc[ai][0][m][n][j]     + sigmoid_f(bf_lo(gb[q])) * acc[ai][1][m][n][j];
                    h[2 * q + 1] = sigmoid_f(bf_hi(ga[q])) * acc[ai][0][m][n][j + 1] + sigmoid_f(bf_hi(gb[q])) * acc[ai][1][m][n][j + 1]; }
                u32x4 w; w.x = cvt_pk_bf16(h[0], h[1]); w.y = cvt_pk_bf16(h[2], h[3]); w.z = cvt_pk_bf16(h[4], h[5]); w.w = cvt_pk_bf16(h[6], h[7]);
                *(u32x4*)(O + row * ldc + col0) = w; }
    }
};

template <class Epi, class Sched, bool ALIGN_EPI = false, bool SP2 = false>
__device__ __forceinline__ void gemm_phase(PG8_LAS unsigned char* lds, const Gemm g, const Sched& S, const Epi& E) {
    const int tid = threadIdx.x, wid = __builtin_amdgcn_readfirstlane(tid >> 6), lane = tid & 63, wr = wid >> 2, wc = wid & 3, fr = lane & 15, fq = lane >> 4;
    const int K = g.K, nt = K / BK;
    unsigned voffA[2], voffB[2];
#pragma unroll
    for (int i = 0; i < 2; ++i) { int R, C; stage_rc(tid * 16 + i * 8192, R, C); const int Rb = Epi::PERM ? ((R & ~31) + perm32(R & 31)) : R;
        voffA[i] = (unsigned)(R * K + C) * 2u; voffB[i] = (unsigned)(Rb * K + C) * 2u; }
    const size_t kstep = (size_t)(BK * 2);
    const size_t hstep = (size_t)HALF * K * 2;
    const size_t tstep = 2 * hstep;
    const unsigned ldsw = (unsigned)wid * 1024u;
    const int aoff = lds_byte(wr * 64 + fr, fq * 8), boff = lds_byte(wc * 32 + fr, fq * 8);
#define PG8_SA(b, h) (((b) * 2 + (h)) * HTB)
#define PG8_SB(b, h) ((4 + (b) * 2 + (h)) * HTB)
#define PG8_STAGE(bufoff, gbase, voff) do { _Pragma("unroll") for (int _i = 0; _i < 2; ++_i) \
        __builtin_amdgcn_global_load_lds((const unsigned*)((const char*)(gbase) + (voff)[_i]), (PG8_LAS unsigned*)(lds + (bufoff) + ldsw + _i * 8192), 16, 0, 0); } while (0)
#define PG8_LDA(dst, b, h) do { _Pragma("unroll") for (int m = 0; m < 4; ++m) _Pragma("unroll") for (int k = 0; k < 2; ++k) dst[m][k] = *(const PG8_LAS bf16x8*)(lds + PG8_SA(b, h) + aoff + m * 2048 + k * 1024); } while (0)
#define PG8_LDB(dst, b, h) do { _Pragma("unroll") for (int n = 0; n < 2; ++n) _Pragma("unroll") for (int k = 0; k < 2; ++k) dst[n][k] = *(const PG8_LAS bf16x8*)(lds + PG8_SB(b, h) + boff + n * 2048 + k * 1024); } while (0)
#define PG8_MMA(ai, bj, At, Bt) do { __builtin_amdgcn_s_setprio(1); _Pragma("unroll") for (int m = 0; m < 4; ++m) _Pragma("unroll") for (int n = 0; n < 2; ++n) _Pragma("unroll") for (int k = 0; k < 2; ++k) \
        acc[ai][bj][m][n] = __builtin_amdgcn_mfma_f32_16x16x32_bf16(Bt[n][k], At[m][k], acc[ai][bj][m][n], 0, 0, 0); __builtin_amdgcn_s_setprio(0); } while (0)
#define PG8_WAIT_V(n) asm volatile("s_waitcnt vmcnt(" #n ")" ::: "memory")
#define PG8_WAIT_L(n) asm volatile("s_waitcnt lgkmcnt(" #n ")" ::: "memory")
#define PG8_BAR __builtin_amdgcn_s_barrier()
#define PG8_SCHED __builtin_amdgcn_sched_barrier(0)
    Unit cur, nxt; int ui = 0;
    if (!S.next(0, cur)) return;
    f32x4 acc[2][2][4][2];
#pragma unroll
    for (int a = 0; a < 2; ++a)
#pragma unroll
        for (int b = 0; b < 2; ++b)
#pragma unroll
            for (int m = 0; m < 4; ++m)
#pragma unroll
                for (int n = 0; n < 2; ++n) acc[a][b][m][n] = (f32x4){0.f, 0.f, 0.f, 0.f};
    bf16x8 At[4][2], B0[2][2], B1[2][2];
    const char* cA = (const char*)g.A + (size_t)cur.pm * tstep; const char* cB = (const char*)g.Bt + (size_t)cur.pn * tstep;
    S.a_ready(cur);
    if constexpr (SP2) {
        PG8_STAGE(PG8_SB(0, 0), cB, voffB); PG8_STAGE(PG8_SB(0, 1), cB + hstep, voffB); PG8_STAGE(PG8_SA(0, 0), cA, voffA); PG8_STAGE(PG8_SA(0, 1), cA + hstep, voffA);
        if (wr == 1) PG8_BAR;
        PG8_WAIT_V(2); PG8_BAR;
        PG8_STAGE(PG8_SB(1, 0), cB + kstep, voffB); PG8_STAGE(PG8_SA(1, 0), cA + kstep, voffA); PG8_STAGE(PG8_SB(1, 1), cB + hstep + kstep, voffB);
        PG8_WAIT_V(6); PG8_BAR;
    } else {
        PG8_STAGE(PG8_SB(0, 0), cB, voffB); PG8_STAGE(PG8_SA(0, 0), cA, voffA); PG8_STAGE(PG8_SB(0, 1), cB + hstep, voffB); PG8_STAGE(PG8_SA(0, 1), cA + hstep, voffA);
        if (wr == 1) PG8_BAR;
        PG8_WAIT_V(4); PG8_BAR;
        PG8_STAGE(PG8_SB(1, 0), cB + kstep, voffB); PG8_STAGE(PG8_SA(1, 0), cA + kstep, voffA); PG8_STAGE(PG8_SB(1, 1), cB + hstep + kstep, voffB);
        PG8_WAIT_V(6); PG8_BAR;
    }
    for (;;) {
        const bool has_next = S.next(ui + 1, nxt);
        const char* nA = has_next ? (const char*)g.A + (size_t)nxt.pm * tstep : cA; const char* nB = has_next ? (const char*)g.Bt + (size_t)nxt.pn * tstep : cB;
        for (int t = 0; t < nt; t += 2) {
            const bool last = (t == nt - 2);
            const char* a1 = cA + (size_t)(t + 1) * kstep;
            const char* a2 = last ? nA : cA + (size_t)(t + 2) * kstep; const char* b2 = last ? nB : cB + (size_t)(t + 2) * kstep;
            const char* a3 = a2 + kstep; const char* b3 = b2 + kstep;
            if (last && has_next) S.a_ready(nxt);
            if constexpr (SP2) {
            PG8_LDB(B0, 0, 0); PG8_LDB(B1, 0, 1); PG8_SCHED; PG8_LDA(At, 0, 0); PG8_STAGE(PG8_SA(1, 1), a1 + hstep, voffA);
            PG8_WAIT_V(8); PG8_WAIT_L(0); PG8_BAR; PG8_MMA(0, 0, At, B0); PG8_MMA(0, 1, At, B1); PG8_BAR; PG8_SCHED;
            PG8_LDA(At, 0, 1); PG8_STAGE(PG8_SB(0, 0), b2, voffB); PG8_STAGE(PG8_SB(0, 1), b2 + hstep, voffB); PG8_STAGE(PG8_SA(0, 0), a2, voffA);
            PG8_WAIT_V(8); PG8_WAIT_L(0); PG8_BAR; PG8_MMA(1, 0, At, B0); PG8_MMA(1, 1, At, B1); PG8_BAR; PG8_SCHED;
            PG8_LDB(B0, 1, 0); PG8_LDB(B1, 1, 1); PG8_SCHED; PG8_LDA(At, 1, 0); PG8_STAGE(PG8_SA(0, 1), a2 + hstep, voffA);
            PG8_WAIT_V(8); PG8_WAIT_L(0); PG8_BAR; PG8_MMA(0, 0, At, B0); PG8_MMA(0, 1, At, B1); PG8_BAR; PG8_SCHED;
            PG8_LDA(At, 1, 1); PG8_STAGE(PG8_SB(1, 0), b3, voffB); PG8_STAGE(PG8_SB(1, 1), b3 + hstep, voffB); PG8_STAGE(PG8_SA(1, 0), a3, voffA);
            PG8_WAIT_V(8); PG8_WAIT_L(0); PG8_BAR; PG8_MMA(1, 0, At, B0); PG8_MMA(1, 1, At, B1); PG8_BAR; PG8_SCHED;
            } else {
            PG8_LDB(B0, 0, 0); PG8_SCHED; PG8_LDA(At, 0, 0); PG8_STAGE(PG8_SA(1, 1), a1 + hstep, voffA);
            PG8_WAIT_L(8); PG8_BAR; PG8_WAIT_L(0); PG8_MMA(0, 0, At, B0); PG8_BAR; PG8_SCHED;
            PG8_LDB(B1, 0, 1); PG8_STAGE(PG8_SB(0, 0), b2, voffB);
            PG8_BAR; PG8_WAIT_L(0); PG8_MMA(0, 1, At, B1); PG8_BAR;
            PG8_LDA(At, 0, 1); PG8_STAGE(PG8_SA(0, 0), a2, voffA);
            PG8_BAR; PG8_WAIT_L(0); PG8_MMA(1, 0, At, B0); PG8_BAR; PG8_SCHED;
            PG8_STAGE(PG8_SB(0, 1), b2 + hstep, voffB);
            PG8_WAIT_V(6); PG8_BAR; PG8_MMA(1, 1, At, B1); PG8_BAR;
            PG8_LDB(B0, 1, 0); PG8_SCHED; PG8_LDA(At, 1, 0); PG8_STAGE(PG8_SA(0, 1), a2 + hstep, voffA);
            PG8_WAIT_L(8); PG8_BAR; PG8_WAIT_L(0); PG8_MMA(0, 0, At, B0); PG8_BAR; PG8_SCHED;
            PG8_LDB(B1, 1, 1); PG8_STAGE(PG8_SB(1, 0), b3, voffB);
            PG8_BAR; PG8_WAIT_L(0); PG8_MMA(0, 1, At, B1); PG8_BAR;
            PG8_LDA(At, 1, 1); PG8_STAGE(PG8_SA(1, 0), a3, voffA);
            PG8_BAR; PG8_WAIT_L(0); PG8_MMA(1, 0, At, B0); PG8_BAR; PG8_SCHED;
            PG8_STAGE(PG8_SB(1, 1), b3 + hstep, voffB);
            PG8_WAIT_V(6); PG8_BAR; PG8_MMA(1, 1, At, B1); PG8_BAR;
            }
        }
        if constexpr (ALIGN_EPI) { if (wr == 0) PG8_BAR; }
        if constexpr (!Epi::AFTER_DRAIN) { E(acc, cur, wr, wc, fr, fq); S.done(cur); }
        if (!has_next) break;
#pragma unroll
        for (int a = 0; a < 2; ++a)
#pragma unroll
            for (int b = 0; b < 2; ++b)
#pragma unroll
                for (int m = 0; m < 4; ++m)
#pragma unroll
                    for (int n = 0; n < 2; ++n) acc[a][b][m][n] = (f32x4){0.f, 0.f, 0.f, 0.f};
        cur = nxt; cA = nA; cB = nB; ++ui;
        if constexpr (ALIGN_EPI) { if (wr == 1) PG8_BAR; }
    }
    PG8_WAIT_V(0);
    if constexpr (!ALIGN_EPI) { if (wr == 0) PG8_BAR; }
    PG8_BAR;
    if constexpr (Epi::AFTER_DRAIN) { E.fused(acc, cur, wr, wc, fr, fq, lds, wid, lane); S.done(cur); }
#undef PG8_SA
#undef PG8_SB
#undef PG8_STAGE
#undef PG8_LDA
#undef PG8_LDB
#undef PG8_MMA
#undef PG8_WAIT_V
#undef PG8_WAIT_L
#undef PG8_BAR
#undef PG8_SCHED
}
}

#ifndef PG8_SP2
#define PG8_SP2 true
#endif
#ifndef PG8_ALIGN
#define PG8_ALIGN true
#endif
namespace mla {
#define MLA_LAS __attribute__((address_space(3)))
using bf16x8 = __attribute__((ext_vector_type(8))) short;
using s16x4  = __attribute__((ext_vector_type(4))) short;
using f32x16 = __attribute__((ext_vector_type(16))) float;
using u32x4  = __attribute__((ext_vector_type(4))) unsigned;
using u32x2  = __attribute__((ext_vector_type(2))) unsigned;
typedef unsigned short bf16_t;
constexpr int NW = 8, QBLK = 32, KVBLK = 64, DQK = 96, DV = 64, SEQ = 4096, NHEAD = 8;
constexpr int LDQ = 1792, LDO = 768, LDKR = 32, KOFF = 768, HSTRIDE = 128;
constexpr float SCALE = 0.10206207261596575f;
constexpr float THR = 8.f;
constexpr int SHM_V = KVBLK * DV * 2, SHM_K = KVBLK * 256, SHM_ATTN = 2 * SHM_V + 2 * SHM_K + NW * 64 * 4;
#define MLA_KSWZ(row, colB) ((row) * 256 + ((colB) ^ (((row) & 7) << 4)))
#define MLA_SBAR() __builtin_amdgcn_sched_barrier(0)
__device__ __forceinline__ int crow(int r, int hi) { return (r & 3) + 8 * (r >> 2) + 4 * hi; }
__device__ __forceinline__ unsigned cvtpk(float lo, float hi) { unsigned r; asm volatile("v_cvt_pk_bf16_f32 %0, %1, %2" : "=v"(r) : "v"(lo), "v"(hi)); return r; }

__device__ __forceinline__ void partialSM(f32x16& p0, f32x16& p1, float& m_reg, float& mn, float& alpha) {
  constexpr float C = SCALE * 1.4426950408889634f;
  float pmax = p0[0];
#pragma unroll
  for (int r = 1; r < 16; ++r) pmax = fmaxf(pmax, p0[r]);
#pragma unroll
  for (int r = 0; r < 16; ++r) pmax = fmaxf(pmax, p1[r]);
  { auto rr = __builtin_amdgcn_permlane32_swap(__float_as_uint(pmax), __float_as_uint(pmax), false, false);
    pmax = fmaxf(__uint_as_float(rr[0]), __uint_as_float(rr[1])); }
  if (__builtin_expect(__all(pmax - m_reg <= THR / SCALE), 1)) { mn = m_reg; alpha = 1.f; }
  else { mn = fmaxf(m_reg, pmax); alpha = __builtin_amdgcn_exp2f((m_reg - mn) * C); m_reg = mn; }
  const float mnC = -mn * C;
#pragma unroll
  for (int r = 0; r < 16; ++r) p0[r] = fmaf(p0[r], C, mnC);
#pragma unroll
  for (int r = 0; r < 16; ++r) p1[r] = fmaf(p1[r], C, mnC);
#pragma unroll
  for (int r = 0; r < 16; ++r) p0[r] = __builtin_amdgcn_exp2f(p0[r]);
}
__device__ __forceinline__ void finishSM(f32x16& p0, f32x16& p1, float alpha, float& l_reg, bf16x8& pa0, bf16x8& pa1, bf16x8& pa2, bf16x8& pa3) {
#pragma unroll
  for (int r = 0; r < 16; ++r) p1[r] = __builtin_amdgcn_exp2f(p1[r]);
  float ps = 0;
#pragma unroll
  for (int r = 0; r < 16; ++r) ps += p0[r];
#pragma unroll
  for (int r = 0; r < 16; ++r) ps += p1[r];
  { auto rr = __builtin_amdgcn_permlane32_swap(__float_as_uint(ps), __float_as_uint(ps), false, false);
    ps = __uint_as_float(rr[0]) + __uint_as_float(rr[1]); }
  l_reg = l_reg * alpha + ps;
#define MLA_PK4(P, BASE, OUT) do { unsigned a0 = cvtpk(P[BASE + 0], P[BASE + 1]), a1 = cvtpk(P[BASE + 2], P[BASE + 3]);   \
    unsigned b0 = cvtpk(P[BASE + 4], P[BASE + 5]), b1 = cvtpk(P[BASE + 6], P[BASE + 7]);                              \
    auto r0 = __builtin_amdgcn_permlane32_swap(a0, b0, false, false); auto r1 = __builtin_amdgcn_permlane32_swap(a1, b1, false, false); \
    u32x4 w = {r0[0], r1[0], r0[1], r1[1]}; OUT = __builtin_bit_cast(bf16x8, w); } while (0)
  MLA_PK4(p0, 0, pa0); MLA_PK4(p0, 8, pa1); MLA_PK4(p1, 0, pa2); MLA_PK4(p1, 8, pa3);
#undef MLA_PK4
}
__device__ __forceinline__ void qkt(f32x16& p0, f32x16& p1, const MLA_LAS char* Ks, const bf16x8* qr, int r32, int hi) {
  p0 = f32x16{}; p1 = f32x16{};
#pragma unroll
  for (int d0 = 0; d0 < DQK / 16; ++d0) { const int cb = (d0 * 16 + hi * 8) * 2;
    const bf16x8 b0 = *reinterpret_cast<const MLA_LAS bf16x8*>(Ks + MLA_KSWZ(r32, cb));
    const bf16x8 b1 = *reinterpret_cast<const MLA_LAS bf16x8*>(Ks + MLA_KSWZ(32 + r32, cb));
    p0 = __builtin_amdgcn_mfma_f32_32x32x16_bf16(b0, qr[d0], p0, 0, 0, 0);
    p1 = __builtin_amdgcn_mfma_f32_32x32x16_bf16(b1, qr[d0], p1, 0, 0, 0); }
}
__device__ __forceinline__ int v_st(int k, int c) { const int kk = (k & ~0xC) | ((k & 4) << 1) | ((k & 8) >> 1); return ((kk >> 3) * 2 + (c >> 5)) * 512 + ((kk & 7) * 32 + (c & 31)) * 2; }
__device__ __forceinline__ int v_rd_base(int lane) { return ((lane & 3) << 3) | (((lane >> 2) & 3) << 6) | (((lane >> 4) & 1) << 5) | (((lane >> 5) & 1) << 8); }
constexpr int v_rd_off(int d0, int ks, int half) { return d0 * 512 + ks * 2048 + half * 1024; }
template <int OFF> __device__ __forceinline__ s16x4 tr_read(int vb) {
  s16x4 r; asm volatile("ds_read_b64_tr_b16 %0, %1 offset:%2" : "=&v"(r) : "v"(vb), "i"(OFF) : "memory"); return r;
}
template <int D0> __device__ __forceinline__ void pv_one(f32x16& od, int vb, bf16x8 pa0, bf16x8 pa1, bf16x8 pa2, bf16x8 pa3) {
  const s16x4 l0 = tr_read<v_rd_off(D0, 0, 0)>(vb), h0 = tr_read<v_rd_off(D0, 0, 1)>(vb), l1 = tr_read<v_rd_off(D0, 1, 0)>(vb), h1 = tr_read<v_rd_off(D0, 1, 1)>(vb);
  const s16x4 l2 = tr_read<v_rd_off(D0, 2, 0)>(vb), h2 = tr_read<v_rd_off(D0, 2, 1)>(vb), l3 = tr_read<v_rd_off(D0, 3, 0)>(vb), h3 = tr_read<v_rd_off(D0, 3, 1)>(vb);
  asm volatile("s_waitcnt lgkmcnt(0)" ::: "memory"); MLA_SBAR();
#define MLA_PK(L, H) (bf16x8){L[0], L[1], L[2], L[3], H[0], H[1], H[2], H[3]}
  od = __builtin_amdgcn_mfma_f32_32x32x16_bf16(pa0, MLA_PK(l0, h0), od, 0, 0, 0);
  od = __builtin_amdgcn_mfma_f32_32x32x16_bf16(pa1, MLA_PK(l1, h1), od, 0, 0, 0);
  od = __builtin_amdgcn_mfma_f32_32x32x16_bf16(pa2, MLA_PK(l2, h2), od, 0, 0, 0);
  od = __builtin_amdgcn_mfma_f32_32x32x16_bf16(pa3, MLA_PK(l3, h3), od, 0, 0, 0);
#undef MLA_PK
}
__device__ __forceinline__ void pv_d0(f32x16* o, int vb, bf16x8 pa0, bf16x8 pa1, bf16x8 pa2, bf16x8 pa3) {
  pv_one<0>(o[0], vb, pa0, pa1, pa2, pa3); pv_one<1>(o[1], vb, pa0, pa1, pa2, pa3);
}
__device__ __forceinline__ unsigned short f2bf_rne(float f) { unsigned u = __builtin_bit_cast(unsigned, f); return (unsigned short)((u + 0x7fffu + ((u >> 16) & 1u)) >> 16); }

__device__ __forceinline__ void attn_unit(const bf16_t* __restrict__ QKVM, const bf16_t* __restrict__ KR, bf16_t* __restrict__ OB, int b, int h, int q0, MLA_LAS char* lds) {
  const int tid = threadIdx.x, wid = tid >> 6, lane = tid & 63, r32 = lane & 31, hi = lane >> 5;
  MLA_LAS char* V_lds = lds; MLA_LAS char* K_lds = lds + 2 * SHM_V;
  MLA_LAS float* ws = (MLA_LAS float*)(lds + 2 * SHM_V + 2 * SHM_K) + wid * 64; MLA_LAS float* li_l = ws; MLA_LAS float* al_l = ws + 32;
  const long tok0 = (long)b * SEQ;
  float m_reg = -1e30f, l_reg = 0; f32x16 o[2] = {}; bf16x8 qr[6];
  const bf16_t* Qw = QKVM + (tok0 + q0 + wid * QBLK + r32) * LDQ + h * DQK + hi * 8;
#pragma unroll
  for (int d0 = 0; d0 < 6; ++d0) qr[d0] = *reinterpret_cast<const bf16x8*>(Qw + d0 * 16);
  const int sr = tid >> 3, sc8 = tid & 7;
  const int vst = v_st(sr, sc8 * 8), kst = MLA_KSWZ(sr, sc8 * 16), krst = MLA_KSWZ(sr, 128 + sc8 * 8);
  const bf16_t* Kg = QKVM + (tok0 + sr) * LDQ + KOFF + h * HSTRIDE + sc8 * 8;
  const bf16_t* KRg = KR + (tok0 + sr) * LDKR + sc8 * 4;
  const int vb0 = (int)(unsigned)(uintptr_t)V_lds + v_rd_base(lane);
  struct { bf16x8 ks, vs; u32x2 kr; } sr_[2];
#define MLA_SLOAD(i, k0) do { sr_[i].ks = *reinterpret_cast<const bf16x8*>(Kg + (long)(k0) * LDQ); sr_[i].vs = *reinterpret_cast<const bf16x8*>(Kg + (long)(k0) * LDQ + 64); \
    sr_[i].kr = *reinterpret_cast<const u32x2*>(KRg + (long)(k0) * LDKR); } while (0)
#define MLA_SWRITE(bb, i) do { *(MLA_LAS bf16x8*)(V_lds + (bb) * SHM_V + vst) = sr_[i].vs; *(MLA_LAS bf16x8*)(K_lds + (bb) * SHM_K + kst) = sr_[i].ks; \
    *(MLA_LAS u32x2*)(K_lds + (bb) * SHM_K + krst) = sr_[i].kr; } while (0)
#define MLA_SWAIT() asm volatile("s_waitcnt vmcnt(3)" ::: "memory")
#define MLA_RESC(a) do { if (__any((a) < 1.f)) { if (hi == 0) al_l[r32] = (a); asm volatile("s_waitcnt lgkmcnt(0)" ::: "memory"); \
    _Pragma("unroll") for (int d = 0; d < 2; ++d) _Pragma("unroll") for (int r = 0; r < 16; ++r) o[d][r] *= al_l[crow(r, hi)]; } } while (0)
  f32x16 pA0, pA1, pB0, pB1; float mnA, mnB, alA, alB; bf16x8 pa0, pa1, pa2, pa3; constexpr int NT = SEQ / KVBLK;
  constexpr int SE = 0, SO = 1;
  MLA_SLOAD(SE, 0); asm volatile("s_waitcnt vmcnt(0)" ::: "memory"); MLA_SWRITE(0, SE); __syncthreads();
  qkt(pA0, pA1, K_lds, qr, r32, hi); partialSM(pA0, pA1, m_reg, mnA, alA);
  MLA_SLOAD(SO, KVBLK); MLA_SLOAD(SE, 2 * KVBLK);
  MLA_SWAIT(); MLA_SWRITE(1, SO); __syncthreads();
  for (int j = 1; j + 1 < NT; j += 2) {
    MLA_SBAR(); qkt(pB0, pB1, K_lds + SHM_K, qr, r32, hi);
    finishSM(pA0, pA1, alA, l_reg, pa0, pa1, pa2, pa3); MLA_SBAR();
    MLA_SLOAD(SO, (j + 2) * KVBLK); MLA_SBAR();
    pv_d0(o, vb0, pa0, pa1, pa2, pa3); partialSM(pB0, pB1, m_reg, mnB, alB);
    __syncthreads(); MLA_SWAIT(); MLA_SWRITE(0, SE);
    MLA_RESC(alB); __syncthreads();
    MLA_SBAR(); qkt(pA0, pA1, K_lds, qr, r32, hi);
    finishSM(pB0, pB1, alB, l_reg, pa0, pa1, pa2, pa3); MLA_SBAR();
    if (j + 3 < NT) MLA_SLOAD(SE, (j + 3) * KVBLK); MLA_SBAR();
    pv_d0(o, vb0 + SHM_V, pa0, pa1, pa2, pa3); partialSM(pA0, pA1, m_reg, mnA, alA);
    __syncthreads(); MLA_SWAIT(); MLA_SWRITE(1, SO);
    MLA_RESC(alA); __syncthreads();
  }
  MLA_SBAR(); qkt(pB0, pB1, K_lds + SHM_K, qr, r32, hi);
  finishSM(pA0, pA1, alA, l_reg, pa0, pa1, pa2, pa3); MLA_SBAR();
  pv_d0(o, vb0, pa0, pa1, pa2, pa3); partialSM(pB0, pB1, m_reg, mnB, alB);
  __syncthreads(); MLA_RESC(alB);
  finishSM(pB0, pB1, alB, l_reg, pa0, pa1, pa2, pa3); MLA_SBAR();
  pv_d0(o, vb0 + SHM_V, pa0, pa1, pa2, pa3);
  if (hi == 0) li_l[r32] = l_reg; asm volatile("s_waitcnt lgkmcnt(0)" ::: "memory");
  float rli[16];
#pragma unroll
  for (int r = 0; r < 16; ++r) rli[r] = __builtin_amdgcn_rcpf(li_l[crow(r, hi)]);
  bf16_t* Ow = OB + (tok0 + q0 + wid * QBLK) * LDO + h * DV;
#pragma unroll
  for (int r = 0; r < 16; ++r) { const int orow = crow(r, hi);
#pragma unroll
    for (int d0 = 0; d0 < 2; ++d0) Ow[(long)orow * LDO + d0 * 32 + r32] = f2bf_rne(o[d0][r] * rli[r]); }
  __syncthreads();
#undef MLA_SLOAD
#undef MLA_SWRITE
#undef MLA_SWAIT
#undef MLA_RESC
}
}

#define GAS __attribute__((address_space(1)))
#define LAS __attribute__((address_space(3)))
typedef unsigned short bf16;
typedef unsigned v4u __attribute__((ext_vector_type(4)));
typedef float f32x4 __attribute__((ext_vector_type(4)));
typedef short bf16x8 __attribute__((ext_vector_type(8)));
typedef GAS unsigned gu32;
typedef GAS unsigned long long gu64;
#define RLX_AGENT __ATOMIC_RELAXED, __HIP_MEMORY_SCOPE_AGENT
#define LDS_WAIT() asm volatile("s_waitcnt lgkmcnt(0)" ::: "memory")
#define VM_WAIT() asm volatile("s_waitcnt vmcnt(0)" ::: "memory")
__device__ __forceinline__ unsigned long long rt() { return __builtin_amdgcn_s_memrealtime(); }
__device__ __forceinline__ unsigned f2bf(float f) { unsigned u = __builtin_bit_cast(unsigned, f); return (u + 0x7fffu + ((u >> 16) & 1u)) >> 16; }
__device__ __forceinline__ unsigned pk2(float lo, float hi) { return f2bf(lo) | (f2bf(hi) << 16); }

#define XB_TMO      128
#define XB_XCNT(j)  (256  + 64 * (j))
#define XB_XSUB(j)  (1280 + 64 * (j))
#define XB_XGEN(j)  (2304 + 64 * (j))
#define XB_TOP      3328
#define XB_TOPGEN   3392
#define XCD_BAR_WORDS 3456
#define XB_SPIN_CAP (1u << 18)

__device__ __forceinline__ unsigned xb_ld(unsigned* p)              { return __hip_atomic_load(p, __ATOMIC_RELAXED, __HIP_MEMORY_SCOPE_AGENT); }
__device__ __forceinline__ unsigned xb_add(unsigned* p, unsigned v) { return __hip_atomic_fetch_add(p, v, __ATOMIC_RELAXED, __HIP_MEMORY_SCOPE_AGENT); }
__device__ __forceinline__ unsigned xb_xcc_id() { return (unsigned)__builtin_amdgcn_s_getreg((3 << 11) | 20) & 0xFu; }
#define XB_SPIN(cond, bar) do { unsigned _sp = 0; while (cond) { __builtin_amdgcn_s_sleep(1); \
    if ((++_sp & 255u) == 0u) { if (xb_ld(&(bar)[XB_TMO])) break; if (_sp > XB_SPIN_CAP) { atomicAdd(&(bar)[XB_TMO], 1u); break; } } } } while (0)

struct XcdBarrier {
    unsigned* bar; unsigned x;
    volatile LAS unsigned* st;
};

__device__ __forceinline__ XcdBarrier xcd_barrier_post(unsigned* bar, volatile LAS unsigned* st) {
    XcdBarrier b; b.bar = bar; b.x = xb_xcc_id(); b.st = st;
    if (threadIdx.x == 0) (void)xb_add(&bar[XB_XCNT(b.x)], 1u);
    return b;
}
__device__ __forceinline__ void xcd_barrier_complete(unsigned* bar, unsigned x, unsigned& nloc, unsigned& nx) {
    const unsigned G = gridDim.x * gridDim.y * gridDim.z;
    unsigned sum, cnt, mine, sp = 0u;
    for (;;) {
        sum = 0u; cnt = 0u; mine = 0u;
#pragma unroll
        for (unsigned j = 0; j < 16; ++j) { const unsigned c = xb_ld(&bar[XB_XCNT(j)]); sum += c; cnt += (c > 0u) ? 1u : 0u; mine = (j == x) ? c : mine; }
        if (sum == G) break;
        __builtin_amdgcn_s_sleep(1);
        if ((++sp & 255u) == 0u) { if (xb_ld(&bar[XB_TMO])) break; if (sp > XB_SPIN_CAP) { atomicAdd(&bar[XB_TMO], 1u); break; } }
    }
    nloc = mine > 0u ? mine : 1u; nx = cnt > 0u ? cnt : 1u;
}

__device__ __forceinline__ void xcd_barrier(const XcdBarrier& b) {
    asm volatile("s_waitcnt vmcnt(0)" ::: "memory");
    __syncthreads();
    if (threadIdx.x == 0) {
        unsigned* bar = b.bar;
        __builtin_amdgcn_s_waitcnt(0);
        unsigned nloc = b.st[0], nx = b.st[1];
        if (nloc == 0u) { xcd_barrier_complete(bar, b.x, nloc, nx); b.st[0] = nloc; b.st[1] = nx; }
        const unsigned old = xb_add(&bar[XB_XSUB(b.x)], 1u);
        const unsigned gen = old / nloc;
        if (old + 1u == (gen + 1u) * nloc) {
            __builtin_amdgcn_fence(__ATOMIC_RELEASE, "agent");
            asm volatile("s_waitcnt vmcnt(0)" ::: "memory");
            const unsigned og = xb_add(&bar[XB_TOP], 1u);
            const unsigned tg = og / nx;
            if (og + 1u == (tg + 1u) * nx) xb_add(&bar[XB_TOPGEN], 1u);
            else XB_SPIN(xb_ld(&bar[XB_TOPGEN]) == tg, bar);
            __builtin_amdgcn_fence(__ATOMIC_ACQUIRE, "agent");
            xb_add(&bar[XB_XGEN(b.x)], 1u);
            asm volatile("s_waitcnt vmcnt(0)" ::: "memory");
        } else {
            XB_SPIN(xb_ld(&bar[XB_XGEN(b.x)]) == gen, bar);
            __builtin_amdgcn_fence(__ATOMIC_ACQUIRE, "agent");
            asm volatile("s_waitcnt vmcnt(0)" ::: "memory");
        }
    }
    __syncthreads();
}


constexpr int NWAVES = 8;
#ifndef MK_PER_PHASE
#define MK_PER_PHASE 1
#endif
constexpr int NPH = 17;

constexpr int BATCH = 8, SEQ = 4096, D = 1024, M = BATCH * SEQ, FF = 2816;
constexpr int NADA = 9216;
constexpr int N_CKV = 512, N_DQKV = 2304, N_GATES = 2048, K_UP = 384, N_UP = 1792, K_OD = 768, N_OD = 2048;
constexpr float EPS = 1e-6f;

constexpr size_t MiB = 1u << 20;
constexpr size_t WS_CTL = 0, CTL_ZERO_BYTES = 1 * MiB;
constexpr size_t WS_WGU1 = 1 * MiB, WS_WD1 = 12 * MiB, WS_WGU2 = 18 * MiB, WS_WD2 = 29 * MiB, WS_WINA = 35 * MiB, WS_WINB = 36 * MiB, WS_WINC = 41 * MiB,
                 WS_WUP = 45 * MiB, WS_WOD = 47 * MiB, WS_WOUT = 50 * MiB, WS_ADA = 52 * MiB, WS_KR = 53 * MiB;
constexpr size_t WS_GATES = 56 * MiB, WS_HID = 56 * MiB, WS_DQKV = 184 * MiB, WS_MG = 184 * MiB, WS_XN = 328 * MiB, WS_Y = 392 * MiB, WS_QKVM = 328 * MiB,
                 WS_O = 440 * MiB, WS_CKV = 456 * MiB, WS_CN = 488 * MiB, WS_END = 512 * MiB;
static_assert(WS_WGU1 + (size_t)2 * FF * D * 2 <= WS_WD1 && WS_WD1 + (size_t)D * FF * 2 <= WS_WGU2 && WS_WGU2 + (size_t)2 * FF * D * 2 <= WS_WD2 && WS_WD2 + (size_t)D * FF * 2 <= WS_WINA, "ws map 1");
static_assert(WS_WINA + (size_t)N_CKV * D * 2 <= WS_WINB && WS_WINB + (size_t)N_DQKV * D * 2 <= WS_WINC && WS_WINC + (size_t)N_GATES * D * 2 <= WS_WUP && WS_WUP + (size_t)N_UP * K_UP * 2 <= WS_WOD, "ws map 2");
static_assert(WS_WOD + (size_t)N_OD * K_OD * 2 <= WS_WOUT && WS_WOUT + (size_t)D * D * 2 <= WS_ADA && WS_ADA + (size_t)BATCH * NADA * 4 <= WS_KR && WS_KR + (size_t)M * 32 * 2 <= WS_GATES, "ws map 3");
static_assert(WS_HID + (size_t)M * FF * 2 <= WS_XN && WS_GATES + (size_t)M * N_GATES * 2 <= WS_DQKV && WS_DQKV + (size_t)M * N_DQKV * 2 <= WS_XN && WS_XN + (size_t)M * D * 2 <= WS_Y && WS_Y + (size_t)M * D * 2 <= WS_CKV, "ws map 4");
static_assert(WS_QKVM + (size_t)M * N_UP * 2 <= WS_O && WS_O + (size_t)M * K_OD * 2 <= WS_CN && WS_CKV + (size_t)M * N_CKV * 2 <= WS_CN && WS_CN + (size_t)M * K_UP * 2 <= WS_END && WS_MG + (size_t)M * D * 2 <= WS_XN, "ws map 5");
constexpr int CW_BAR = 4096;

constexpr int RING_OFF = 0, RING_BYTES = 131072;
constexpr int LDSCTL_OFF = RING_BYTES, MISC_OFF = LDSCTL_OFF + 320;
constexpr int LDS_BYTES = 147456;
static_assert(MISC_OFF + 128 <= LDS_BYTES && mla::SHM_ATTN <= RING_BYTES, "LDS map");

typedef unsigned v2u __attribute__((ext_vector_type(2)));
struct Frame {
    LAS unsigned char* lds;
    volatile LAS unsigned* MISC;
    gu32* ctl;
    int tid, lane, wave;
    int vcu, G;
    unsigned char* ws;
};
__device__ __forceinline__ float wave_sum(float v) {
#pragma unroll
    for (int o = 1; o < 64; o <<= 1) v += __shfl_xor(v, o);
    return v;
}
__device__ __forceinline__ float bflo(unsigned w) { return __uint_as_float(w << 16); }
__device__ __forceinline__ float bfhi(unsigned w) { return __uint_as_float(w & 0xffff0000u); }
__device__ __forceinline__ float bf1(bf16 h) { return __uint_as_float((unsigned)h << 16); }

__device__ __forceinline__ void transpose_item(const float* W, int N, int k0, int n0, bf16* WT, int ldk, int drow0, int kd0, LAS float* scr, int lane) {
#pragma unroll 8
    for (int i = 0; i < 32; ++i) { const int kk = 2 * i + (lane >> 5); scr[kk * 33 + (lane & 31)] = W[(size_t)(k0 + kk) * N + n0 + (lane & 31)]; }
    LDS_WAIT(); asm volatile("" ::: "memory");
    const int c = lane & 7;
#pragma unroll
    for (int j = 0; j < 4; ++j) { const int n = (lane >> 3) + 8 * j; const LAS float* s = scr + (8 * c) * 33 + n;
        v4u o; o.x = pk2(s[0 * 33], s[1 * 33]); o.y = pk2(s[2 * 33], s[3 * 33]); o.z = pk2(s[4 * 33], s[5 * 33]); o.w = pk2(s[6 * 33], s[7 * 33]);
        *(GAS v4u*)(WT + (size_t)(drow0 + n) * ldk + kd0 + 8 * c) = o; }
    LDS_WAIT(); asm volatile("" ::: "memory");
}
__device__ __forceinline__ void zero_bytes(unsigned char* p, int nbytes, int lane) {
    const v4u z = {0u, 0u, 0u, 0u};
    for (int o = lane * 16; o < nbytes; o += 1024) *(GAS v4u*)(p + o) = z;
}
__device__ __forceinline__ int pair_row(int n0) { return 256 * (n0 >> 7) + (n0 & 127); }

struct Args { const void* in[25]; float* out; unsigned char* ws; int ph_lo, ph_hi, li, pad; };
enum { I_X = 0, I_C, I_POS, I_WADA, I_BADA, I_GPRE1, I_WG1, I_WU1, I_WD1, I_GPOST1, I_GPREM, I_WIN, I_GCQ, I_WUQ, I_GCKV, I_WUKV, I_WOMLA, I_WODIL, I_WOUT, I_GPOSTM, I_GPRE2, I_WG2, I_WU2, I_WD2, I_GPOST2 };

__device__ __forceinline__ void p0_prologue(Frame& F, const Args& A) {
    const float* c = (const float*)A.in[I_C]; const float* w_ada = (const float*)A.in[I_WADA]; const float* b_ada = (const float*)A.in[I_BADA];
    float* ada = (float*)(F.ws + WS_ADA);
    for (int g = F.vcu; g < NADA / 64; g += F.G) {
        LAS float* sc = (LAS float*)(F.lds + RING_OFF); LAS float* red = (LAS float*)(F.lds + RING_OFF + 32768);
        for (int i = F.tid; i < BATCH * D; i += NWAVES * 64) { const float v = c[i]; sc[i] = v / (1.0f + __expf(-v)); }
        __syncthreads();
        float acc[BATCH];
#pragma unroll
        for (int b = 0; b < BATCH; ++b) acc[b] = 0.f;
        const int col = 64 * g + F.lane;
#pragma unroll 4
        for (int kk = 0; kk < 128; ++kk) { const int k = 128 * F.wave + kk; const float w = w_ada[(size_t)k * NADA + col];
#pragma unroll
            for (int b = 0; b < BATCH; ++b) acc[b] += sc[b * D + k] * w; }
#pragma unroll
        for (int b = 0; b < BATCH; ++b) red[(F.wave * BATCH + b) * 64 + F.lane] = acc[b];
        __syncthreads();
        { const int b = F.tid >> 6; float s = 0.f;
#pragma unroll
          for (int w8 = 0; w8 < NWAVES; ++w8) s += red[(w8 * BATCH + b) * 64 + F.lane];
          ada[(size_t)b * NADA + col] = s + b_ada[col]; }
        __syncthreads();
    }
    LAS float* scr = (LAS float*)(F.lds + RING_OFF + F.wave * 16384);
    const int gw = F.vcu * NWAVES + F.wave, NGW = F.G * NWAVES;
    bf16* WGU1 = (bf16*)(F.ws + WS_WGU1); bf16* WD1 = (bf16*)(F.ws + WS_WD1); bf16* WGU2 = (bf16*)(F.ws + WS_WGU2); bf16* WD2 = (bf16*)(F.ws + WS_WD2);
    bf16* WINA = (bf16*)(F.ws + WS_WINA); bf16* WINB = (bf16*)(F.ws + WS_WINB); bf16* WINC = (bf16*)(F.ws + WS_WINC);
    bf16* WUP = (bf16*)(F.ws + WS_WUP); bf16* WOD = (bf16*)(F.ws + WS_WOD); bf16* WOUT = (bf16*)(F.ws + WS_WOUT);
    constexpr int I_GU = (D / 64) * (FF / 32);
    constexpr int I_DN = (FF / 64) * (D / 32);
    constexpr int I_IN = (D / 64) * (4768 / 32);
    constexpr int I_UQ = (256 / 64) * (768 / 32);
    constexpr int I_UKV = (128 / 64) * (1024 / 32);
    constexpr int I_OM = (512 / 64) * (D / 32);
    constexpr int I_ODL = (256 / 64) * (D / 32);
    constexpr int I_OUT = (D / 64) * (D / 32);
    constexpr int Z_A = 96, Z_UP = N_UP, Z_OD = N_OD;
    constexpr int NITEMS = 4 * I_GU + 2 * I_DN + I_IN + I_UQ + I_UKV + I_OM + I_ODL + I_OUT + Z_A + Z_UP + Z_OD;
    for (int it = gw; it < NITEMS; it += NGW) {
        int r = it;
        if (r < 4 * I_GU) {
            const int which = r / I_GU; r -= which * I_GU; const int nblk = FF / 32, kb = r / nblk, nb = r % nblk, n0 = 32 * nb;
            const float* W = which == 0 ? (const float*)A.in[I_WG1] : which == 1 ? (const float*)A.in[I_WU1] : which == 2 ? (const float*)A.in[I_WG2] : (const float*)A.in[I_WU2];
            transpose_item(W, FF, 64 * kb, n0, which < 2 ? WGU1 : WGU2, D, pair_row(n0) + (which & 1) * 128, 64 * kb, scr, F.lane); continue; }
        r -= 4 * I_GU;
        if (r < 2 * I_DN) { const int which = r / I_DN; r -= which * I_DN; const int nblk = D / 32, kb = r / nblk, nb = r % nblk;
            transpose_item(which ? (const float*)A.in[I_WD2] : (const float*)A.in[I_WD1], D, 64 * kb, 32 * nb, which ? WD2 : WD1, FF, 32 * nb, 64 * kb, scr, F.lane); continue; }
        r -= 2 * I_DN;
        if (r < I_IN) { const int nblk = 4768 / 32, kb = r / nblk, nb = r % nblk, n0 = 32 * nb;
            bf16* dst; int drow;
            if (n0 < 416) { dst = WINA; drow = n0; } else if (n0 < 2720) { dst = WINB; drow = n0 - 416; } else { dst = WINC; drow = n0 - 2720; }
            transpose_item((const float*)A.in[I_WIN], 4768, 64 * kb, n0, dst, D, drow, 64 * kb, scr, F.lane); continue; }
        r -= I_IN;
        if (r < I_UQ) { const int nblk = 768 / 32, kb = r / nblk, nb = r % nblk;
            transpose_item((const float*)A.in[I_WUQ], 768, 64 * kb, 32 * nb, WUP, K_UP, 32 * nb, 64 * kb, scr, F.lane); continue; }
        r -= I_UQ;
        if (r < I_UKV) { const int nblk = 1024 / 32, kb = r / nblk, nb = r % nblk;
            transpose_item((const float*)A.in[I_WUKV], 1024, 64 * kb, 32 * nb, WUP, K_UP, 768 + 32 * nb, 256 + 64 * kb, scr, F.lane); continue; }
        r -= I_UKV;
        if (r < I_OM) { const int nblk = D / 32, kb = r / nblk, nb = r % nblk;
            transpose_item((const float*)A.in[I_WOMLA], D, 64 * kb, 32 * nb, WOD, K_OD, pair_row(32 * nb), 64 * kb, scr, F.lane); continue; }
        r -= I_OM;
        if (r < I_ODL) { const int nblk = D / 32, kb = r / nblk, nb = r % nblk;
            transpose_item((const float*)A.in[I_WODIL], D, 64 * kb, 32 * nb, WOD, K_OD, pair_row(32 * nb) + 128, 512 + 64 * kb, scr, F.lane); continue; }
        r -= I_ODL;
        if (r < I_OUT) { const int nblk = D / 32, kb = r / nblk, nb = r % nblk;
            transpose_item((const float*)A.in[I_WOUT], D, 64 * kb, 32 * nb, WOUT, D, 32 * nb, 64 * kb, scr, F.lane); continue; }
        r -= I_OUT;
        if (r < Z_A) { zero_bytes((unsigned char*)(WINA + (size_t)(416 + r) * D), D * 2, F.lane); continue; }
        r -= Z_A;
        if (r < Z_UP) { unsigned char* row = (unsigned char*)(WUP + (size_t)r * K_UP); if (r < 768) zero_bytes(row + 512, 256, F.lane); else zero_bytes(row, 512, F.lane); continue; }
        r -= Z_UP;
        { unsigned char* row = (unsigned char*)(WOD + (size_t)r * K_OD); if ((r & 128) == 0) zero_bytes(row + 1024, 512, F.lane); else zero_bytes(row, 1024, F.lane); }
    }
}

template <int MODE>
__device__ __forceinline__ void row_pass(Frame& F, const float* xi, const bf16* y, float* xo, bf16* XN, const float* g_post, const float* gate, float cg,
                                         const float* g_pre, const float* shift, const float* scale) {
    const int gw = F.vcu * NWAVES + F.wave, NGW = F.G * NWAVES;
    for (int m = gw; m < M; m += NGW) {
        const int b = m >> 12;
        f32x4 v[4];
#pragma unroll
        for (int j = 0; j < 4; ++j) v[j] = *(const GAS f32x4*)(xi + (size_t)m * D + 256 * j + 4 * F.lane);
        if (MODE != 0) {
            f32x4 yv[4]; float s = 0.f;
#pragma unroll
            for (int j = 0; j < 4; ++j) { const v2u w = *(const GAS v2u*)(y + (size_t)m * D + 256 * j + 4 * F.lane);
                yv[j] = (f32x4){bflo(w.x), bfhi(w.x), bflo(w.y), bfhi(w.y)}; s += (yv[j].x * yv[j].x + yv[j].y * yv[j].y) + (yv[j].z * yv[j].z + yv[j].w * yv[j].w); }
            const float rstd = 1.0f / sqrtf(wave_sum(s) * (1.0f / D) + EPS);
#pragma unroll
            for (int j = 0; j < 4; ++j) { const int col = 256 * j + 4 * F.lane;
                const f32x4 gp = *(const GAS f32x4*)(g_post + col), gt = *(const GAS f32x4*)(gate + (size_t)b * NADA + col);
                v[j] = v[j] + (gt * cg) * (yv[j] * rstd * gp);
                *(GAS f32x4*)(xo + (size_t)m * D + col) = v[j]; }
        }
        if (MODE != 2) {
            float s = 0.f;
#pragma unroll
            for (int j = 0; j < 4; ++j) s += (v[j].x * v[j].x + v[j].y * v[j].y) + (v[j].z * v[j].z + v[j].w * v[j].w);
            const float rstd = 1.0f / sqrtf(wave_sum(s) * (1.0f / D) + EPS);
#pragma unroll
            for (int j = 0; j < 4; ++j) { const int col = 256 * j + 4 * F.lane;
                const f32x4 gp = *(const GAS f32x4*)(g_pre + col), sh = *(const GAS f32x4*)(shift + (size_t)b * NADA + col), sc = *(const GAS f32x4*)(scale + (size_t)b * NADA + col);
                const f32x4 h = (v[j] * rstd * gp) * (sc + 1.0f) + sh;
                v2u o; o.x = pk2(h.x, h.y); o.y = pk2(h.z, h.w);
                *(GAS v2u*)(XN + (size_t)m * D + col) = o; }
        }
    }
}

__device__ __forceinline__ void rope_rot(float t1, float t2, float ang, float& o1, float& o2) { float s, c; sincosf(ang, &s, &c); o1 = t1 * c - t2 * s; o2 = t2 * c + t1 * s; }

__device__ __forceinline__ void mix_prep(Frame& F, const Args& A) {
    const bf16* CKV = (const bf16*)(F.ws + WS_CKV); bf16* CN = (bf16*)(F.ws + WS_CN); bf16* KR = (bf16*)(F.ws + WS_KR); bf16* DQ = (bf16*)(F.ws + WS_DQKV);
    const float* g_cq = (const float*)A.in[I_GCQ]; const float* g_ckv = (const float*)A.in[I_GCKV]; const int* positions = (const int*)A.in[I_POS];
    const int gw = F.vcu * NWAVES + F.wave, NGW = F.G * NWAVES, lane = F.lane;
    for (int m = gw; m < M; m += NGW) {
        const float pos = (float)positions[m];
        { const v2u w = *(const GAS v2u*)(CKV + (size_t)m * N_CKV + 4 * lane);
          const float a0 = bflo(w.x), a1 = bfhi(w.x), a2 = bflo(w.y), a3 = bfhi(w.y);
          const float rstd = 1.0f / sqrtf(wave_sum((a0 * a0 + a1 * a1) + (a2 * a2 + a3 * a3)) * (1.0f / 256.0f) + EPS);
          const f32x4 g = *(const GAS f32x4*)(g_cq + 4 * lane);
          v2u o; o.x = pk2(a0 * rstd * g.x, a1 * rstd * g.y); o.y = pk2(a2 * rstd * g.z, a3 * rstd * g.w);
          *(GAS v2u*)(CN + (size_t)m * K_UP + 4 * lane) = o; }
        { const unsigned w = *(const GAS unsigned*)(CKV + (size_t)m * N_CKV + 256 + 2 * lane);
          const float a0 = bflo(w), a1 = bfhi(w);
          const float rstd = 1.0f / sqrtf(wave_sum(a0 * a0 + a1 * a1) * (1.0f / 128.0f) + EPS);
          *(GAS unsigned*)(CN + (size_t)m * K_UP + 256 + 2 * lane) = pk2(a0 * rstd * g_ckv[2 * lane], a1 * rstd * g_ckv[2 * lane + 1]); }
        if (lane < 16) {
            const float t1 = bf1(CKV[(size_t)m * N_CKV + 384 + lane]), t2 = bf1(CKV[(size_t)m * N_CKV + 400 + lane]);
            const float inv = exp2f(-(float)lane * (13.287712379549449f / 16.0f));
            float o1, o2; rope_rot(t1, t2, pos * inv, o1, o2);
            KR[(size_t)m * 32 + lane] = (bf16)f2bf(o1); KR[(size_t)m * 32 + 16 + lane] = (bf16)f2bf(o2);
        }
#pragma unroll
        for (int r = 0; r < 3; ++r) { const int p = lane + 64 * r, head = p >> 3, i = p & 7; bf16* q = DQ + (size_t)m * N_DQKV + head * 64 + i;
            const float t1 = bf1(q[0]), t2 = bf1(q[8]);
            const float inv = exp2f(-(float)i * (18.931568569324174f / 8.0f));
            float o1, o2; rope_rot(t1, t2, pos * inv, o1, o2);
            q[0] = (bf16)f2bf(o1); q[8] = (bf16)f2bf(o2); }
    }
}
__device__ __forceinline__ void q_rope(Frame& F, const Args& A) {
    bf16* Q = (bf16*)(F.ws + WS_QKVM); const int* positions = (const int*)A.in[I_POS];
    const int gw = F.vcu * NWAVES + F.wave, NGW = F.G * NWAVES, lane = F.lane;
    for (int m = gw; m < M; m += NGW) {
        const float pos = (float)positions[m];
#pragma unroll
        for (int r = 0; r < 2; ++r) { const int p = lane + 64 * r, h = p >> 4, i = p & 15; bf16* q = Q + (size_t)m * N_UP + h * 96 + 64 + i;
            const float t1 = bf1(q[0]), t2 = bf1(q[16]);
            const float inv = exp2f(-(float)i * (13.287712379549449f / 16.0f));
            float o1, o2; rope_rot(t1, t2, pos * inv, o1, o2);
            q[0] = (bf16)f2bf(o1); q[16] = (bf16)f2bf(o2); }
    }
}
__device__ __forceinline__ void dil_attn_simple(Frame& F) {
    const bf16* DQ = (const bf16*)(F.ws + WS_DQKV); bf16* OB = (bf16*)(F.ws + WS_O);
    constexpr float C2 = 0.125f * 1.4426950408889634f;
    for (int idx = F.vcu * (NWAVES * 64) + F.tid; idx < M * 4; idx += F.G * NWAVES * 64) {
        const int hs = idx & 3, m = idx >> 2, t = m & (SEQ - 1); const size_t rowb = (size_t)(m - t);
        float acc[64];
#pragma unroll
        for (int e = 0; e < 64; ++e) acc[e] = 0.f;
        float mrun = -1e30f, l = 0.f;
#pragma unroll 1
        for (int g = 0; g < 3; ++g) {
            const int dil = 1 << (2 * g);
            float q[64];
            { const bf16* qp = DQ + (size_t)m * N_DQKV + (g * 4 + hs) * 64;
#pragma unroll
              for (int c = 0; c < 8; ++c) { const v4u w = *(const GAS v4u*)(qp + 8 * c);
#pragma unroll
                  for (int k = 0; k < 4; ++k) { q[8 * c + 2 * k] = bflo(w[k]) * C2; q[8 * c + 2 * k + 1] = bfhi(w[k]) * C2; } } }
#pragma unroll 1
            for (int j = -64; j <= 64; ++j) {
                const int tt = t + dil * j; if (tt < 0 || tt >= SEQ) continue;
                const bf16* kp = DQ + (rowb + tt) * N_DQKV + (12 + g * 4 + hs) * 64; const bf16* vp = kp + 12 * 64;
                float s = 0.f;
#pragma unroll
                for (int c = 0; c < 8; ++c) { const v4u w = *(const GAS v4u*)(kp + 8 * c);
#pragma unroll
                    for (int k = 0; k < 4; ++k) { s += q[8 * c + 2 * k] * bflo(w[k]); s += q[8 * c + 2 * k + 1] * bfhi(w[k]); } }
                const float mn = fmaxf(mrun, s), alpha = __builtin_amdgcn_exp2f(mrun - mn), p = __builtin_amdgcn_exp2f(s - mn);
                mrun = mn; l = l * alpha + p;
#pragma unroll
                for (int c = 0; c < 8; ++c) { const v4u w = *(const GAS v4u*)(vp + 8 * c);
#pragma unroll
                    for (int k = 0; k < 4; ++k) { acc[8 * c + 2 * k] = acc[8 * c + 2 * k] * alpha + p * bflo(w[k]); acc[8 * c + 2 * k + 1] = acc[8 * c + 2 * k + 1] * alpha + p * bfhi(w[k]); } }
            }
        }
        const float rl = 1.0f / l; bf16* op = OB + (size_t)m * K_OD + 512 + hs * 64;
#pragma unroll
        for (int c = 0; c < 8; ++c) { v4u w;
#pragma unroll
            for (int k = 0; k < 4; ++k) w[k] = pk2(acc[8 * c + 2 * k] * rl, acc[8 * c + 2 * k + 1] * rl);
            *(GAS v4u*)(op + 8 * c) = w; }
    }
}

__global__ void __launch_bounds__(NWAVES * 64, 2) mk_fwd(Args args) {
    extern __shared__ __attribute__((aligned(16))) unsigned char lds[];
    Frame F;
    F.lds = (LAS unsigned char*)lds;
    F.MISC = (volatile LAS unsigned*)(F.lds + MISC_OFF);
    F.tid = threadIdx.x; F.lane = F.tid & 63; F.wave = __builtin_amdgcn_readfirstlane(F.tid >> 6);
    F.G = gridDim.x; { const int bx = blockIdx.x; F.vcu = (F.G % 8 == 0) ? (bx % 8) * (F.G / 8) + bx / 8 : bx; }
    F.ws = args.ws; F.ctl = (gu32*)(args.ws + WS_CTL);
    for (int u = F.tid; u < (LDS_BYTES - LDSCTL_OFF) / 4; u += NWAVES * 64) ((LAS unsigned*)(F.lds + LDSCTL_OFF))[u] = 0u;
    __syncthreads();
    XcdBarrier bar; bar.bar = (unsigned*)(F.ctl + CW_BAR); bar.x = 0; bar.st = nullptr;
    if (!MK_PER_PHASE) bar = xcd_barrier_post((unsigned*)(F.ctl + CW_BAR), F.MISC + 8);
#define GRID_BAR() do { if (!MK_PER_PHASE) xcd_barrier(bar); } while (0)
    const int lo = args.ph_lo, hi = args.ph_hi;
#define IN(k) (lo <= (k) && (k) < hi)
#define BOTH(k) (IN(k) && IN((k) + 1))
    const float* x = (const float*)args.in[I_X]; float* out = args.out;
    const float* ada = (const float*)(F.ws + WS_ADA);
    bf16* XN = (bf16*)(F.ws + WS_XN); bf16* HID = (bf16*)(F.ws + WS_HID); bf16* Y = (bf16*)(F.ws + WS_Y);
    typedef pg8::bf16_t pb;

    if (IN(0)) { p0_prologue(F, args); if (BOTH(0)) GRID_BAR(); }
    if (IN(1)) { row_pass<0>(F, x, nullptr, nullptr, XN, nullptr, nullptr, 0.f, (const float*)args.in[I_GPRE1], ada + 0 * D, ada + 1 * D); if (BOTH(1)) GRID_BAR(); }
    if (IN(2)) { pg8::Gemm g{(const pb*)XN, (const pb*)(F.ws + WS_WGU1), M, 2 * FF, D}; pg8::StaticOrder S; S.init(M, 2 * FF, F.G, (int)blockIdx.x);
        pg8::EpiSwiGLU E{(pb*)HID, FF}; pg8::gemm_phase<pg8::EpiSwiGLU, pg8::StaticOrder, PG8_ALIGN, PG8_SP2>(F.lds + RING_OFF, g, S, E); if (BOTH(2)) GRID_BAR(); }
    if (IN(3)) { pg8::Gemm g{(const pb*)HID, (const pb*)(F.ws + WS_WD1), M, D, FF}; pg8::StaticOrder S; S.init(M, D, F.G, (int)blockIdx.x);
        pg8::EpiBf16 E{(pb*)Y, D}; pg8::gemm_phase<pg8::EpiBf16, pg8::StaticOrder, PG8_ALIGN, PG8_SP2>(F.lds + RING_OFF, g, S, E); if (BOTH(3)) GRID_BAR(); }
    if (IN(4)) { row_pass<1>(F, x, Y, out, XN, (const float*)args.in[I_GPOST1], ada + 2 * D, 0.5f, (const float*)args.in[I_GPREM], ada + 3 * D, ada + 4 * D); if (BOTH(4)) GRID_BAR(); }
    if (IN(5)) {
        { pg8::Gemm g{(const pb*)XN, (const pb*)(F.ws + WS_WINA), M, N_CKV, D}; pg8::StaticOrder S; S.init(M, N_CKV, F.G, (int)blockIdx.x);
          pg8::EpiBf16 E{(pb*)(F.ws + WS_CKV), N_CKV}; pg8::gemm_phase<pg8::EpiBf16, pg8::StaticOrder, PG8_ALIGN, PG8_SP2>(F.lds + RING_OFF, g, S, E); }
        { pg8::Gemm g{(const pb*)XN, (const pb*)(F.ws + WS_WINB), M, N_DQKV, D}; pg8::StaticOrder S; S.init(M, N_DQKV, F.G, (int)blockIdx.x);
          pg8::EpiBf16 E{(pb*)(F.ws + WS_DQKV), N_DQKV}; pg8::gemm_phase<pg8::EpiBf16, pg8::StaticOrder, PG8_ALIGN, PG8_SP2>(F.lds + RING_OFF, g, S, E); }
        { pg8::Gemm g{(const pb*)XN, (const pb*)(F.ws + WS_WINC), M, N_GATES, D}; pg8::StaticOrder S; S.init(M, N_GATES, F.G, (int)blockIdx.x);
          pg8::EpiBf16 E{(pb*)(F.ws + WS_GATES), N_GATES}; pg8::gemm_phase<pg8::EpiBf16, pg8::StaticOrder, PG8_ALIGN, PG8_SP2>(F.lds + RING_OFF, g, S, E); }
        if (BOTH(5)) GRID_BAR(); }
    if (IN(6)) { mix_prep(F, args); if (BOTH(6)) GRID_BAR(); }
    if (IN(7)) { pg8::Gemm g{(const pb*)(F.ws + WS_CN), (const pb*)(F.ws + WS_WUP), M, N_UP, K_UP}; pg8::StaticOrder S; S.init(M, N_UP, F.G, (int)blockIdx.x);
        pg8::EpiBf16 E{(pb*)(F.ws + WS_QKVM), N_UP}; pg8::gemm_phase<pg8::EpiBf16, pg8::StaticOrder, PG8_ALIGN, PG8_SP2>(F.lds + RING_OFF, g, S, E); if (BOTH(7)) GRID_BAR(); }
    if (IN(8)) { q_rope(F, args); if (BOTH(8)) GRID_BAR(); }
    if (IN(9)) {
        const int NU = BATCH * 8 * (SEQ / 256), per = NU / F.G; const bool even = (NU % F.G) == 0;
        for (int i = 0;; ++i) { int un; if (even) { if (i >= per) break; un = F.vcu * per + i; } else { un = F.vcu + i * F.G; if (un >= NU) break; }
            const int bh = un >> 4, qb = un & 15;
            mla::attn_unit((const mla::bf16_t*)(F.ws + WS_QKVM), (const mla::bf16_t*)(F.ws + WS_KR), (mla::bf16_t*)(F.ws + WS_O), bh >> 3, bh & 7, qb * 256, (LAS char*)(F.lds + RING_OFF)); }
        if (BOTH(9)) GRID_BAR(); }
    if (IN(10)) { dil_attn_simple(F); if (BOTH(10)) GRID_BAR(); }
    if (IN(11)) { pg8::Gemm g{(const pb*)(F.ws + WS_O), (const pb*)(F.ws + WS_WOD), M, N_OD, K_OD}; pg8::StaticOrder S; S.init(M, N_OD, F.G, (int)blockIdx.x);
        pg8::EpiMerge E{(pb*)(F.ws + WS_MG), D, (const pb*)(F.ws + WS_GATES), N_GATES, D}; pg8::gemm_phase<pg8::EpiMerge, pg8::StaticOrder, PG8_ALIGN, PG8_SP2>(F.lds + RING_OFF, g, S, E); if (BOTH(11)) GRID_BAR(); }
    if (IN(12)) { pg8::Gemm g{(const pb*)(F.ws + WS_MG), (const pb*)(F.ws + WS_WOUT), M, D, D}; pg8::StaticOrder S; S.init(M, D, F.G, (int)blockIdx.x);
        pg8::EpiBf16 E{(pb*)Y, D}; pg8::gemm_phase<pg8::EpiBf16, pg8::StaticOrder, PG8_ALIGN, PG8_SP2>(F.lds + RING_OFF, g, S, E); if (BOTH(12)) GRID_BAR(); }
    if (IN(13)) { row_pass<1>(F, out, Y, out, XN, (const float*)args.in[I_GPOSTM], ada + 5 * D, 1.0f, (const float*)args.in[I_GPRE2], ada + 6 * D, ada + 7 * D); if (BOTH(13)) GRID_BAR(); }
    if (IN(14)) { pg8::Gemm g{(const pb*)XN, (const pb*)(F.ws + WS_WGU2), M, 2 * FF, D}; pg8::StaticOrder S; S.init(M, 2 * FF, F.G, (int)blockIdx.x);
        pg8::EpiSwiGLU E{(pb*)HID, FF}; pg8::gemm_phase<pg8::EpiSwiGLU, pg8::StaticOrder, PG8_ALIGN, PG8_SP2>(F.lds + RING_OFF, g, S, E); if (BOTH(14)) GRID_BAR(); }
    if (IN(15)) { pg8::Gemm g{(const pb*)HID, (const pb*)(F.ws + WS_WD2), M, D, FF}; pg8::StaticOrder S; S.init(M, D, F.G, (int)blockIdx.x);
        pg8::EpiBf16 E{(pb*)Y, D}; pg8::gemm_phase<pg8::EpiBf16, pg8::StaticOrder, PG8_ALIGN, PG8_SP2>(F.lds + RING_OFF, g, S, E); if (BOTH(15)) GRID_BAR(); }
    if (IN(16)) { row_pass<2>(F, out, Y, out, nullptr, (const float*)args.in[I_GPOST2], ada + 8 * D, 0.5f, nullptr, nullptr, nullptr); }
#undef IN
#undef BOTH
#undef GRID_BAR
}

extern "C" void kernel_launch(void* const* d_in, const int* in_sizes, int n_in, void* d_out, int out_size, void* d_ws, size_t ws_size, hipStream_t stream) {
    static int grid = 0;
    if (grid == 0) {
        if (n_in != 25 || in_sizes[0] != M * D || out_size != M * D || ws_size < WS_END) { fprintf(stderr, "kernel_launch: shape mismatch: n_in %d in0 %d out %d ws %zu (need >= %zu)\n", n_in, n_in > 0 ? in_sizes[0] : -1, out_size, ws_size, (size_t)WS_END); grid = -1; return; }
        int dev = 0, cus = 0, per_cu = 0;
        if (hipGetDevice(&dev) != hipSuccess || hipDeviceGetAttribute(&cus, hipDeviceAttributeMultiprocessorCount, dev) != hipSuccess) { fprintf(stderr, "kernel_launch: device query failed\n"); grid = -1; return; }
        if (hipFuncSetAttribute((const void*)mk_fwd, hipFuncAttributeMaxDynamicSharedMemorySize, LDS_BYTES) != hipSuccess) { fprintf(stderr, "kernel_launch: hipFuncSetAttribute failed\n"); grid = -1; return; }
        if (hipOccupancyMaxActiveBlocksPerMultiprocessor(&per_cu, (const void*)mk_fwd, NWAVES * 64, LDS_BYTES) != hipSuccess || per_cu < 1) { fprintf(stderr, "kernel_launch: occupancy query reports %d workgroups per CU\n", per_cu); (void)hipGetLastError(); grid = -1; return; }
        grid = cus;
    }
    if (grid < 0) return;
    if (hipMemsetAsync((char*)d_ws + WS_CTL, 0, CTL_ZERO_BYTES, stream) != hipSuccess) { fprintf(stderr, "kernel_launch: hipMemsetAsync failed\n"); return; }
    Args a{};
    for (int i = 0; i < 25; ++i) a.in[i] = d_in[i];
    a.out = (float*)d_out; a.ws = (unsigned char*)d_ws;
#if MK_PER_PHASE
    for (int p = 0; p < NPH; ++p) { a.ph_lo = p; a.ph_hi = p + 1; a.li = p;
        hipLaunchKernelGGL(mk_fwd, dim3(grid), dim3(NWAVES * 64), LDS_BYTES, stream, a); }
#else
    a.ph_lo = 0; a.ph_hi = NPH; a.li = 0;
    void* kargs[] = {&a};
    hipError_t e = hipLaunchCooperativeKernel((const void*)mk_fwd, dim3(grid), dim3(NWAVES * 64), kargs, LDS_BYTES, stream);
    if (e != hipSuccess) fprintf(stderr, "kernel_launch: cooperative launch failed: %s (grid %d)\n", hipGetErrorString(e), grid);
#endif
    const hipError_t le = hipPeekAtLastError();
    if (le != hipSuccess) fprintf(stderr, "kernel_launch: launch failed: %s\n", hipGetErrorName(le));
}
```

```cpp
#include <hip/hip_runtime.h>
#ifndef PROBE_EPI2
#define PROBE_EPI2 0
#endif
#include <hip/hip_bf16.h>
#include <cstdio>
#include <cstdint>
#include <cmath>
namespace pg8 {
#define PG8_LAS __attribute__((address_space(3)))
typedef unsigned short bf16_t;
typedef short bf16x8 __attribute__((ext_vector_type(8)));
typedef float f32x4 __attribute__((ext_vector_type(4)));
typedef unsigned u32x4 __attribute__((ext_vector_type(4)));
constexpr int BM = 256, BK = 64, HALF = 128, HTB = HALF * BK * 2  , STAGE_BYTES = 8 * HTB, NXCD = 8, WGM = 8;

__host__ __device__ __forceinline__ int lds_byte(int r, int c) { const int st = (r >> 4) * 2 + (c >> 5), rr = r & 15, cc = c & 31, ob = rr * 64 + cc * 2; return st * 1024 + (ob ^ (((ob >> 9) & 1) << 5)); }
__host__ __device__ __forceinline__ void stage_rc(int b, int& R, int& C) { const int st = b / 1024, sb = b % 1024, swz = sb ^ (((sb >> 9) & 1) << 5); R = (st >> 1) * 16 + swz / 64; C = (st & 1) * 32 + (swz % 64) / 2; }
__host__ __device__ __forceinline__ int perm32(int rho) { const int n = rho >> 4, i = rho & 15; return 8 * (i >> 2) + 4 * n + (i & 3); }

struct Unit { int pm, pn; };
struct Gemm { const bf16_t* A; const bf16_t* Bt; int M, N, K; };

struct StaticOrder {
    int nM, nN, nwg, G, c;
    __host__ __device__ void init(int M, int N, int G_, int c_) { nM = M / BM; nN = N / BM; nwg = nM * nN; G = G_; c = c_; }
    __host__ __device__ bool next(int i, Unit& u) const {
        const long L = (long)i * G + c; if (L >= nwg) return false;
        int wgid = (int)L; { const int q = nwg / NXCD, r = nwg % NXCD, xcd = wgid % NXCD, off = wgid / NXCD; wgid = (xcd < r ? xcd * (q + 1) : r * (q + 1) + (xcd - r) * q) + off; }
        const int nig = WGM * nN, gid = wgid / nig, fm = gid * WGM, gsz = (nM - fm) < WGM ? (nM - fm) : WGM;
        u.pm = fm + ((wgid % nig) % gsz); u.pn = (wgid % nig) / gsz; return true;
    }
    __device__ __forceinline__ void a_ready(const Unit&) const {}
    __device__ __forceinline__ void done(const Unit&) const {}
    __device__ __forceinline__ void krange(const Unit&, int nt_all, int& k0, int& nt) const { k0 = 0; nt = nt_all; }
};
struct UpOrder : StaticOrder {
    __device__ __forceinline__ void krange(const Unit& u, int, int& k0, int& nt) const { if (u.pn < 3) { k0 = 0; nt = 4; } else { k0 = 4; nt = 2; } }
};

__device__ __forceinline__ unsigned cvt_pk_bf16(float lo, float hi) { unsigned r; asm volatile("v_cvt_pk_bf16_f32 %0, %1, %2" : "=v"(r) : "v"(lo), "v"(hi)); return r; }
__device__ __forceinline__ float bf_lo(unsigned w) { return __uint_as_float(w << 16); }
__device__ __forceinline__ float bf_hi(unsigned w) { return __uint_as_float(w & 0xffff0000u); }
__device__ __forceinline__ float sigmoid_f(float x) { return __builtin_amdgcn_rcpf(1.0f + __builtin_amdgcn_exp2f(-1.4426950408889634f * x)); }

struct EpiBf16 {
    static constexpr bool PERM = true, AFTER_DRAIN = false, IDEMP = true; static constexpr int MID_T = 0; static constexpr bool ADJ = true;
    bf16_t* O; int ldc;
    static __device__ __forceinline__ unsigned ror8(unsigned v) { return (unsigned)__builtin_amdgcn_update_dpp(0, (int)v, 0x128  , 0xf, 0xf, true); }
    __device__ __forceinline__ void operator()(const f32x4 (&acc)[2][2][4][2], const Unit& u, int wr, int wc, int fr, int fq) const {
        const bool lo = fr < 8;
        const int rbase = u.pm * BM + wr * 64 + (fr & 7); const int col = u.pn * BM + wc * 64 + 8 * fq + (lo ? 0 : 32);
#pragma unroll
        for (int ai = 0; ai < 2; ++ai)
#pragma unroll
            for (int m = 0; m < 4; ++m) { bf16_t* rowp = O + (size_t)(rbase + ai * HALF + m * 16) * ldc + col;
                u32x4 w0, w1;
                { const f32x4 v0 = acc[ai][0][m][0], v1 = acc[ai][0][m][1]; w0.x = cvt_pk_bf16(v0[0], v0[1]); w0.y = cvt_pk_bf16(v0[2], v0[3]); w0.z = cvt_pk_bf16(v1[0], v1[1]); w0.w = cvt_pk_bf16(v1[2], v1[3]); }
                { const f32x4 v0 = acc[ai][1][m][0], v1 = acc[ai][1][m][1]; w1.x = cvt_pk_bf16(v0[0], v0[1]); w1.y = cvt_pk_bf16(v0[2], v0[3]); w1.z = cvt_pk_bf16(v1[0], v1[1]); w1.w = cvt_pk_bf16(v1[2], v1[3]); }
                u32x4 dA, dB;
#pragma unroll
                for (int q = 0; q < 4; ++q) { const unsigned t1 = ror8(w1[q]), t0 = ror8(w0[q]); dA[q] = lo ? w0[q] : t1; dB[q] = lo ? t0 : w1[q]; }
                *(u32x4*)rowp = dA; *(u32x4*)(rowp + (size_t)8 * ldc) = dB; }
    }
};
struct EpiSwiGLU {
    static constexpr bool PERM = true, AFTER_DRAIN = false, IDEMP = true; static constexpr int MID_T = 0; static constexpr bool ADJ = false;
    bf16_t* O; int ldc;
    __device__ __forceinline__ void operator()(const f32x4 (&acc)[2][2][4][2], const Unit& u, int wr, int wc, int fr, int fq) const {
        typedef float f32x2 __attribute__((ext_vector_type(2)));
        const int row0 = u.pm * BM + wr * 64 + fr; const int col0 = u.pn * HALF + wc * 32 + 8 * fq;
#pragma unroll
        for (int ai = 0; ai < 2; ++ai)
#pragma unroll
            for (int m = 0; m < 4; ++m) { bf16_t* rowp = O + (size_t)(row0 + ai * HALF + m * 16) * ldc + col0;
                f32x2 h[4];
#pragma unroll
                for (int q = 0; q < 4; ++q) { const int n = q >> 1, j = (q & 1) * 2;
                    const f32x2 g = {acc[ai][0][m][n][j], acc[ai][0][m][n][j + 1]}, up = {acc[ai][1][m][n][j], acc[ai][1][m][n][j + 1]};
                    f32x2 e; e.x = __builtin_amdgcn_exp2f(g.x); e.y = __builtin_amdgcn_exp2f(g.y);
                    const f32x2 d = e + 1.0f; f32x2 r; r.x = __builtin_amdgcn_rcpf(d.x); r.y = __builtin_amdgcn_rcpf(d.y);
                    h[q] = (g * up) * r; }
                u32x4 w; w.x = cvt_pk_bf16(h[0].x, h[0].y); w.y = cvt_pk_bf16(h[1].x, h[1].y); w.z = cvt_pk_bf16(h[2].x, h[2].y); w.w = cvt_pk_bf16(h[3].x, h[3].y);
                *(u32x4*)rowp = w; }
    }
};
template <bool ACCUM> struct EpiGate {
    static constexpr bool PERM = true, AFTER_DRAIN = false, IDEMP = !ACCUM; static constexpr int MID_T = 0; static constexpr bool ADJ = false;
    bf16_t* O; int ldc; const bf16_t* G; int ldg; int goff;
    __device__ __forceinline__ void operator()(const f32x4 (&acc)[2][2][4][2], const Unit& u, int wr, int wc, int fr, int fq) const {
        const int row0 = u.pm * BM + wr * 64 + fr; const int col0 = u.pn * BM + wc * 32 + 8 * fq;
#pragma unroll
        for (int ai = 0; ai < 2; ++ai)
#pragma unroll
            for (int m = 0; m < 4; ++m) { const size_t row = (size_t)(row0 + ai * HALF + m * 16);
#pragma unroll
                for (int bj = 0; bj < 2; ++bj) { const int col = col0 + bj * HALF;
                    const u32x4 gv = *(const u32x4*)(G + row * ldg + goff + col);
                    u32x4 prev = {0u, 0u, 0u, 0u}; if (ACCUM) prev = *(const u32x4*)(O + row * ldc + col);
                    float h[8];
#pragma unroll
                    for (int q = 0; q < 4; ++q) { const int n = q >> 1, j = (q & 1) * 2;
                        h[2 * q]     = sigmoid_f(bf_lo(gv[q])) * acc[ai][bj][m][n][j];
                        h[2 * q + 1] = sigmoid_f(bf_hi(gv[q])) * acc[ai][bj][m][n][j + 1];
                        if (ACCUM) { h[2 * q] += bf_lo(prev[q]); h[2 * q + 1] += bf_hi(prev[q]); } }
                    u32x4 w; w.x = cvt_pk_bf16(h[0], h[1]); w.y = cvt_pk_bf16(h[2], h[3]); w.z = cvt_pk_bf16(h[4], h[5]); w.w = cvt_pk_bf16(h[6], h[7]);
                    *(u32x4*)(O + row * ldc + col) = w; } }
    }
};
struct EpiGate2 {
    static constexpr bool PERM = true, AFTER_DRAIN = false, IDEMP = true; static constexpr int MID_T = 8; static constexpr bool ADJ = false;
    bf16_t* O; int ldc; const bf16_t* G; int ldg; int goff;
    static __device__ __forceinline__ float dbf(float gb) { return fminf(1.0f + __builtin_amdgcn_exp2f(-1.4426950408889634f * gb), 1e30f); }
    __device__ __forceinline__ void mid(f32x4 (&acc)[2][2][4][2], const Unit& u, int wr, int wc, int fr, int fq) const {
        const int row0 = u.pm * BM + wr * 64 + fr; const int col0 = u.pn * BM + wc * 32 + 8 * fq;
#pragma unroll
        for (int ai = 0; ai < 2; ++ai)
#pragma unroll
            for (int m = 0; m < 4; ++m) { const size_t row = (size_t)(row0 + ai * HALF + m * 16);
#pragma unroll
                for (int bj = 0; bj < 2; ++bj) { const int col = col0 + bj * HALF;
                    const u32x4 ga = *(const u32x4*)(G + row * ldg + col), gb = *(const u32x4*)(G + row * ldg + goff + col);
#pragma unroll
                    for (int q = 0; q < 4; ++q) { const int n = q >> 1, j = (q & 1) * 2;
                        acc[ai][bj][m][n][j]     *= dbf(bf_lo(gb[q])) * sigmoid_f(bf_lo(ga[q]));
                        acc[ai][bj][m][n][j + 1] *= dbf(bf_hi(gb[q])) * sigmoid_f(bf_hi(ga[q])); } } }
    }
    __device__ __forceinline__ void operator()(const f32x4 (&acc)[2][2][4][2], const Unit& u, int wr, int wc, int fr, int fq) const {
        const int row0 = u.pm * BM + wr * 64 + fr; const int col0 = u.pn * BM + wc * 32 + 8 * fq;
#pragma unroll
        for (int ai = 0; ai < 2; ++ai)
#pragma unroll
            for (int m = 0; m < 4; ++m) { const size_t row = (size_t)(row0 + ai * HALF + m * 16);
#pragma unroll
                for (int bj = 0; bj < 2; ++bj) { const int col = col0 + bj * HALF;
                    const u32x4 gb = *(const u32x4*)(G + row * ldg + goff + col);
                    float h[8];
#pragma unroll
                    for (int q = 0; q < 4; ++q) { const int n = q >> 1, j = (q & 1) * 2;
                        h[2 * q]     = __builtin_amdgcn_rcpf(dbf(bf_lo(gb[q]))) * acc[ai][bj][m][n][j];
                        h[2 * q + 1] = __builtin_amdgcn_rcpf(dbf(bf_hi(gb[q]))) * acc[ai][bj][m][n][j + 1]; }
                    u32x4 w; w.x = cvt_pk_bf16(h[0], h[1]); w.y = cvt_pk_bf16(h[2], h[3]); w.z = cvt_pk_bf16(h[4], h[5]); w.w = cvt_pk_bf16(h[6], h[7]);
                    *(u32x4*)(O + row * ldc + col) = w; } }
    }
};
struct EpiRoute3 {
    static constexpr bool PERM = true, AFTER_DRAIN = false, IDEMP = true; static constexpr int MID_T = 0; static constexpr bool ADJ = false;
    bf16_t* O0; int ld0; int t1; bf16_t* O1; int ld1; int t2; bf16_t* O2; int ld2;
    __device__ __forceinline__ void operator()(const f32x4 (&acc)[2][2][4][2], const Unit& u, int wr, int wc, int fr, int fq) const {
        bf16_t* base; int ldc, colt;
        if (u.pn < t1) { base = O0; ldc = ld0; colt = u.pn * BM; } else if (u.pn < t2) { base = O1; ldc = ld1; colt = (u.pn - t1) * BM; } else { base = O2; ldc = ld2; colt = (u.pn - t2) * BM; }
        const int row0 = u.pm * BM + wr * 64 + fr; const int col0 = colt + wc * 32 + 8 * fq;
#pragma unroll
        for (int ai = 0; ai < 2; ++ai)
#pragma unroll
            for (int m = 0; m < 4; ++m) { bf16_t* rowp = base + (size_t)(row0 + ai * HALF + m * 16) * ldc + col0;
#pragma unroll
                for (int bj = 0; bj < 2; ++bj) { const f32x4 v0 = acc[ai][bj][m][0], v1 = acc[ai][bj][m][1];
                    u32x4 w; w.x = cvt_pk_bf16(v0[0], v0[1]); w.y = cvt_pk_bf16(v0[2], v0[3]); w.z = cvt_pk_bf16(v1[0], v1[1]); w.w = cvt_pk_bf16(v1[2], v1[3]);
                    *(u32x4*)(rowp + bj * HALF) = w; } }
    }
};

struct EpiIn {
    static constexpr bool PERM = true, AFTER_DRAIN = false, IDEMP = true; static constexpr int MID_T = 0; static constexpr bool ADJ = false;
    bf16_t* CN; bf16_t* KR; bf16_t* DQ; bf16_t* GT; const float* g_cq; const float* g_ckv; const float* ropem; const float* roped; PG8_LAS float* red; float eps;
    static __device__ __forceinline__ void st8(bf16_t* p, const float (&h)[8]) { u32x4 w; w.x = cvt_pk_bf16(h[0], h[1]); w.y = cvt_pk_bf16(h[2], h[3]); w.z = cvt_pk_bf16(h[4], h[5]); w.w = cvt_pk_bf16(h[6], h[7]); *(u32x4*)p = w; }
    __device__ __forceinline__ void operator()(const f32x4 (&acc)[2][2][4][2], const Unit& u, int wr, int wc, int fr, int fq) const {
        const int row0 = u.pm * BM + wr * 64 + fr, rl0 = wr * 64 + fr, cl = wc * 32 + 8 * fq;
        if (u.pn >= 4) {
            bf16_t* base; int ldc, colt; if (u.pn < 11) { base = DQ; ldc = 2304; colt = (u.pn - 2) * BM; } else { base = GT; ldc = 2048; colt = (u.pn - 11) * BM; }
#pragma unroll
            for (int ai = 0; ai < 2; ++ai)
#pragma unroll
                for (int m = 0; m < 4; ++m) { bf16_t* rowp = base + (size_t)(row0 + ai * HALF + m * 16) * ldc + colt + cl;
#pragma unroll
                    for (int bj = 0; bj < 2; ++bj) { const f32x4 v0 = acc[ai][bj][m][0], v1 = acc[ai][bj][m][1]; const float h[8] = {v0[0], v0[1], v0[2], v0[3], v1[0], v1[1], v1[2], v1[3]}; st8(rowp + bj * HALF, h); } }
            return; }
        if (u.pn <= 1) {
            const int nbj = (u.pn == 0) ? 2 : 1;
#pragma unroll
            for (int ai = 0; ai < 2; ++ai)
#pragma unroll
                for (int m = 0; m < 4; ++m) { float sq = 0.f;
#pragma unroll
                    for (int bj = 0; bj < 2; ++bj) if (bj < nbj) {
#pragma unroll
                        for (int n = 0; n < 2; ++n) { const f32x4 v = acc[ai][bj][m][n]; sq += (v[0] * v[0] + v[1] * v[1]) + (v[2] * v[2] + v[3] * v[3]); } }
                    sq += __shfl_xor(sq, 16); sq += __shfl_xor(sq, 32);
                    if (fq == 0) red[(ai * HALF + rl0 + m * 16) * 4 + wc] = sq; }
            asm volatile("s_waitcnt lgkmcnt(0)" ::: "memory"); __builtin_amdgcn_s_barrier(); asm volatile("" ::: "memory");
            const float invn = (u.pn == 0) ? (1.0f / 256.0f) : (1.0f / 128.0f); const float* gv = (u.pn == 0) ? g_cq : g_ckv; const int cbase = (u.pn == 0) ? 0 : 256;
#pragma unroll
            for (int ai = 0; ai < 2; ++ai)
#pragma unroll
                for (int m = 0; m < 4; ++m) { const f32x4 pr = *(const PG8_LAS f32x4*)(red + (ai * HALF + rl0 + m * 16) * 4);
                    const float rstd = 1.0f / sqrtf(((pr[0] + pr[1]) + (pr[2] + pr[3])) * invn + eps); const size_t row = (size_t)(row0 + ai * HALF + m * 16);
#pragma unroll
                    for (int bj = 0; bj < 2; ++bj) if (bj < nbj) { const int col = bj * HALF + cl; const f32x4 g0 = *(const f32x4*)(gv + col), g1 = *(const f32x4*)(gv + col + 4);
                        const f32x4 v0 = acc[ai][bj][m][0], v1 = acc[ai][bj][m][1];
                        const float h[8] = {v0[0] * rstd * g0[0], v0[1] * rstd * g0[1], v0[2] * rstd * g0[2], v0[3] * rstd * g0[3], v1[0] * rstd * g1[0], v1[1] * rstd * g1[1], v1[2] * rstd * g1[2], v1[3] * rstd * g1[3]};
                        st8(CN + row * 384 + cbase + col, h); } }
            if (u.pn == 1 && wc == 0) {
                const bool hiH = fq >= 2;
#pragma unroll
                for (int ai = 0; ai < 2; ++ai)
#pragma unroll
                    for (int m = 0; m < 4; ++m) { const size_t row = (size_t)(row0 + ai * HALF + m * 16); const float* rp = ropem + row * 32 + 8 * (fq & 1);
                        const f32x4 c0 = *(const f32x4*)rp, c1 = *(const f32x4*)(rp + 4), s0 = *(const f32x4*)(rp + 16), s1 = *(const f32x4*)(rp + 20);
                        float h[8];
#pragma unroll
                        for (int i = 0; i < 8; ++i) { const float own = acc[ai][1][m][i >> 2][i & 3];
                            const auto rr = __builtin_amdgcn_permlane32_swap(__float_as_uint(own), __float_as_uint(own), false, false);
                            const float oth = __uint_as_float(hiH ? rr[0] : rr[1]); const float cs = (i < 4) ? c0[i & 3] : c1[i & 3], sn = (i < 4) ? s0[i & 3] : s1[i & 3];
                            h[i] = hiH ? (own * cs + oth * sn) : (own * cs - oth * sn); }
                        st8(KR + row * 32 + (hiH ? 16 : 0) + 8 * (fq & 1), h); } }
            return; }
        const int colt = (u.pn - 2) * BM; const bool odd = (fq & 1) != 0;
#pragma unroll
        for (int ai = 0; ai < 2; ++ai)
#pragma unroll
            for (int m = 0; m < 4; ++m) { const size_t row = (size_t)(row0 + ai * HALF + m * 16); const float* rp = roped + row * 16;
                const f32x4 c0 = *(const f32x4*)rp, c1 = *(const f32x4*)(rp + 4), s0 = *(const f32x4*)(rp + 8), s1 = *(const f32x4*)(rp + 12);
#pragma unroll
                for (int bj = 0; bj < 2; ++bj) { const int col = colt + bj * HALF + cl; float h[8];
                    if (colt + bj * HALF < 384) {
#pragma unroll
                        for (int i = 0; i < 8; ++i) { const float own = acc[ai][bj][m][i >> 2][i & 3];
                            const auto rr = __builtin_amdgcn_permlane16_swap(__float_as_uint(own), __float_as_uint(own), false, false);
                            const float oth = __uint_as_float(odd ? rr[0] : rr[1]); const float cs = (i < 4) ? c0[i & 3] : c1[i & 3], sn = (i < 4) ? s0[i & 3] : s1[i & 3];
                            h[i] = odd ? (own * cs + oth * sn) : (own * cs - oth * sn); }
                    } else {
#pragma unroll
                        for (int i = 0; i < 8; ++i) h[i] = acc[ai][bj][m][i >> 2][i & 3]; }
                    st8(DQ + row * 2304 + col, h); } }
    }
};

template <class Epi, class Sched, bool ALIGN_EPI = false, bool SP2 = false, bool OPAQUE_K = false>
__device__ __forceinline__ void gemm_phase(PG8_LAS unsigned char* lds, const Gemm g, const Sched& S, const Epi& E) {
    const int tid = threadIdx.x, wid = __builtin_amdgcn_readfirstlane(tid >> 6), lane = tid & 63, wr = wid >> 2, wc = wid & 3, fr = lane & 15, fq = lane >> 4;
    int K_ = g.K; if constexpr (OPAQUE_K) asm volatile("" : "+s"(K_));
    const int K = K_, nt_all = K / BK;
    unsigned voffA[2], voffB[2];
#pragma unroll
    for (int i = 0; i < 2; ++i) { int R, C; stage_rc(tid * 16 + i * 8192, R, C); const int Rb = Epi::ADJ ? ((R >> 5) * 64 + perm32(R & 31)) : Epi::PERM ? ((R & ~31) + perm32(R & 31)) : R;
        voffA[i] = (unsigned)(R * K + C) * 2u; voffB[i] = (unsigned)(Rb * K + C) * 2u; }
    const size_t kstep = (size_t)(BK * 2);
    const size_t hstep = (size_t)HALF * K * 2;
    const size_t tstep = 2 * hstep;
    const size_t bh1 = Epi::ADJ ? (size_t)32 * K * 2 : hstep;
    const unsigned ldsw = (unsigned)wid * 1024u;
    const int aoff = lds_byte(wr * 64 + fr, fq * 8), boff = lds_byte(wc * 32 + fr, fq * 8);
#define PG8_SA(b, h) (((b) * 2 + (h)) * HTB)
#define PG8_SB(b, h) ((4 + (b) * 2 + (h)) * HTB)
#define PG8_STAGE(bufoff, gbase, voff) do { _Pragma("unroll") for (int _i = 0; _i < 2; ++_i) \
        __builtin_amdgcn_global_load_lds((const unsigned*)((const char*)(gbase) + (voff)[_i]), (PG8_LAS unsigned*)(lds + (bufoff) + ldsw + _i * 8192), 16, 0, 0); } while (0)
#define PG8_LDA(dst, b, h) do { _Pragma("unroll") for (int m = 0; m < 4; ++m) _Pragma("unroll") for (int k = 0; k < 2; ++k) dst[m][k] = *(const PG8_LAS bf16x8*)(lds + PG8_SA(b, h) + aoff + m * 2048 + k * 1024); } while (0)
#define PG8_LDB(dst, b, h) do { _Pragma("unroll") for (int n = 0; n < 2; ++n) _Pragma("unroll") for (int k = 0; k < 2; ++k) dst[n][k] = *(const PG8_LAS bf16x8*)(lds + PG8_SB(b, h) + boff + n * 2048 + k * 1024); } while (0)
#define PG8_MMA(ai, bj, At, Bt) do { __builtin_amdgcn_s_setprio(1); _Pragma("unroll") for (int m = 0; m < 4; ++m) _Pragma("unroll") for (int n = 0; n < 2; ++n) _Pragma("unroll") for (int k = 0; k < 2; ++k) \
        acc[ai][bj][m][n] = __builtin_amdgcn_mfma_f32_16x16x32_bf16(Bt[n][k], At[m][k], acc[ai][bj][m][n], 0, 0, 0); __builtin_amdgcn_s_setprio(0); } while (0)
#define PG8_WAIT_V(n) asm volatile("s_waitcnt vmcnt(" #n ")" ::: "memory")
#define PG8_WAIT_L(n) asm volatile("s_waitcnt lgkmcnt(" #n ")" ::: "memory")
#define PG8_BAR __builtin_amdgcn_s_barrier()
#define PG8_SCHED __builtin_amdgcn_sched_barrier(0)
    Unit cur, nxt; int ui = 0;
    if (!S.next(0, cur)) return;
    f32x4 acc[2][2][4][2];
#pragma unroll
    for (int a = 0; a < 2; ++a)
#pragma unroll
        for (int b = 0; b < 2; ++b)
#pragma unroll
            for (int m = 0; m < 4; ++m)
#pragma unroll
                for (int n = 0; n < 2; ++n) acc[a][b][m][n] = (f32x4){0.f, 0.f, 0.f, 0.f};
    bf16x8 At[4][2], B0[2][2], B1[2][2];
    int k0c, nt; S.krange(cur, nt_all, k0c, nt);
    const char* cA = (const char*)g.A + (size_t)cur.pm * tstep + (size_t)k0c * kstep; const char* cB = (const char*)g.Bt + (size_t)cur.pn * tstep + (size_t)k0c * kstep;
    S.a_ready(cur);
    if constexpr (SP2) {
        PG8_STAGE(PG8_SB(0, 0), cB, voffB); PG8_STAGE(PG8_SB(0, 1), cB + bh1, voffB); PG8_STAGE(PG8_SA(0, 0), cA, voffA); PG8_STAGE(PG8_SA(0, 1), cA + hstep, voffA);
        if (wr == 1) PG8_BAR;
        PG8_WAIT_V(2); PG8_BAR;
        PG8_STAGE(PG8_SB(1, 0), cB + kstep, voffB); PG8_STAGE(PG8_SA(1, 0), cA + kstep, voffA); PG8_STAGE(PG8_SB(1, 1), cB + bh1 + kstep, voffB);
        PG8_WAIT_V(6); PG8_BAR;
    } else {
        PG8_STAGE(PG8_SB(0, 0), cB, voffB); PG8_STAGE(PG8_SA(0, 0), cA, voffA); PG8_STAGE(PG8_SB(0, 1), cB + bh1, voffB); PG8_STAGE(PG8_SA(0, 1), cA + hstep, voffA);
        if (wr == 1) PG8_BAR;
        PG8_WAIT_V(4); PG8_BAR;
        PG8_STAGE(PG8_SB(1, 0), cB + kstep, voffB); PG8_STAGE(PG8_SA(1, 0), cA + kstep, voffA); PG8_STAGE(PG8_SB(1, 1), cB + bh1 + kstep, voffB);
        PG8_WAIT_V(6); PG8_BAR;
    }
    for (;;) {
        const bool has_next = S.next(ui + 1, nxt);
        int k0n = 0, ntn = nt; if (has_next) S.krange(nxt, nt_all, k0n, ntn);
        const char* nA = has_next ? (const char*)g.A + (size_t)nxt.pm * tstep + (size_t)k0n * kstep : cA; const char* nB = has_next ? (const char*)g.Bt + (size_t)nxt.pn * tstep + (size_t)k0n * kstep : cB;
        for (int t = 0; t < nt; t += 2) {
            if constexpr (Epi::MID_T > 0) { if (t == Epi::MID_T) E.mid(acc, cur, wr, wc, fr, fq); }
            const bool last = (t == nt - 2);
            const char* a1 = cA + (size_t)(t + 1) * kstep;
            const char* a2 = last ? nA : cA + (size_t)(t + 2) * kstep; const char* b2 = last ? nB : cB + (size_t)(t + 2) * kstep;
            const char* a3 = a2 + kstep; const char* b3 = b2 + kstep;
            if (last && has_next) S.a_ready(nxt);
            if constexpr (SP2) {
            PG8_LDB(B0, 0, 0); PG8_LDB(B1, 0, 1); PG8_SCHED; PG8_LDA(At, 0, 0); PG8_STAGE(PG8_SA(1, 1), a1 + hstep, voffA);
            PG8_WAIT_V(8); PG8_WAIT_L(0); PG8_BAR; PG8_MMA(0, 0, At, B0); PG8_MMA(0, 1, At, B1); PG8_BAR; PG8_SCHED;
            PG8_LDA(At, 0, 1); PG8_STAGE(PG8_SB(0, 0), b2, voffB); PG8_STAGE(PG8_SB(0, 1), b2 + bh1, voffB); PG8_STAGE(PG8_SA(0, 0), a2, voffA);
            PG8_WAIT_V(8); PG8_WAIT_L(0); PG8_BAR; PG8_MMA(1, 0, At, B0); PG8_MMA(1, 1, At, B1); PG8_BAR; PG8_SCHED;
            PG8_LDB(B0, 1, 0); PG8_LDB(B1, 1, 1); PG8_SCHED; PG8_LDA(At, 1, 0); PG8_STAGE(PG8_SA(0, 1), a2 + hstep, voffA);
            PG8_WAIT_V(8); PG8_WAIT_L(0); PG8_BAR; PG8_MMA(0, 0, At, B0); PG8_MMA(0, 1, At, B1); PG8_BAR; PG8_SCHED;
            PG8_LDA(At, 1, 1); PG8_STAGE(PG8_SB(1, 0), b3, voffB); PG8_STAGE(PG8_SB(1, 1), b3 + bh1, voffB); PG8_STAGE(PG8_SA(1, 0), a3, voffA);
            PG8_WAIT_V(8); PG8_WAIT_L(0); PG8_BAR; PG8_MMA(1, 0, At, B0); PG8_MMA(1, 1, At, B1); PG8_BAR; PG8_SCHED;
            } else {
            PG8_LDB(B0, 0, 0); PG8_SCHED; PG8_LDA(At, 0, 0); PG8_STAGE(PG8_SA(1, 1), a1 + hstep, voffA);
            PG8_WAIT_L(8); PG8_BAR; PG8_WAIT_L(0); PG8_MMA(0, 0, At, B0); PG8_BAR; PG8_SCHED;
            PG8_LDB(B1, 0, 1); PG8_STAGE(PG8_SB(0, 0), b2, voffB);
            PG8_BAR; PG8_WAIT_L(0); PG8_MMA(0, 1, At, B1); PG8_BAR;
            PG8_LDA(At, 0, 1); PG8_STAGE(PG8_SA(0, 0), a2, voffA);
            PG8_BAR; PG8_WAIT_L(0); PG8_MMA(1, 0, At, B0); PG8_BAR; PG8_SCHED;
            PG8_STAGE(PG8_SB(0, 1), b2 + bh1, voffB);
            PG8_WAIT_V(6); PG8_BAR; PG8_MMA(1, 1, At, B1); PG8_BAR;
            PG8_LDB(B0, 1, 0); PG8_SCHED; PG8_LDA(At, 1, 0); PG8_STAGE(PG8_SA(0, 1), a2 + hstep, voffA);
            PG8_WAIT_L(8); PG8_BAR; PG8_WAIT_L(0); PG8_MMA(0, 0, At, B0); PG8_BAR; PG8_SCHED;
            PG8_LDB(B1, 1, 1); PG8_STAGE(PG8_SB(1, 0), b3, voffB);
            PG8_BAR; PG8_WAIT_L(0); PG8_MMA(0, 1, At, B1); PG8_BAR;
            PG8_LDA(At, 1, 1); PG8_STAGE(PG8_SA(1, 0), a3, voffA);
            PG8_BAR; PG8_WAIT_L(0); PG8_MMA(1, 0, At, B0); PG8_BAR; PG8_SCHED;
            PG8_STAGE(PG8_SB(1, 1), b3 + bh1, voffB);
            PG8_WAIT_V(6); PG8_BAR; PG8_MMA(1, 1, At, B1); PG8_BAR;
            }
        }
        if constexpr (ALIGN_EPI) { if (wr == 0) PG8_BAR; }
        if constexpr (!Epi::AFTER_DRAIN) { E(acc, cur, wr, wc, fr, fq);
#if defined(PROBE_EPI2) && PROBE_EPI2
            if constexpr (Epi::IDEMP) { asm volatile("" ::: "memory"); E(acc, cur, wr, wc, fr, fq); }
#endif
            S.done(cur); }
        if (!has_next) break;
#pragma unroll
        for (int a = 0; a < 2; ++a)
#pragma unroll
            for (int b = 0; b < 2; ++b)
#pragma unroll
                for (int m = 0; m < 4; ++m)
#pragma unroll
                    for (int n = 0; n < 2; ++n) acc[a][b][m][n] = (f32x4){0.f, 0.f, 0.f, 0.f};
        cur = nxt; cA = nA; cB = nB; nt = ntn; ++ui;
        if constexpr (ALIGN_EPI) { if (wr == 1) PG8_BAR; }
    }
    PG8_WAIT_V(0);
    if constexpr (!ALIGN_EPI) { if (wr == 0) PG8_BAR; }
    PG8_BAR;
    if constexpr (Epi::AFTER_DRAIN) { E.fused(acc, cur, wr, wc, fr, fq, lds, wid, lane); S.done(cur); }
#undef PG8_SA
#undef PG8_SB
#undef PG8_STAGE
#undef PG8_LDA
#undef PG8_LDB
#undef PG8_MMA
#undef PG8_WAIT_V
#undef PG8_WAIT_L
#undef PG8_BAR
#undef PG8_SCHED
}
}

#ifndef PG8_SP2
#define PG8_SP2 true
#endif
#ifndef PG8_ALIGN
#define PG8_ALIGN true
#endif
namespace mla {
#define MLA_LAS __attribute__((address_space(3)))
using bf16x8 = __attribute__((ext_vector_type(8))) short;
using s16x4  = __attribute__((ext_vector_type(4))) short;
using f32x16 = __attribute__((ext_vector_type(16))) float;
using u32x4  = __attribute__((ext_vector_type(4))) unsigned;
using u32x2  = __attribute__((ext_vector_type(2))) unsigned;
using f32x4v = __attribute__((ext_vector_type(4))) float;
typedef unsigned short bf16_t;
constexpr int NW = 8, QBLK = 32, KVBLK = 64, DQK = 96, DV = 64, SEQ = 4096, NHEAD = 8;
constexpr int LDQ = 1792, LDO = 768, LDKR = 32, KOFF = 768, HSTRIDE = 128;
constexpr float SCALE = 0.10206207261596575f;
constexpr float THR = 8.f;
constexpr int SHM_V = KVBLK * DV * 2, SHM_K = KVBLK * 256, SHM_ATTN = 2 * SHM_V + 2 * SHM_K + NW * 64 * 4;
#define MLA_KSWZ(row, colB) ((row) * 256 + ((colB) ^ (((row) & 15) << 4)))
#define MLA_SBAR() __builtin_amdgcn_sched_barrier(0)
__device__ __forceinline__ int crow(int r, int hi) { return (r & 3) + 8 * (r >> 2) + 4 * hi; }
__device__ __forceinline__ unsigned cvtpk(float lo, float hi) { unsigned r; asm volatile("v_cvt_pk_bf16_f32 %0, %1, %2" : "=v"(r) : "v"(lo), "v"(hi)); return r; }
__device__ __forceinline__ unsigned pair_pack(float e, float f, bool odd) {
  const float send = odd ? e : f;
  const float recv = __uint_as_float((unsigned)__builtin_amdgcn_update_dpp(0, (int)__float_as_uint(send), 0xB1  , 0xf, 0xf, true));
  return odd ? cvtpk(recv, f) : cvtpk(e, recv);
}

constexpr float THR2 = THR * 1.4426950408889634f, THR0 = 16.0f;
template <bool FIRST>
__device__ __forceinline__ void partialSM(f32x16& p0, f32x16& p1, float& m_reg, bool& zref, float& alpha, float& l_reg) {
  if (!FIRST && !zref) {
#pragma unroll
    for (int r = 0; r < 16; ++r) { p0[r] -= m_reg; p1[r] -= m_reg; } }
  float pmax = p0[0];
#pragma unroll
  for (int r = 1; r < 16; ++r) pmax = fmaxf(pmax, p0[r]);
#pragma unroll
  for (int r = 0; r < 16; ++r) pmax = fmaxf(pmax, p1[r]);
  { auto rr = __builtin_amdgcn_permlane32_swap(__float_as_uint(pmax), __float_as_uint(pmax), false, false);
    pmax = fmaxf(__uint_as_float(rr[0]), __uint_as_float(rr[1])); }
  alpha = 1.f;
  if (FIRST ? !__builtin_expect(__all(fabsf(pmax) <= THR0), 1) : !__builtin_expect(__all(pmax <= THR2), 1)) {
    const float dl = FIRST ? pmax : fmaxf(pmax, 0.f);
    m_reg += dl; alpha = FIRST ? 1.f : __builtin_amdgcn_exp2f(-dl);
    l_reg *= alpha;
#pragma unroll
    for (int r = 0; r < 16; ++r) { p0[r] -= dl; p1[r] -= dl; }
    zref = zref && __all(m_reg == 0.f);
  }
#pragma unroll
  for (int r = 0; r < 16; ++r) p0[r] = __builtin_amdgcn_exp2f(p0[r]);
}
__device__ __forceinline__ void finishSM(f32x16& p0, f32x16& p1, float& l_reg, bf16x8& pa0, bf16x8& pa1, bf16x8& pa2, bf16x8& pa3) {
#pragma unroll
  for (int r = 0; r < 16; ++r) p1[r] = __builtin_amdgcn_exp2f(p1[r]);
  typedef float f32x2s __attribute__((ext_vector_type(2)));
  f32x2s sa = {0.f, 0.f}, sb = {0.f, 0.f};
#pragma unroll
  for (int r = 0; r < 16; r += 4) { sa += (f32x2s){p0[r], p0[r + 1]}; sb += (f32x2s){p0[r + 2], p0[r + 3]}; }
#pragma unroll
  for (int r = 0; r < 16; r += 4) { sa += (f32x2s){p1[r], p1[r + 1]}; sb += (f32x2s){p1[r + 2], p1[r + 3]}; }
  sa += sb; l_reg += sa.x + sa.y;
#define MLA_PK4(P, BASE, OUT) do { unsigned a0 = cvtpk(P[BASE + 0], P[BASE + 1]), a1 = cvtpk(P[BASE + 2], P[BASE + 3]);   \
    unsigned b0 = cvtpk(P[BASE + 4], P[BASE + 5]), b1 = cvtpk(P[BASE + 6], P[BASE + 7]);                              \
    u32x4 w = {a0, a1, b0, b1}; OUT = __builtin_bit_cast(bf16x8, w); } while (0)
  MLA_PK4(p0, 0, pa0); MLA_PK4(p0, 8, pa1); MLA_PK4(p1, 0, pa2); MLA_PK4(p1, 8, pa3);
#undef MLA_PK4
}
__device__ __forceinline__ void qkt(f32x16& p0, f32x16& p1, const MLA_LAS char* Ks, const bf16x8* qr, int r32, int hi) {
#pragma unroll
  for (int d0 = 0; d0 < DQK / 16; ++d0) { const int cb = (d0 * 16 + hi * 8) * 2;
    const bf16x8 b0 = *reinterpret_cast<const MLA_LAS bf16x8*>(Ks + MLA_KSWZ(r32, cb));
    const bf16x8 b1 = *reinterpret_cast<const MLA_LAS bf16x8*>(Ks + MLA_KSWZ(32 + r32, cb));
    if (d0 == 0) { p0 = __builtin_amdgcn_mfma_f32_32x32x16_bf16(b0, qr[0], f32x16{}, 0, 0, 0); p1 = __builtin_amdgcn_mfma_f32_32x32x16_bf16(b1, qr[0], f32x16{}, 0, 0, 0); }
    else { p0 = __builtin_amdgcn_mfma_f32_32x32x16_bf16(b0, qr[d0], p0, 0, 0, 0); p1 = __builtin_amdgcn_mfma_f32_32x32x16_bf16(b1, qr[d0], p1, 0, 0, 0); }
  }
}
struct KPre { bf16x8 f[6]; };
__device__ __forceinline__ void kpre_load(KPre& kp, const MLA_LAS char* Ks, int r32, int hi) {
#pragma unroll
  for (int d0 = 0; d0 < 6; ++d0) kp.f[d0] = *reinterpret_cast<const MLA_LAS bf16x8*>(Ks + MLA_KSWZ(32 + r32, (d0 * 16 + hi * 8) * 2));
}
__device__ __forceinline__ void qkt_pre(f32x16& p0, f32x16& p1, const MLA_LAS char* Ks, const bf16x8* qr, int r32, int hi, const KPre& kp) {
#define MLA_KF(row, d0) (*reinterpret_cast<const MLA_LAS bf16x8*>(Ks + MLA_KSWZ((row) + r32, ((d0) * 16 + hi * 8) * 2)))
#define MLA_PIN() __builtin_amdgcn_sched_barrier(0x6)
  const bf16x8 a0 = MLA_KF(0, 0), a1 = MLA_KF(0, 1), a2 = MLA_KF(0, 2), a3 = MLA_KF(0, 3);
  MLA_PIN();
  p1 = __builtin_amdgcn_mfma_f32_32x32x16_bf16(kp.f[0], qr[0], f32x16{}, 0, 0, 0);
  p1 = __builtin_amdgcn_mfma_f32_32x32x16_bf16(kp.f[1], qr[1], p1, 0, 0, 0);
  p1 = __builtin_amdgcn_mfma_f32_32x32x16_bf16(kp.f[2], qr[2], p1, 0, 0, 0);
  p1 = __builtin_amdgcn_mfma_f32_32x32x16_bf16(kp.f[3], qr[3], p1, 0, 0, 0);
  p1 = __builtin_amdgcn_mfma_f32_32x32x16_bf16(kp.f[4], qr[4], p1, 0, 0, 0);
  p1 = __builtin_amdgcn_mfma_f32_32x32x16_bf16(kp.f[5], qr[5], p1, 0, 0, 0);
  MLA_PIN();
  const bf16x8 a4 = MLA_KF(0, 4), a5 = MLA_KF(0, 5);
  MLA_PIN();
  p0 = __builtin_amdgcn_mfma_f32_32x32x16_bf16(a0, qr[0], f32x16{}, 0, 0, 0);
  p0 = __builtin_amdgcn_mfma_f32_32x32x16_bf16(a1, qr[1], p0, 0, 0, 0);
  p0 = __builtin_amdgcn_mfma_f32_32x32x16_bf16(a2, qr[2], p0, 0, 0, 0);
  p0 = __builtin_amdgcn_mfma_f32_32x32x16_bf16(a3, qr[3], p0, 0, 0, 0);
  p0 = __builtin_amdgcn_mfma_f32_32x32x16_bf16(a4, qr[4], p0, 0, 0, 0);
  p0 = __builtin_amdgcn_mfma_f32_32x32x16_bf16(a5, qr[5], p0, 0, 0, 0);
#undef MLA_KF
#undef MLA_PIN
}
__device__ __forceinline__ int v_st(int k, int c) { const int kk = k; return ((kk >> 3) * 2 + (c >> 5)) * 512 + ((kk & 7) * 32 + (c & 31)) * 2; }
__device__ __forceinline__ int v_rd_base(int lane) { return ((lane & 3) << 3) | (((lane >> 2) & 3) << 6) | (((lane >> 4) & 1) << 5) | (((lane >> 5) & 1) << 8); }
constexpr int v_rd_off(int d0, int ks, int half) { return d0 * 512 + ks * 2048 + half * 1024; }
typedef short v4i16_t __attribute__((ext_vector_type(4)));
__device__ __forceinline__ s16x4 vtr(const MLA_LAS char* p) { return __builtin_bit_cast(s16x4, __builtin_amdgcn_ds_read_tr16_b64_v4i16((MLA_LAS v4i16_t*)p)); }
template <int D0> __device__ __forceinline__ void pv_one_b(f32x16& od, const MLA_LAS char* vp, bf16x8 pa0, bf16x8 pa1, bf16x8 pa2, bf16x8 pa3) {
  const s16x4 l0 = vtr(vp + v_rd_off(D0, 0, 0)), h0 = vtr(vp + v_rd_off(D0, 0, 1)), l1 = vtr(vp + v_rd_off(D0, 1, 0)), h1 = vtr(vp + v_rd_off(D0, 1, 1));
  const s16x4 l2 = vtr(vp + v_rd_off(D0, 2, 0)), h2 = vtr(vp + v_rd_off(D0, 2, 1)), l3 = vtr(vp + v_rd_off(D0, 3, 0)), h3 = vtr(vp + v_rd_off(D0, 3, 1));
#define MLA_PKB(L, H) (bf16x8){L[0], L[1], L[2], L[3], H[0], H[1], H[2], H[3]}
  od = __builtin_amdgcn_mfma_f32_32x32x16_bf16(pa0, MLA_PKB(l0, h0), od, 0, 0, 0);
  od = __builtin_amdgcn_mfma_f32_32x32x16_bf16(pa1, MLA_PKB(l1, h1), od, 0, 0, 0);
  od = __builtin_amdgcn_mfma_f32_32x32x16_bf16(pa2, MLA_PKB(l2, h2), od, 0, 0, 0);
  od = __builtin_amdgcn_mfma_f32_32x32x16_bf16(pa3, MLA_PKB(l3, h3), od, 0, 0, 0);
#undef MLA_PKB
}
__device__ __forceinline__ void pv_d0_b(f32x16* o, const MLA_LAS char* vp, bf16x8 pa0, bf16x8 pa1, bf16x8 pa2, bf16x8 pa3) {
  pv_one_b<0>(o[0], vp, pa0, pa1, pa2, pa3); pv_one_b<1>(o[1], vp, pa0, pa1, pa2, pa3);
}
__device__ __forceinline__ unsigned short f2bf_rne(float f) { unsigned u = __builtin_bit_cast(unsigned, f); return (unsigned short)((u + 0x7fffu + ((u >> 16) & 1u)) >> 16); }

#ifndef MLA_FORCE_SAFE
#define MLA_FORCE_SAFE 0
#endif
template <bool FAST>
__device__ __forceinline__ bool attn_unit_stag(const bf16_t* __restrict__ QKVM, const bf16_t* __restrict__ KR, bf16_t* __restrict__ OB, const float* __restrict__ ROPEM, int b, int h, int q0, MLA_LAS char* lds) {
  const int tid = threadIdx.x, wid = __builtin_amdgcn_readfirstlane(tid >> 6), lane = tid & 63, r32 = lane & 31, hi = lane >> 5, grp = wid >> 2;
  MLA_LAS char* V_lds = lds; MLA_LAS char* K_lds = lds + 2 * SHM_V;
  MLA_LAS float* ws = (MLA_LAS float*)(lds + 2 * SHM_V + 2 * SHM_K) + wid * 64; MLA_LAS float* li_l = ws; MLA_LAS float* al_l = ws + 32;
  const long tok0 = (long)b * SEQ;
  float m_reg = 0.f, l_reg = 0; f32x16 o[2] = {}; bf16x8 qr[6];
  const bf16_t* Qw = QKVM + (tok0 + q0 + wid * QBLK + r32) * LDQ + h * DQK + hi * 8;
#pragma unroll
  for (int d0 = 0; d0 < 6; ++d0) qr[d0] = *reinterpret_cast<const bf16x8*>(Qw + d0 * 16);
  { const float* rp = ROPEM + (tok0 + q0 + wid * QBLK + r32) * 32 + 8 * hi;
    const f32x4v c0 = *reinterpret_cast<const f32x4v*>(rp), c1 = *reinterpret_cast<const f32x4v*>(rp + 4), s0 = *reinterpret_cast<const f32x4v*>(rp + 16), s1 = *reinterpret_cast<const f32x4v*>(rp + 20);
#pragma unroll
    for (int j = 0; j < 8; ++j) { const float cs = j < 4 ? c0[j & 3] : c1[j & 3], sn = j < 4 ? s0[j & 3] : s1[j & 3];
      const float t1 = __uint_as_float((unsigned)(unsigned short)qr[4][j] << 16), t2 = __uint_as_float((unsigned)(unsigned short)qr[5][j] << 16);
      qr[4][j] = (short)f2bf_rne(t1 * cs - t2 * sn); qr[5][j] = (short)f2bf_rne(t2 * cs + t1 * sn); } }
  const int sr = tid >> 3, sc8 = tid & 7;
  const int vst = v_st(sr, sc8 * 8), kst = MLA_KSWZ(sr, sc8 * 16), krst = MLA_KSWZ(sr, 128 + sc8 * 8);
  const bf16_t* Kg = QKVM + (tok0 + sr) * LDQ + KOFF + h * HSTRIDE + sc8 * 8;
  const bf16_t* KRg = KR + (tok0 + sr) * LDKR + sc8 * 4;
  const int vrb = v_rd_base(lane);
  constexpr int NT = SEQ / KVBLK;
  struct StageSet { bf16x8 ks, vs; u32x2 kr; };
  StageSet sE, sO;
  sE.ks = bf16x8{}; sE.vs = bf16x8{}; sE.kr = u32x2{}; sO = sE;
#define STG_LOAD(S, w) do { if ((w) < NT) { S.ks = *reinterpret_cast<const bf16x8*>(Kg + (long)(w) * KVBLK * LDQ); S.kr = *reinterpret_cast<const u32x2*>(KRg + (long)(w) * KVBLK * LDKR); } \
    if ((w) >= 1) S.vs = *reinterpret_cast<const bf16x8*>(Kg + (long)((w) - 1) * KVBLK * LDQ + 64); } while (0)
#define STG_WRITE(S, w) do { const int sl_ = (w) & 1; if ((w) < NT) { *(MLA_LAS bf16x8*)(K_lds + sl_ * SHM_K + kst) = S.ks; *(MLA_LAS u32x2*)(K_lds + sl_ * SHM_K + krst) = S.kr; } \
    if ((w) >= 1) *(MLA_LAS bf16x8*)(V_lds + sl_ * SHM_V + vst) = S.vs; } while (0)
#define STG_RESC(a) do { if (__any((a) < 1.f)) { if (hi == 0) al_l[r32] = (a); asm volatile("s_waitcnt lgkmcnt(0)" ::: "memory"); \
    _Pragma("unroll") for (int d = 0; d < 2; ++d) _Pragma("unroll") for (int r = 0; r < 16; ++r) o[d][r] *= al_l[crow(r, hi)]; } } while (0)
  f32x16 pA0 = f32x16{}, pA1 = f32x16{}, pB0 = f32x16{}, pB1 = f32x16{};
  float alpha = 1.f; bf16x8 pa0 = bf16x8{}, pa1 = bf16x8{}, pa2 = bf16x8{}, pa3 = bf16x8{};
  KPre kp;
  bool zref = true;
#define STG_XQ(u, C0, C1) do { __builtin_amdgcn_s_setprio(1); qkt(C0, C1, K_lds + ((u) & 1) * SHM_K, qr, r32, hi); __builtin_amdgcn_s_setprio(0); } while (0)
#define STG_XQF(u, C0, C1, P0, P1) do { __builtin_amdgcn_s_setprio(1); qkt_pre(C0, C1, K_lds + ((u) & 1) * SHM_K, qr, r32, hi, kp); \
    finishSM(P0, P1, l_reg, pa0, pa1, pa2, pa3); pv_d0_b(o, V_lds + ((u) & 1) * SHM_V + vrb, pa0, pa1, pa2, pa3); __builtin_amdgcn_s_setprio(0); } while (0)
#define STG_XF(u, P0, P1) do { __builtin_amdgcn_s_setprio(1); finishSM(P0, P1, l_reg, pa0, pa1, pa2, pa3); pv_d0_b(o, V_lds + ((u) & 1) * SHM_V + vrb, pa0, pa1, pa2, pa3); __builtin_amdgcn_s_setprio(0); } while (0)
#define STG_STAGE(S, w) do { STG_WRITE(S, w); if ((w) + 2 <= NT) STG_LOAD(S, (w) + 2); } while (0)
#define STG_STAGE_U(S, w) do { const int sl_ = (w) & 1; *(MLA_LAS bf16x8*)(K_lds + sl_ * SHM_K + kst) = S.ks; *(MLA_LAS u32x2*)(K_lds + sl_ * SHM_K + krst) = S.kr; *(MLA_LAS bf16x8*)(V_lds + sl_ * SHM_V + vst) = S.vs; \
    S.ks = *reinterpret_cast<const bf16x8*>(Kg + (long)((w) + 2) * KVBLK * LDQ); S.kr = *reinterpret_cast<const u32x2*>(KRg + (long)((w) + 2) * KVBLK * LDKR); S.vs = *reinterpret_cast<const bf16x8*>(Kg + (long)((w) + 1) * KVBLK * LDQ + 64); } while (0)
#define STG_SM(FIRST, P0, P1, un) do { if constexpr (FAST) { _Pragma("unroll") for (int r_ = 0; r_ < 16; ++r_) P0[r_] = __builtin_amdgcn_exp2f(P0[r_]); } \
    else { partialSM<FIRST>(P0, P1, m_reg, zref, alpha, l_reg); STG_RESC(alpha); } kpre_load(kp, K_lds + ((un) & 1) * SHM_K, r32, hi); } while (0)
  STG_LOAD(sE, 0); STG_WRITE(sE, 0); STG_LOAD(sO, 1); STG_LOAD(sE, 2); __syncthreads();
  if (grp == 0) {
    STG_XQ(0, pA0, pA1);                                     __syncthreads();
    STG_STAGE(sO, 1); STG_SM(true, pA0, pA1, 1);             __syncthreads();
    STG_XQF(1, pB0, pB1, pA0, pA1);                          __syncthreads();
    STG_STAGE(sE, 2); STG_SM(false, pB0, pB1, 2);            __syncthreads();
#define STG_IT0(i, STAGE) do { STG_XQF(i, pA0, pA1, pB0, pB1); __syncthreads(); STAGE(sO, (i) + 1); STG_SM(false, pA0, pA1, (i) + 1); __syncthreads(); \
      STG_XQF((i) + 1, pB0, pB1, pA0, pA1); __syncthreads(); STAGE(sE, (i) + 2); STG_SM(false, pB0, pB1, (i) + 2); __syncthreads(); } while (0)
#pragma unroll 1
    for (int i = 2; i < NT - 4; i += 2) STG_IT0(i, STG_STAGE_U);
    STG_IT0(NT - 4, STG_STAGE); STG_IT0(NT - 2, STG_STAGE);
#undef STG_IT0
    STG_XF(NT, pB0, pB1);                                    __syncthreads();
                                                             __syncthreads();
  } else {
    STG_STAGE(sO, 1);                                        __syncthreads();
    STG_XQ(0, pA0, pA1);                                     __syncthreads();
    STG_STAGE(sE, 2); STG_SM(true, pA0, pA1, 1);             __syncthreads();
    STG_XQF(1, pB0, pB1, pA0, pA1);                          __syncthreads();
#define STG_IT1(i, STAGE) do { STAGE(sO, (i) + 1); STG_SM(false, pB0, pB1, (i)); __syncthreads(); STG_XQF(i, pA0, pA1, pB0, pB1); __syncthreads(); \
      STAGE(sE, (i) + 2); STG_SM(false, pA0, pA1, (i) + 1); __syncthreads(); STG_XQF((i) + 1, pB0, pB1, pA0, pA1); __syncthreads(); } while (0)
#pragma unroll 1
    for (int i = 2; i < NT - 4; i += 2) STG_IT1(i, STG_STAGE_U);
    STG_IT1(NT - 4, STG_STAGE); STG_IT1(NT - 2, STG_STAGE);
#undef STG_IT1
    STG_SM(false, pB0, pB1, NT);                             __syncthreads();
    STG_XF(NT, pB0, pB1);                                    __syncthreads();
  }
  { auto rr = __builtin_amdgcn_permlane32_swap(__float_as_uint(l_reg), __float_as_uint(l_reg), false, false); l_reg = __uint_as_float(rr[0]) + __uint_as_float(rr[1]); }
  bool unit_ok = true;
  if constexpr (FAST) {
    MLA_LAS unsigned* okf = (MLA_LAS unsigned*)(lds + SHM_ATTN);
    const bool okw = !MLA_FORCE_SAFE && __all(l_reg >= 0x1p-80f && l_reg <= 0x1p80f);
    if (lane == 0) okf[wid] = okw ? 1u : 0u;
    asm volatile("s_waitcnt lgkmcnt(0)" ::: "memory"); __syncthreads();
    unsigned acc_ok = 1u;
#pragma unroll
    for (int w = 0; w < NW; ++w) acc_ok &= okf[w];
    unit_ok = __builtin_amdgcn_readfirstlane(acc_ok) != 0u;
  }
  if (hi == 0) li_l[r32] = l_reg; asm volatile("s_waitcnt lgkmcnt(0)" ::: "memory");
  float rli[16];
#pragma unroll
  for (int r = 0; r < 16; ++r) rli[r] = __builtin_amdgcn_rcpf(li_l[crow(r, hi)]);
  bf16_t* Ow = OB + (tok0 + q0 + wid * QBLK) * LDO + h * DV;
#pragma unroll
  for (int r = 0; r < 16; r += 2) { const bool odd = (r32 & 1) != 0; const int orow = crow(r, hi) + (odd ? 1 : 0);
#pragma unroll
    for (int d0 = 0; d0 < 2; ++d0) *reinterpret_cast<unsigned*>(Ow + (long)orow * LDO + d0 * 32 + (r32 & ~1)) = pair_pack(o[d0][r] * rli[r], o[d0][r + 1] * rli[r + 1], odd); }
#undef STG_LOAD
#undef STG_WRITE
#undef STG_RESC
#undef STG_XQ
#undef STG_XQF
#undef STG_XF
#undef STG_STAGE
#undef STG_STAGE_U
#undef STG_SM
  return unit_ok;
}
}


#ifndef DIL_FORCE_SAFE
#define DIL_FORCE_SAFE 0
#endif
namespace dil2 {
using mla::bf16x8; using mla::s16x4; using mla::f32x16; using mla::u32x4; using mla::crow; using mla::cvtpk; using mla::v_st; using mla::v_rd_base; using mla::v_rd_off;
typedef unsigned short bf16_t;
constexpr int LDD = 2304, SEQ = 4096, MTOK = 8 * 4096;
constexpr float C = 0.125f * 1.4426950408889634f;
constexpr int NKT = 12, TB = 4096, LDS_K = 0, LDS_V = NKT * TB, LDS_SCR = 2 * NKT * TB, LDS_BYTES = LDS_SCR + 8 * 256;
constexpr int NSTEPS = 8 * 3 * 4 * 16;
struct Step { int b, g, hs, r, i0; };
__device__ __forceinline__ Step decode(int sidx) { Step S; const int st = sidx & 15; S.hs = (sidx >> 4) & 3; const int bg = sidx >> 6; S.g = bg % 3; S.b = bg / 3;
  const int sh = 2 * S.g; S.r = st >> (4 - sh); S.i0 = 8 * (st & ((16 >> sh) - 1)); return S; }
struct KV { u32x4 k[6], v[6]; };
__device__ __forceinline__ void kv_load(KV& R, const bf16_t* __restrict__ DQ, const Step& S, int tid) {
  const int sh = 2 * S.g, dil = 1 << sh, nb32 = (SEQ >> sh) >> 5;
  const int row = (tid >> 3) & 31, chunk = tid & 7; const long rowbase = (long)S.b * SEQ;
  const int hk = 12 + S.g * 4 + S.hs;
  const int kcol = chunk < 2 ? 16 * hk + 8 * chunk : 384 + 48 * hk + 8 * (chunk - 2), vcol = 1536 + (S.g * 4 + S.hs) * 64 + chunk * 8;
#pragma unroll
  for (int j = 0; j < 6; ++j) { const int kt = 2 * j + (tid >> 8); int ti = S.i0 - 2 + kt; ti = ti < 0 ? 0 : (ti >= nb32 ? nb32 - 1 : ti);
    const bf16_t* p = DQ + (rowbase + S.r + (long)dil * (32 * ti + row)) * LDD;
    R.k[j] = *reinterpret_cast<const u32x4*>(p + kcol); R.v[j] = *reinterpret_cast<const u32x4*>(p + vcol); }
}
__device__ __forceinline__ void kv_write(const KV& R, MLA_LAS char* lds, int tid) {
  const int row = (tid >> 3) & 31, chunk = tid & 7;
  const int ko = row * 128 + ((chunk ^ ((row >> 1) & 7)) << 4), vo = v_st(row, chunk * 8);
#pragma unroll
  for (int j = 0; j < 6; ++j) { const int kt = 2 * j + (tid >> 8);
    *(MLA_LAS u32x4*)(lds + LDS_K + kt * TB + ko) = R.k[j]; *(MLA_LAS u32x4*)(lds + LDS_V + kt * TB + vo) = R.v[j]; }
}
template <bool USE_MAX>
__device__ __forceinline__ bool block(const bf16_t* __restrict__ DQ, bf16_t* __restrict__ PART, float* __restrict__ LSE, const Step& S, int w, MLA_LAS char* lds, int lane) {
  const int r32 = lane & 31, hi = lane >> 5;
  const int sh = 2 * S.g, dil = 1 << sh, nb32 = (SEQ >> sh) >> 5;
  const int i = S.i0 + w; const long rowbase = (long)S.b * SEQ;
  const long tq = rowbase + S.r + (long)dil * (32 * i + r32);
  const int hq = S.g * 4 + S.hs; const bf16_t* Qrow = DQ + tq * LDD + hi * 8;
  bf16x8 qf[4];
  qf[0] = *reinterpret_cast<const bf16x8*>(Qrow + 16 * hq);
#pragma unroll
  for (int d0 = 1; d0 < 4; ++d0) qf[d0] = *reinterpret_cast<const bf16x8*>(Qrow + 384 + 48 * hq + 16 * (d0 - 1));
  MLA_LAS float* scr = (MLA_LAS float*)(lds + LDS_SCR + w * 256);
  const int ksw = (r32 >> 1) & 7;
  f32x16 p[5]; bool vld[5]; float mx = 0.f, ls = 0.f;
  { constexpr bool use_max = USE_MAX;
#pragma unroll
    for (int kb = 0; kb < 5; ++kb) { const int ti = i - 2 + kb; vld[kb] = (ti >= 0) && (ti < nb32);
      const MLA_LAS char* kt = lds + LDS_K + (w + kb) * TB + r32 * 128;
      p[kb] = f32x16{};
#pragma unroll
      for (int d0 = 0; d0 < 4; ++d0) { const bf16x8 kf = *reinterpret_cast<const MLA_LAS bf16x8*>(kt + (((2 * d0 + hi) ^ ksw) << 4));
        p[kb] = __builtin_amdgcn_mfma_f32_32x32x16_bf16(kf, qf[d0], p[kb], 0, 0, 0); } }
#pragma unroll
    for (int kb = 0; kb < 5; ++kb)
#pragma unroll
      for (int rr = 0; rr < 16; ++rr) { bool ok = vld[kb]; if (kb == 0) ok = ok && (crow(rr, hi) >= r32); if (kb == 4) ok = ok && (crow(rr, hi) <= r32);
        p[kb][rr] = ok ? p[kb][rr] : -1e30f; }
    mx = 0.f;
    if constexpr (use_max) {
      mx = -1e30f;
#pragma unroll
      for (int kb = 0; kb < 5; ++kb)
#pragma unroll
        for (int rr = 0; rr < 16; ++rr) mx = fmaxf(mx, p[kb][rr]);
      { auto sw = __builtin_amdgcn_permlane32_swap(__float_as_uint(mx), __float_as_uint(mx), false, false); mx = fmaxf(__uint_as_float(sw[0]), __uint_as_float(sw[1])); }
#pragma unroll
      for (int kb = 0; kb < 5; ++kb)
#pragma unroll
        for (int rr = 0; rr < 16; ++rr) p[kb][rr] -= mx;
    }
    ls = 0.f;
#pragma unroll
    for (int kb = 0; kb < 5; ++kb)
#pragma unroll
      for (int rr = 0; rr < 16; ++rr) { const float e = __builtin_amdgcn_exp2f(p[kb][rr]); p[kb][rr] = e; ls += e; }
    { auto sw = __builtin_amdgcn_permlane32_swap(__float_as_uint(ls), __float_as_uint(ls), false, false); ls = __uint_as_float(sw[0]) + __uint_as_float(sw[1]); }
  }
  if (!USE_MAX) { if (DIL_FORCE_SAFE || !__all(ls >= 0x1p-80f && ls <= 0x1p80f)) return false; }
  bf16x8 pa[10];
#define DIL2_PK4(P, BASE, OUT) do { unsigned a0 = cvtpk(P[BASE + 0], P[BASE + 1]), a1 = cvtpk(P[BASE + 2], P[BASE + 3]);   \
    unsigned b0 = cvtpk(P[BASE + 4], P[BASE + 5]), b1 = cvtpk(P[BASE + 6], P[BASE + 7]);                              \
    u32x4 wv = {a0, a1, b0, b1}; OUT = __builtin_bit_cast(bf16x8, wv); } while (0)
#pragma unroll
  for (int kb = 0; kb < 5; ++kb) { DIL2_PK4(p[kb], 0, pa[2 * kb]); DIL2_PK4(p[kb], 8, pa[2 * kb + 1]); }
#undef DIL2_PK4
  f32x16 od[2] = {};
  const MLA_LAS char* vbase = lds + LDS_V + v_rd_base(lane);
#pragma unroll
  for (int kb = 0; kb < 5; ++kb) { const MLA_LAS char* vb = vbase + (w + kb) * TB;
#define DIL2_PK(L_, H_) (bf16x8){L_[0], L_[1], L_[2], L_[3], H_[0], H_[1], H_[2], H_[3]}
    const s16x4 l0 = mla::vtr(vb + v_rd_off(0, 0, 0)), h0 = mla::vtr(vb + v_rd_off(0, 0, 1)), l1 = mla::vtr(vb + v_rd_off(0, 1, 0)), h1 = mla::vtr(vb + v_rd_off(0, 1, 1));
    const s16x4 l2 = mla::vtr(vb + v_rd_off(1, 0, 0)), h2 = mla::vtr(vb + v_rd_off(1, 0, 1)), l3 = mla::vtr(vb + v_rd_off(1, 1, 0)), h3 = mla::vtr(vb + v_rd_off(1, 1, 1));
    od[0] = __builtin_amdgcn_mfma_f32_32x32x16_bf16(pa[2 * kb], DIL2_PK(l0, h0), od[0], 0, 0, 0);
    od[0] = __builtin_amdgcn_mfma_f32_32x32x16_bf16(pa[2 * kb + 1], DIL2_PK(l1, h1), od[0], 0, 0, 0);
    od[1] = __builtin_amdgcn_mfma_f32_32x32x16_bf16(pa[2 * kb], DIL2_PK(l2, h2), od[1], 0, 0, 0);
    od[1] = __builtin_amdgcn_mfma_f32_32x32x16_bf16(pa[2 * kb + 1], DIL2_PK(l3, h3), od[1], 0, 0, 0);
#undef DIL2_PK
  }
  if (hi == 0) { scr[r32] = ls; LSE[((long)S.g * MTOK + tq) * 4 + S.hs] = mx + __builtin_amdgcn_logf(ls); }
  asm volatile("s_waitcnt lgkmcnt(0)" ::: "memory");
  float rli[16];
#pragma unroll
  for (int rr = 0; rr < 16; ++rr) rli[rr] = __builtin_amdgcn_rcpf(scr[crow(rr, hi)]);
  bf16_t* Pw = PART + ((long)S.g * MTOK + rowbase + S.r + (long)dil * (32 * i)) * 256 + S.hs * 64 + r32;
#pragma unroll
  for (int rr = 0; rr < 16; rr += 2) { const bool odd = (r32 & 1) != 0; const long ro = (long)dil * (crow(rr, hi) + (odd ? 1 : 0)) * 256 - (odd ? 1 : 0);
#pragma unroll
    for (int d0 = 0; d0 < 2; ++d0) *reinterpret_cast<unsigned*>(Pw + ro + d0 * 32) = mla::pair_pack(od[d0][rr] * rli[rr], od[d0][rr + 1] * rli[rr + 1], odd); }
  return true;
}
}

#define GAS __attribute__((address_space(1)))
#define LAS __attribute__((address_space(3)))
typedef unsigned short bf16;
typedef unsigned v4u __attribute__((ext_vector_type(4)));
typedef float f32x4 __attribute__((ext_vector_type(4)));
typedef short bf16x8 __attribute__((ext_vector_type(8)));
typedef GAS unsigned gu32;
typedef GAS unsigned long long gu64;
#define RLX_AGENT __ATOMIC_RELAXED, __HIP_MEMORY_SCOPE_AGENT
#define LDS_WAIT() asm volatile("s_waitcnt lgkmcnt(0)" ::: "memory")
#define VM_WAIT() asm volatile("s_waitcnt vmcnt(0)" ::: "memory")
__device__ __forceinline__ unsigned long long rt() { return __builtin_amdgcn_s_memrealtime(); }
__device__ __forceinline__ unsigned f2bf(float f) { unsigned u = __builtin_bit_cast(unsigned, f); return (u + 0x7fffu + ((u >> 16) & 1u)) >> 16; }
__device__ __forceinline__ unsigned pk2(float lo, float hi) { return f2bf(lo) | (f2bf(hi) << 16); }

#define XB_TMO      128
#define XB_XCNT(j)  (256  + 64 * (j))
#define XB_XSUB(j)  (1280 + 64 * (j))
#define XB_XGEN(j)  (2304 + 64 * (j))
#define XB_TOP      3328
#define XB_TOPGEN   3392
#define XCD_BAR_WORDS 3456
#define XB_SPIN_CAP (1u << 18)

__device__ __forceinline__ unsigned xb_ld(unsigned* p)              { return __hip_atomic_load(p, __ATOMIC_RELAXED, __HIP_MEMORY_SCOPE_AGENT); }
__device__ __forceinline__ unsigned xb_add(unsigned* p, unsigned v) { return __hip_atomic_fetch_add(p, v, __ATOMIC_RELAXED, __HIP_MEMORY_SCOPE_AGENT); }
__device__ __forceinline__ unsigned xb_xcc_id() { return (unsigned)__builtin_amdgcn_s_getreg((3 << 11) | 20) & 0xFu; }
#define XB_SPIN(cond, bar) do { unsigned _sp = 0; while (cond) { __builtin_amdgcn_s_sleep(1); \
    if ((++_sp & 255u) == 0u) { if (xb_ld(&(bar)[XB_TMO])) break; if (_sp > XB_SPIN_CAP) { atomicAdd(&(bar)[XB_TMO], 1u); break; } } } } while (0)

struct XcdBarrier {
    unsigned* bar; unsigned x;
    volatile LAS unsigned* st;
};

__device__ __forceinline__ XcdBarrier xcd_barrier_post(unsigned* bar, volatile LAS unsigned* st) {
    XcdBarrier b; b.bar = bar; b.x = xb_xcc_id(); b.st = st;
    if (threadIdx.x == 0) (void)xb_add(&bar[XB_XCNT(b.x)], 1u);
    return b;
}
__device__ __forceinline__ void xcd_barrier_complete(unsigned* bar, unsigned x, unsigned& nloc, unsigned& nx) {
    const unsigned G = gridDim.x * gridDim.y * gridDim.z;
    unsigned sum, cnt, mine, sp = 0u;
    for (;;) {
        sum = 0u; cnt = 0u; mine = 0u;
#pragma unroll
        for (unsigned j = 0; j < 16; ++j) { const unsigned c = xb_ld(&bar[XB_XCNT(j)]); sum += c; cnt += (c > 0u) ? 1u : 0u; mine = (j == x) ? c : mine; }
        if (sum == G) break;
        __builtin_amdgcn_s_sleep(1);
        if ((++sp & 255u) == 0u) { if (xb_ld(&bar[XB_TMO])) break; if (sp > XB_SPIN_CAP) { atomicAdd(&bar[XB_TMO], 1u); break; } }
    }
    nloc = mine > 0u ? mine : 1u; nx = cnt > 0u ? cnt : 1u;
}

__device__ __forceinline__ void xcd_barrier(const XcdBarrier& b) {
    asm volatile("s_waitcnt vmcnt(0)" ::: "memory");
    __syncthreads();
    if (threadIdx.x == 0) {
        unsigned* bar = b.bar;
        __builtin_amdgcn_s_waitcnt(0);
        unsigned nloc = b.st[0], nx = b.st[1];
        if (nloc == 0u) { xcd_barrier_complete(bar, b.x, nloc, nx); b.st[0] = nloc; b.st[1] = nx; }
        const unsigned old = xb_add(&bar[XB_XSUB(b.x)], 1u);
        const unsigned gen = old / nloc;
        if (old + 1u == (gen + 1u) * nloc) {
            __builtin_amdgcn_fence(__ATOMIC_RELEASE, "agent");
            asm volatile("s_waitcnt vmcnt(0)" ::: "memory");
            const unsigned og = xb_add(&bar[XB_TOP], 1u);
            const unsigned tg = og / nx;
            if (og + 1u == (tg + 1u) * nx) xb_add(&bar[XB_TOPGEN], 1u);
            else XB_SPIN(xb_ld(&bar[XB_TOPGEN]) == tg, bar);
            __builtin_amdgcn_fence(__ATOMIC_ACQUIRE, "agent");
            xb_add(&bar[XB_XGEN(b.x)], 1u);
            asm volatile("s_waitcnt vmcnt(0)" ::: "memory");
        } else {
            XB_SPIN(xb_ld(&bar[XB_XGEN(b.x)]) == gen, bar);
            __builtin_amdgcn_fence(__ATOMIC_ACQUIRE, "agent");
            asm volatile("s_waitcnt vmcnt(0)" ::: "memory");
        }
    }
    __syncthreads();
}


constexpr int NWAVES = 8;
#ifndef MK_PER_PHASE
#define MK_PER_PHASE 0
#endif
#ifndef PROBE_REPEAT
#define PROBE_REPEAT -1
#endif
#define REP(k) for (int rep_ = 0; rep_ < ((PROBE_REPEAT) == (k) ? 2 : 1); ++rep_)
constexpr int NPH = 18;

constexpr int BATCH = 8, SEQ = 4096, D = 1024, M = BATCH * SEQ, FF = 2816;
constexpr int NADA = 9216;
constexpr int N_CKV = 512, N_DQKV = 2304, N_GATES = 2048, N_IN = N_CKV + N_DQKV + N_GATES, K_UP = 384, N_UP = 1792, K_OM = 512, K_ODL = 256, K_OMD = K_OM + K_ODL;
constexpr float EPS = 1e-6f;

constexpr size_t MiB = 1u << 20;
constexpr size_t WS_CTL = 0, CTL_ZERO_BYTES = 64 * 1024;
constexpr size_t WS_WGU1 = 1 * MiB, WS_WD1 = WS_WGU1 + (size_t)2 * FF * D * 2, WS_WGU2 = WS_WD1 + (size_t)D * FF * 2, WS_WD2 = WS_WGU2 + (size_t)2 * FF * D * 2,
                 WS_WINA = WS_WD2 + (size_t)D * FF * 2, WS_WINB = WS_WINA + (size_t)512 * 1024 * 2, WS_WINC = WS_WINB + (size_t)2304 * 1024 * 2,
                 WS_WUP = WS_WINC + (size_t)2048 * 1024 * 2, WS_WOM = WS_WUP + (size_t)1792 * 384 * 2, WS_WODL = WS_WOM + (size_t)1024 * 512 * 2, WS_WOUT = WS_WODL + (size_t)1024 * 256 * 2,
                 WS_ADA = WS_WOUT + (size_t)1024 * 1024 * 2, WS_KR = WS_ADA + (size_t)8 * 9216 * 4, WS_ROPEM = WS_KR + (size_t)32768 * 32 * 2, WS_WEND = WS_ROPEM + (size_t)32768 * 32 * 4;
static_assert(WS_WEND <= 56 * MiB && (WS_WD1 % 256) == 0 && (WS_WINA % 256) == 0 && (WS_WUP % 256) == 0 && (WS_WOM % 256) == 0 && (WS_ADA % 256) == 0 && (WS_KR % 256) == 0 && (WS_ROPEM % 256) == 0, "weight area");
constexpr size_t WS_GATES = 56 * MiB, WS_HID = 56 * MiB, WS_DQKV = 184 * MiB, WS_MG = 184 * MiB, WS_X2 = 232 * MiB  , WS_XN = 328 * MiB, WS_Y = 392 * MiB, WS_QKVM = 328 * MiB,
                 WS_PART = 328 * MiB, WS_LSE = 376 * MiB, WS_O = 440 * MiB, WS_ODIL = 472 * MiB, WS_CKV = 456 * MiB, WS_ROPED = 456 * MiB  , WS_CN = 488 * MiB, WS_END = 512 * MiB;
static_assert(WS_HID + (size_t)M * FF * 2 <= WS_XN && WS_GATES + (size_t)M * N_GATES * 2 <= WS_DQKV && WS_DQKV + (size_t)M * N_DQKV * 2 <= WS_XN && WS_XN + (size_t)M * D * 2 <= WS_Y && WS_Y + (size_t)M * D * 2 <= WS_CKV, "ws map 4");
static_assert(WS_QKVM + (size_t)M * N_UP * 2 <= WS_O && WS_O + (size_t)M * K_OMD * 2 <= WS_CN && WS_CKV + (size_t)M * N_CKV * 2 <= WS_CN && WS_CN + (size_t)M * K_UP * 2 <= WS_END && WS_MG + (size_t)M * D * 2 <= WS_XN, "ws map 5");
constexpr int CW_BAR = 4096;
static_assert((CW_BAR + XCD_BAR_WORDS) * 4 <= (int)CTL_ZERO_BYTES, "barrier words inside the memset region");

constexpr int RING_OFF = 0, RING_BYTES = 131072;
constexpr int LDSCTL_OFF = RING_BYTES, MISC_OFF = LDSCTL_OFF + 320, EPI_RED_OFF = RING_BYTES + 4096, DIL_REDO_OFF = EPI_RED_OFF + 4096;
constexpr int LDS_BYTES = 147456;
static_assert(MISC_OFF + 128 <= EPI_RED_OFF && DIL_REDO_OFF + 64 <= LDS_BYTES && mla::SHM_ATTN <= RING_BYTES && dil2::LDS_BYTES <= RING_BYTES, "LDS map");
static_assert(WS_PART + (size_t)3 * M * 256 * 2 <= WS_LSE && WS_LSE + (size_t)3 * M * 4 * 4 <= WS_O, "ws map 6");

typedef unsigned v2u __attribute__((ext_vector_type(2)));
struct Frame {
    LAS unsigned char* lds;
    volatile LAS unsigned* MISC;
    gu32* ctl;
    int tid, lane, wave;
    int vcu, G;
    unsigned char* ws;
    bf16* part; float* lse;
};
__device__ __forceinline__ float wave_sum(float v) {
#pragma unroll
    for (int o = 1; o < 64; o <<= 1) v += __shfl_xor(v, o);
    return v;
}
__device__ __forceinline__ float bflo(unsigned w) { return __uint_as_float(w << 16); }
__device__ __forceinline__ float bfhi(unsigned w) { return __uint_as_float(w & 0xffff0000u); }
__device__ __forceinline__ float bf1(bf16 h) { return __uint_as_float((unsigned)h << 16); }

__device__ __forceinline__ void transpose_item(const float* W, int N, int k0, int n0, bf16* WT, int ldk, int drow0, int kd0, LAS float* scr, int lane, float wscale = 1.0f, int srow = -1) {
#pragma unroll 8
    for (int i = 0; i < 32; ++i) { const int kk = 2 * i + (lane >> 5); scr[kk * 33 + (lane & 31)] = W[(size_t)(k0 + kk) * N + n0 + (lane & 31)] * wscale; }
    LDS_WAIT(); asm volatile("" ::: "memory");
    const int c = lane & 7;
#pragma unroll
    for (int j = 0; j < 4; ++j) { const int n = (lane >> 3) + 8 * j; const LAS float* s = scr + (8 * c) * 33 + n;
        v4u o; o.x = pk2(s[0 * 33], s[1 * 33]); o.y = pk2(s[2 * 33], s[3 * 33]); o.z = pk2(s[4 * 33], s[5 * 33]); o.w = pk2(s[6 * 33], s[7 * 33]);
        const int drow = (srow >= 0 && n >= 16) ? srow + n - 16 : drow0 + n;
        *(GAS v4u*)(WT + (size_t)drow * ldk + kd0 + 8 * c) = o; }
    LDS_WAIT(); asm volatile("" ::: "memory");
}
__device__ __forceinline__ void zero_bytes(unsigned char* p, int nbytes, int lane) {
    const v4u z = {0u, 0u, 0u, 0u};
    for (int o = lane * 16; o < nbytes; o += 1024) *(GAS v4u*)(p + o) = z;
}
__device__ __forceinline__ int pair_row(int n0) { return 256 * (n0 >> 7) + (n0 & 127); }

struct Args { const void* in[25]; float* out; unsigned char* ws; int ph_lo, ph_hi, li, pad; };
enum { I_X = 0, I_C, I_POS, I_WADA, I_BADA, I_GPRE1, I_WG1, I_WU1, I_WD1, I_GPOST1, I_GPREM, I_WIN, I_GCQ, I_WUQ, I_GCKV, I_WUKV, I_WOMLA, I_WODIL, I_WOUT, I_GPOSTM, I_GPRE2, I_WG2, I_WU2, I_WD2, I_GPOST2 };

__device__ __forceinline__ void p0_prologue(Frame& F, const Args& A) {
    const float* c = (const float*)A.in[I_C]; const float* w_ada = (const float*)A.in[I_WADA]; const float* b_ada = (const float*)A.in[I_BADA];
    float* ada = (float*)(F.ws + WS_ADA);
    for (int g = F.vcu; g < NADA / 64; g += F.G) {
        LAS float* sc = (LAS float*)(F.lds + RING_OFF); LAS float* red = (LAS float*)(F.lds + RING_OFF + 32768);
        for (int i = F.tid; i < BATCH * D; i += NWAVES * 64) { const float v = c[i]; sc[i] = v / (1.0f + __expf(-v)); }
        __syncthreads();
        float acc[BATCH];
#pragma unroll
        for (int b = 0; b < BATCH; ++b) acc[b] = 0.f;
        const int col = 64 * g + F.lane;
#pragma unroll 1
        for (int k0 = 0; k0 < 128; k0 += 32) {
            float w[32];
#pragma unroll
            for (int j = 0; j < 32; ++j) w[j] = w_ada[(size_t)(128 * F.wave + k0 + j) * NADA + col];
#pragma unroll
            for (int j = 0; j < 32; ++j) { const int k = 128 * F.wave + k0 + j;
#pragma unroll
                for (int b = 0; b < BATCH; ++b) acc[b] += sc[b * D + k] * w[j]; } }
#pragma unroll
        for (int b = 0; b < BATCH; ++b) red[(F.wave * BATCH + b) * 64 + F.lane] = acc[b];
        __syncthreads();
        { const int b = F.tid >> 6; float s = 0.f;
#pragma unroll
          for (int w8 = 0; w8 < NWAVES; ++w8) s += red[(w8 * BATCH + b) * 64 + F.lane];
          ada[(size_t)b * NADA + col] = s + b_ada[col]; }
        __syncthreads();
    }
    LAS float* scr = (LAS float*)(F.lds + RING_OFF + F.wave * 16384);
    const int gw = F.vcu * NWAVES + F.wave, NGW = F.G * NWAVES;
    bf16* WGU1 = (bf16*)(F.ws + WS_WGU1); bf16* WD1 = (bf16*)(F.ws + WS_WD1); bf16* WGU2 = (bf16*)(F.ws + WS_WGU2); bf16* WD2 = (bf16*)(F.ws + WS_WD2);
    bf16* WINA = (bf16*)(F.ws + WS_WINA); bf16* WINB = (bf16*)(F.ws + WS_WINB); bf16* WINC = (bf16*)(F.ws + WS_WINC);
    bf16* WUP = (bf16*)(F.ws + WS_WUP); bf16* WOM = (bf16*)(F.ws + WS_WOM); bf16* WODL = (bf16*)(F.ws + WS_WODL); bf16* WOUT = (bf16*)(F.ws + WS_WOUT);
    constexpr int I_GU = (D / 64) * (FF / 32);
    constexpr int I_DN = (FF / 64) * (D / 32);
    constexpr int I_IN = (D / 64) * (4768 / 32);
    constexpr int I_UQ = (256 / 64) * (768 / 32);
    constexpr int I_UKV = (128 / 64) * (1024 / 32);
    constexpr int I_OM = (512 / 64) * (D / 32);
    constexpr int I_ODL = (256 / 64) * (D / 32);
    constexpr int I_OUT = (D / 64) * (D / 32);
    constexpr int Z_A = 96, Z_UP = N_UP;
    constexpr int NITEMS = 4 * I_GU + 2 * I_DN + I_IN + I_UQ + I_UKV + I_OM + I_ODL + I_OUT + Z_A + Z_UP;
    for (int it = gw; it < NITEMS; it += NGW) {
        int r = it;
        if (r < 4 * I_GU) {
            const int which = r / I_GU; r -= which * I_GU; const int nblk = FF / 32, kb = r / nblk, nb = r % nblk, n0 = 32 * nb;
            const float* W = which == 0 ? (const float*)A.in[I_WG1] : which == 1 ? (const float*)A.in[I_WU1] : which == 2 ? (const float*)A.in[I_WG2] : (const float*)A.in[I_WU2];
            transpose_item(W, FF, 64 * kb, n0, which < 2 ? WGU1 : WGU2, D, pair_row(n0) + (which & 1) * 128, 64 * kb, scr, F.lane, (which & 1) ? -0.6931471805599453f : -1.4426950408889634f); continue; }
        r -= 4 * I_GU;
        if (r < 2 * I_DN) { const int which = r / I_DN; r -= which * I_DN; const int nblk = D / 32, kb = r / nblk, nb = r % nblk;
            transpose_item(which ? (const float*)A.in[I_WD2] : (const float*)A.in[I_WD1], D, 64 * kb, 32 * nb, which ? WD2 : WD1, FF, 32 * nb, 64 * kb, scr, F.lane); continue; }
        r -= 2 * I_DN;
        if (r < I_IN) { const int nblk = 4768 / 32, kb = r / nblk, nb = r % nblk, n0 = 32 * nb;
            bf16* dst; int drow, srow = -1;
            if (n0 < 416) { dst = WINA; drow = n0; } else if (n0 < 2720) { dst = WINB; const int q = n0 - 416;
                if (q < 1536) { const int h = q >> 6; if ((q & 63) == 0) { drow = 16 * h; srow = 384 + 48 * h; } else drow = 384 + 48 * h + 16; } else drow = q; }
            else { dst = WINC; drow = n0 - 2720; }
            const float wsc = (n0 >= 416 && n0 < 416 + 768) ? dil2::C : 1.0f;
            transpose_item((const float*)A.in[I_WIN], 4768, 64 * kb, n0, dst, D, drow, 64 * kb, scr, F.lane, wsc, srow); continue; }
        r -= I_IN;
        if (r < I_UQ) { const int nblk = 768 / 32, kb = r / nblk, nb = r % nblk;
            transpose_item((const float*)A.in[I_WUQ], 768, 64 * kb, 32 * nb, WUP, K_UP, 32 * nb, 64 * kb, scr, F.lane, mla::SCALE * 1.4426950408889634f); continue; }
        r -= I_UQ;
        if (r < I_UKV) { const int nblk = 1024 / 32, kb = r / nblk, nb = r % nblk;
            transpose_item((const float*)A.in[I_WUKV], 1024, 64 * kb, 32 * nb, WUP, K_UP, 768 + 32 * nb, 256 + 64 * kb, scr, F.lane); continue; }
        r -= I_UKV;
        if (r < I_OM) { const int nblk = D / 32, kb = r / nblk, nb = r % nblk;
            transpose_item((const float*)A.in[I_WOMLA], D, 64 * kb, 32 * nb, WOM, K_OMD, 32 * nb, 64 * kb, scr, F.lane); continue; }
        r -= I_OM;
        if (r < I_ODL) { const int nblk = D / 32, kb = r / nblk, nb = r % nblk;
            transpose_item((const float*)A.in[I_WODIL], D, 64 * kb, 32 * nb, WOM, K_OMD, 32 * nb, K_OM + 64 * kb, scr, F.lane); continue; }
        r -= I_ODL;
        if (r < I_OUT) { const int nblk = D / 32, kb = r / nblk, nb = r % nblk;
            transpose_item((const float*)A.in[I_WOUT], D, 64 * kb, 32 * nb, WOUT, D, 32 * nb, 64 * kb, scr, F.lane); continue; }
        r -= I_OUT;
        if (r < Z_A) { zero_bytes((unsigned char*)(WINA + (size_t)(416 + r) * D), D * 2, F.lane); continue; }
        r -= Z_A;
        { unsigned char* row = (unsigned char*)(WUP + (size_t)r * K_UP); if (r < 768) zero_bytes(row + 512, 256, F.lane); else zero_bytes(row, 512, F.lane); }
    }
}

struct RowBuf { f32x4 x[4]; v2u xb[4]; v2u y[4]; int pos; };
struct RopeTab { const int* positions; float* ropem; float* roped; float inv; };
template <int MODE, bool XI_BF>
__device__ __forceinline__ void rp_load(RowBuf& B, const float* xi, const bf16* xib, const bf16* y, int m, int lane, const RopeTab& RT) {
    if (MODE == 0) B.pos = RT.positions[m];
#pragma unroll
    for (int j = 0; j < 4; ++j) {
        if (XI_BF) B.xb[j] = *(const GAS v2u*)(xib + (size_t)m * D + 256 * j + 4 * lane); else B.x[j] = *(const GAS f32x4*)(xi + (size_t)m * D + 256 * j + 4 * lane);
        if (MODE != 0) B.y[j] = *(const GAS v2u*)(y + (size_t)m * D + 256 * j + 4 * lane); }
}
template <int MODE, bool XI_BF, bool XO_BF>
__device__ __forceinline__ void rp_process(int m, int lane, f32x4 (&v)[4], const v2u (&yw)[4], float* xo, bf16* xob, bf16* XN, const float* g_post, const float* gate, float cg,
                                           const float* g_pre, const float* shift, const float* scale, int pos, const RopeTab& RT) {
    const int b = m >> 12;
    if (MODE == 0) {
        float sn, cs; sincosf((float)pos * RT.inv, &sn, &cs);
        if (lane < 16) { RT.ropem[(size_t)m * 32 + lane] = cs; RT.ropem[(size_t)m * 32 + 16 + lane] = sn; }
        else if (lane < 24) { RT.roped[(size_t)m * 16 + (lane - 16)] = cs; RT.roped[(size_t)m * 16 + 8 + (lane - 16)] = sn; }
    }
    if (MODE != 0) {
        f32x4 yv[4]; float s = 0.f;
#pragma unroll
        for (int j = 0; j < 4; ++j) { const v2u w = yw[j];
            yv[j] = (f32x4){bflo(w.x), bfhi(w.x), bflo(w.y), bfhi(w.y)}; s += (yv[j].x * yv[j].x + yv[j].y * yv[j].y) + (yv[j].z * yv[j].z + yv[j].w * yv[j].w); }
        const float rstd = 1.0f / sqrtf(wave_sum(s) * (1.0f / D) + EPS);
#pragma unroll
        for (int j = 0; j < 4; ++j) { const int col = 256 * j + 4 * lane;
            const f32x4 gp = *(const GAS f32x4*)(g_post + col), gt = *(const GAS f32x4*)(gate + (size_t)b * NADA + col);
            v[j] = v[j] + (gt * cg) * (yv[j] * rstd * gp);
            if (XO_BF) { v2u o; o.x = pk2(v[j].x, v[j].y); o.y = pk2(v[j].z, v[j].w); *(GAS v2u*)(xob + (size_t)m * D + col) = o; }
            else *(GAS f32x4*)(xo + (size_t)m * D + col) = v[j]; }
    }
    if (MODE != 2) {
        float s = 0.f;
#pragma unroll
        for (int j = 0; j < 4; ++j) s += (v[j].x * v[j].x + v[j].y * v[j].y) + (v[j].z * v[j].z + v[j].w * v[j].w);
        const float rstd = 1.0f / sqrtf(wave_sum(s) * (1.0f / D) + EPS);
#pragma unroll
        for (int j = 0; j < 4; ++j) { const int col = 256 * j + 4 * lane;
            const f32x4 gp = *(const GAS f32x4*)(g_pre + col), sh = *(const GAS f32x4*)(shift + (size_t)b * NADA + col), sc = *(const GAS f32x4*)(scale + (size_t)b * NADA + col);
            const f32x4 h = (v[j] * rstd * gp) * (sc + 1.0f) + sh;
            v2u o; o.x = pk2(h.x, h.y); o.y = pk2(h.z, h.w);
            *(GAS v2u*)(XN + (size_t)m * D + col) = o; }
    }
}
template <int MODE, bool XI_BF = false, bool XO_BF = false>
__device__ __forceinline__ void row_pass(Frame& F, const void* xi_, const bf16* y, void* xo_, bf16* XN, const float* g_post, const float* gate, float cg,
                                         const float* g_pre, const float* shift, const float* scale, const RopeTab RT = RopeTab{nullptr, nullptr, nullptr, 0.f}) {
    const float* xi = (const float*)xi_; const bf16* xib = (const bf16*)xi_; float* xo = (float*)xo_; bf16* xob = (bf16*)xo_;
    int gw = F.vcu * NWAVES + F.wave, lane = F.lane; const int NGW = F.G * NWAVES;
    asm volatile("" : "+s"(gw), "+v"(lane));
    RowBuf A, B;
    if (gw < M) rp_load<MODE, XI_BF>(A, xi, xib, y, gw, lane, RT);
    if (gw + NGW < M) rp_load<MODE, XI_BF>(B, xi, xib, y, gw + NGW, lane, RT);
    for (int m = gw; m < M; m += 2 * NGW) {
        { f32x4 v[4]; v2u yw[4];
#pragma unroll
          for (int j = 0; j < 4; ++j) { if (XI_BF) v[j] = (f32x4){bflo(A.xb[j].x), bfhi(A.xb[j].x), bflo(A.xb[j].y), bfhi(A.xb[j].y)}; else v[j] = A.x[j]; yw[j] = A.y[j]; }
          const int posA = (MODE == 0) ? A.pos : 0;
          if (m + 2 * NGW < M) rp_load<MODE, XI_BF>(A, xi, xib, y, m + 2 * NGW, lane, RT);
          rp_process<MODE, XI_BF, XO_BF>(m, lane, v, yw, xo, xob, XN, g_post, gate, cg, g_pre, shift, scale, posA, RT); }
        if (m + NGW < M) { f32x4 v[4]; v2u yw[4];
#pragma unroll
          for (int j = 0; j < 4; ++j) { if (XI_BF) v[j] = (f32x4){bflo(B.xb[j].x), bfhi(B.xb[j].x), bflo(B.xb[j].y), bfhi(B.xb[j].y)}; else v[j] = B.x[j]; yw[j] = B.y[j]; }
          const int posB = (MODE == 0) ? B.pos : 0;
          if (m + 3 * NGW < M) rp_load<MODE, XI_BF>(B, xi, xib, y, m + 3 * NGW, lane, RT);
          rp_process<MODE, XI_BF, XO_BF>(m + NGW, lane, v, yw, xo, xob, XN, g_post, gate, cg, g_pre, shift, scale, posB, RT); }
    }
}


struct PrepBuf { int pos; v2u cq; unsigned ckv; unsigned short t1, t2; v4u a, b; };
__device__ __forceinline__ void prep_load(PrepBuf& P, const int* positions, const bf16* CKV, const bf16* DQ, int m, int lane) {
    P.pos = positions[m];
    P.cq = *(const GAS v2u*)(CKV + (size_t)m * N_CKV + 4 * lane);
    P.ckv = *(const GAS unsigned*)(CKV + (size_t)m * N_CKV + 256 + 2 * lane);
    P.t1 = 0; P.t2 = 0; if (lane < 16) { P.t1 = CKV[(size_t)m * N_CKV + 384 + lane]; P.t2 = CKV[(size_t)m * N_CKV + 400 + lane]; }
    P.a = (v4u){0u, 0u, 0u, 0u}; P.b = P.a; if (lane < 24) { const GAS v4u* qp = (const GAS v4u*)(DQ + (size_t)m * N_DQKV + lane * 16); P.a = qp[0]; P.b = qp[1]; }
}
__device__ __forceinline__ void mix_prep(Frame& F, const Args& A) {
    const bf16* CKV = (const bf16*)(F.ws + WS_CKV); bf16* CN = (bf16*)(F.ws + WS_CN); bf16* KR = (bf16*)(F.ws + WS_KR); bf16* DQ = (bf16*)(F.ws + WS_DQKV); float* ROPEM = (float*)(F.ws + WS_ROPEM);
    const float* g_cq = (const float*)A.in[I_GCQ]; const float* g_ckv = (const float*)A.in[I_GCKV]; const int* positions = (const int*)A.in[I_POS];
    const int gw = F.vcu * NWAVES + F.wave, NGW = F.G * NWAVES, lane = F.lane;
    const f32x4 gq = *(const GAS f32x4*)(g_cq + 4 * lane); const float gk0 = g_ckv[2 * lane], gk1 = g_ckv[2 * lane + 1];
    const float inv = lane < 16 ? exp2f(-(float)lane * (13.287712379549449f / 16.0f)) : exp2f(-(float)(lane & 7) * (18.931568569324174f / 8.0f));
    PrepBuf N; if (gw < M) prep_load(N, positions, CKV, DQ, gw, lane);
    for (int m = gw; m < M; m += NGW) {
        const PrepBuf C = N;
        if (m + NGW < M) prep_load(N, positions, CKV, DQ, m + NGW, lane);
        const float pos = (float)C.pos;
        float sn, cs; sincosf(pos * inv, &sn, &cs);
        { const float a0 = bflo(C.cq.x), a1 = bfhi(C.cq.x), a2 = bflo(C.cq.y), a3 = bfhi(C.cq.y);
          const float rstd = 1.0f / sqrtf(wave_sum((a0 * a0 + a1 * a1) + (a2 * a2 + a3 * a3)) * (1.0f / 256.0f) + EPS);
          v2u o; o.x = pk2(a0 * rstd * gq.x, a1 * rstd * gq.y); o.y = pk2(a2 * rstd * gq.z, a3 * rstd * gq.w);
          *(GAS v2u*)(CN + (size_t)m * K_UP + 4 * lane) = o; }
        { const float a0 = bflo(C.ckv), a1 = bfhi(C.ckv);
          const float rstd = 1.0f / sqrtf(wave_sum(a0 * a0 + a1 * a1) * (1.0f / 128.0f) + EPS);
          *(GAS unsigned*)(CN + (size_t)m * K_UP + 256 + 2 * lane) = pk2(a0 * rstd * gk0, a1 * rstd * gk1); }
        if (lane < 16) {
            const float t1 = bf1(C.t1), t2 = bf1(C.t2);
            KR[(size_t)m * 32 + lane] = (bf16)f2bf(t1 * cs - t2 * sn); KR[(size_t)m * 32 + 16 + lane] = (bf16)f2bf(t2 * cs + t1 * sn);
            ROPEM[(size_t)m * 32 + lane] = cs; ROPEM[(size_t)m * 32 + 16 + lane] = sn;
        }
        {
            float cj[8], sj[8];
#pragma unroll
            for (int j = 0; j < 8; ++j) { cj[j] = __shfl(cs, 16 + j); sj[j] = __shfl(sn, 16 + j); }
            if (lane < 24) { GAS v4u* qp = (GAS v4u*)(DQ + (size_t)m * N_DQKV + lane * 16);
                v4u oa, ob;
#pragma unroll
                for (int k = 0; k < 4; ++k) { const float t1l = bflo(C.a[k]), t1h = bfhi(C.a[k]), t2l = bflo(C.b[k]), t2h = bfhi(C.b[k]);
                    oa[k] = pk2(t1l * cj[2 * k] - t2l * sj[2 * k], t1h * cj[2 * k + 1] - t2h * sj[2 * k + 1]);
                    ob[k] = pk2(t2l * cj[2 * k] + t1l * sj[2 * k], t2h * cj[2 * k + 1] + t1h * sj[2 * k + 1]); }
                qp[0] = oa; qp[1] = ob; }
        }
    }
}
__device__ __forceinline__ void dil_attn_coop(Frame& F) {
    LAS char* lds = (LAS char*)(F.lds + RING_OFF);
    const dil2::bf16_t* DQ = (const dil2::bf16_t*)(F.ws + WS_DQKV);
    const int per = (dil2::NSTEPS + F.G - 1) / F.G; const int s0 = F.vcu * per, s1 = (s0 + per < dil2::NSTEPS) ? s0 + per : dil2::NSTEPS;
    dil2::KV R;
    if (s0 < s1) { const dil2::Step S = dil2::decode(s0); dil2::kv_load(R, DQ, S, F.tid); }
    for (int si = s0; si < s1; ++si) {
        const dil2::Step S = dil2::decode(si);
        dil2::kv_write(R, lds, F.tid);
        __syncthreads();
        if (si + 1 < s1) { const dil2::Step N = dil2::decode(si + 1); dil2::kv_load(R, DQ, N, F.tid); }
        LAS unsigned* redo = (LAS unsigned*)(F.lds + DIL_REDO_OFF);
        if (!dil2::block<false>(DQ, (dil2::bf16_t*)F.part, F.lse, S, F.wave, lds, F.lane)) { if (F.lane == 0) redo[0] = 1u; }
        asm volatile("s_waitcnt lgkmcnt(0)" ::: "memory");
        __syncthreads();
        if (redo[0] != 0u) {
            const dil2::bf16_t* DQ2 = DQ; int ln = F.lane; asm volatile("" : "+s"(DQ2), "+v"(ln));
            dil2::block<true>(DQ2, (dil2::bf16_t*)F.part, F.lse, S, F.wave, lds, ln);
            __syncthreads(); if (F.tid == 0) redo[0] = 0u; asm volatile("s_waitcnt lgkmcnt(0)" ::: "memory"); __syncthreads(); }
    }
}
__device__ __forceinline__ void dil_combine(Frame& F) {
    const bf16* PART = (const bf16*)F.part; const float* LSE = F.lse; bf16* OB = (bf16*)(F.ws + WS_O) + K_OM;
    const int gw = F.vcu * NWAVES + F.wave, NGW = F.G * NWAVES, lane = F.lane, hs = lane >> 4;
    float nl[3]; v2u nw[3];
#define DC_LOAD(mm) do { _Pragma("unroll") for (int g = 0; g < 3; ++g) { nl[g] = LSE[((size_t)g * M + (mm)) * 4 + hs]; nw[g] = *(const GAS v2u*)(PART + ((size_t)g * M + (mm)) * 256 + 4 * lane); } } while (0)
    if (gw < M) DC_LOAD(gw);
    for (int m = gw; m < M; m += NGW) {
        float l[3]; v2u w[3];
#pragma unroll
        for (int g = 0; g < 3; ++g) { l[g] = nl[g]; w[g] = nw[g]; }
        if (m + NGW < M) DC_LOAD(m + NGW);
        const float mx = fmaxf(l[0], fmaxf(l[1], l[2]));
        const float e0 = exp2f(l[0] - mx), e1 = exp2f(l[1] - mx), e2 = exp2f(l[2] - mx), inv = 1.0f / (e0 + e1 + e2);
        const float a0 = e0 * inv, a1 = e1 * inv, a2 = e2 * inv;
        v2u o;
        o.x = pk2(a0 * bflo(w[0].x) + a1 * bflo(w[1].x) + a2 * bflo(w[2].x), a0 * bfhi(w[0].x) + a1 * bfhi(w[1].x) + a2 * bfhi(w[2].x));
        o.y = pk2(a0 * bflo(w[0].y) + a1 * bflo(w[1].y) + a2 * bflo(w[2].y), a0 * bfhi(w[0].y) + a1 * bfhi(w[1].y) + a2 * bfhi(w[2].y));
        *(GAS v2u*)(OB + (size_t)m * K_OMD + 4 * lane) = o;
    }
#undef DC_LOAD
}

__global__ void __launch_bounds__(NWAVES * 64, 2) mk_fwd(Args args) {
    extern __shared__ __attribute__((aligned(16))) unsigned char lds[];
    Frame F;
    F.lds = (LAS unsigned char*)lds;
    F.MISC = (volatile LAS unsigned*)(F.lds + MISC_OFF);
    F.tid = threadIdx.x; F.lane = F.tid & 63; F.wave = __builtin_amdgcn_readfirstlane(F.tid >> 6);
    F.G = gridDim.x; { const int bx = blockIdx.x; F.vcu = (F.G % 8 == 0) ? (bx % 8) * (F.G / 8) + bx / 8 : bx; }
    F.ws = args.ws; F.ctl = (gu32*)(args.ws + WS_CTL);
    F.part = (bf16*)((unsigned char*)args.out + (size_t)64 * MiB); F.lse = (float*)((unsigned char*)args.out + (size_t)64 * MiB + (size_t)3 * M * 256 * 2);
    for (int u = F.tid; u < (LDS_BYTES - LDSCTL_OFF) / 4; u += NWAVES * 64) ((LAS unsigned*)(F.lds + LDSCTL_OFF))[u] = 0u;
    __syncthreads();
    XcdBarrier bar; bar.bar = (unsigned*)(F.ctl + CW_BAR); bar.x = 0; bar.st = nullptr;
    if (!MK_PER_PHASE) bar = xcd_barrier_post((unsigned*)(F.ctl + CW_BAR), F.MISC + 8);
#define GRID_BAR() do { if (!MK_PER_PHASE) xcd_barrier(bar); } while (0)
    const int lo = args.ph_lo, hi = args.ph_hi;
#define IN(k) (lo <= (k) && (k) < hi)
#define BOTH(k) (IN(k) && IN((k) + 1))
    const float* x = (const float*)args.in[I_X]; float* out = args.out;
    const float* ada = (const float*)(F.ws + WS_ADA);
    bf16* XN = (bf16*)(F.ws + WS_XN); bf16* HID = (bf16*)(F.ws + WS_HID); bf16* Y = (bf16*)(F.ws + WS_Y);
    typedef pg8::bf16_t pb;

    if (IN(0)) REP(0) { p0_prologue(F, args); if (BOTH(0)) GRID_BAR(); }
    if (IN(1)) REP(1) {
        const float inv = F.lane < 16 ? exp2f(-(float)F.lane * (13.287712379549449f / 16.0f)) : exp2f(-(float)(F.lane & 7) * (18.931568569324174f / 8.0f));
        const RopeTab RT{(const int*)args.in[I_POS], (float*)(F.ws + WS_ROPEM), (float*)(F.ws + WS_ROPED), inv};
        row_pass<0>(F, x, nullptr, nullptr, XN, nullptr, nullptr, 0.f, (const float*)args.in[I_GPRE1], ada + 0 * D, ada + 1 * D, RT); if (BOTH(1)) GRID_BAR(); }
    if (IN(2)) REP(2) { pg8::Gemm g{(const pb*)XN, (const pb*)(F.ws + WS_WGU1), M, 2 * FF, D}; pg8::StaticOrder S; S.init(M, 2 * FF, F.G, (int)blockIdx.x);
        pg8::EpiSwiGLU E{(pb*)HID, FF}; pg8::gemm_phase<pg8::EpiSwiGLU, pg8::StaticOrder, PG8_ALIGN, PG8_SP2>(F.lds + RING_OFF, g, S, E); if (BOTH(2)) GRID_BAR(); }
    if (IN(3)) REP(3) { pg8::Gemm g{(const pb*)HID, (const pb*)(F.ws + WS_WD1), M, D, FF}; pg8::StaticOrder S; S.init(M, D, F.G, (int)blockIdx.x);
        pg8::EpiBf16 E{(pb*)Y, D}; pg8::gemm_phase<pg8::EpiBf16, pg8::StaticOrder, PG8_ALIGN, PG8_SP2>(F.lds + RING_OFF, g, S, E); if (BOTH(3)) GRID_BAR(); }
    if (IN(4)) { row_pass<1, false, true>(F, x, Y, out  , XN, (const float*)args.in[I_GPOST1], ada + 2 * D, 0.5f, (const float*)args.in[I_GPREM], ada + 3 * D, ada + 4 * D); if (BOTH(4)) GRID_BAR(); }
    if (IN(5)) REP(5) { pg8::Gemm g{(const pb*)XN, (const pb*)(F.ws + WS_WINA), M, N_IN, D}; pg8::StaticOrder S; S.init(M, N_IN, F.G, (int)blockIdx.x);
        pg8::EpiIn E{(pb*)(F.ws + WS_CN), (pb*)(F.ws + WS_KR), (pb*)(F.ws + WS_DQKV), (pb*)(F.ws + WS_GATES), (const float*)args.in[I_GCQ], (const float*)args.in[I_GCKV],
                     (const float*)(F.ws + WS_ROPEM), (const float*)(F.ws + WS_ROPED), (LAS float*)(F.lds + EPI_RED_OFF), EPS};
        pg8::gemm_phase<pg8::EpiIn, pg8::StaticOrder, PG8_ALIGN, PG8_SP2>(F.lds + RING_OFF, g, S, E); if (IN(5) && IN(7)) GRID_BAR(); }
    if (IN(7)) REP(7) { pg8::Gemm g{(const pb*)(F.ws + WS_CN), (const pb*)(F.ws + WS_WUP), M, N_UP, K_UP}; pg8::UpOrder S; S.init(M, N_UP, F.G, (int)blockIdx.x);
        pg8::EpiBf16 E{(pb*)(F.ws + WS_QKVM), N_UP}; pg8::gemm_phase<pg8::EpiBf16, pg8::UpOrder, PG8_ALIGN, PG8_SP2, true>(F.lds + RING_OFF, g, S, E); if (BOTH(7)) GRID_BAR(); }
    if (IN(9)) REP(9) {
        const int NU = BATCH * 8 * (SEQ / 256), per = NU / F.G; const bool even = (NU % F.G) == 0;
        for (int i = 0;; ++i) { int un; if (even) { if (i >= per) break; un = F.vcu * per + i; } else { un = F.vcu + i * F.G; if (un >= NU) break; }
            const int bh = un >> 4, qb = un & 15;
            const mla::bf16_t* qkvm = (const mla::bf16_t*)(F.ws + WS_QKVM); const mla::bf16_t* krp = (const mla::bf16_t*)(F.ws + WS_KR); mla::bf16_t* op = (mla::bf16_t*)(F.ws + WS_O); const float* ropem = (const float*)(F.ws + WS_ROPEM);
            if (!mla::attn_unit_stag<true>(qkvm, krp, op, ropem, bh >> 3, bh & 7, qb * 256, (LAS char*)(F.lds + RING_OFF))) {
                __syncthreads();
                mla::attn_unit_stag<false>(qkvm, krp, op, ropem, bh >> 3, bh & 7, qb * 256, (LAS char*)(F.lds + RING_OFF)); } }
        __syncthreads(); }
    if (IN(10)) REP(10) { dil_attn_coop(F); if (BOTH(10)) GRID_BAR(); }
    if (IN(11)) REP(11) { dil_combine(F); if (BOTH(11)) GRID_BAR(); }
    if (IN(12)) REP(12) {
        { pg8::Gemm g{(const pb*)(F.ws + WS_O), (const pb*)(F.ws + WS_WOM), M, D, K_OMD}; pg8::StaticOrder S; S.init(M, D, F.G, (int)blockIdx.x);
          pg8::EpiGate2 E{(pb*)(F.ws + WS_MG), D, (const pb*)(F.ws + WS_GATES), N_GATES, D}; pg8::gemm_phase<pg8::EpiGate2, pg8::StaticOrder, PG8_ALIGN, PG8_SP2, true>(F.lds + RING_OFF, g, S, E); }
        if (BOTH(12)) GRID_BAR(); }
    if (IN(13)) REP(13) { pg8::Gemm g{(const pb*)(F.ws + WS_MG), (const pb*)(F.ws + WS_WOUT), M, D, D}; pg8::StaticOrder S; S.init(M, D, F.G, (int)blockIdx.x);
        pg8::EpiBf16 E{(pb*)Y, D}; pg8::gemm_phase<pg8::EpiBf16, pg8::StaticOrder, PG8_ALIGN, PG8_SP2>(F.lds + RING_OFF, g, S, E); if (BOTH(13)) GRID_BAR(); }
    if (IN(14)) { row_pass<1, true, true>(F, out, Y, F.ws + WS_X2  , XN, (const float*)args.in[I_GPOSTM], ada + 5 * D, 1.0f, (const float*)args.in[I_GPRE2], ada + 6 * D, ada + 7 * D); if (BOTH(14)) GRID_BAR(); }
    if (IN(15)) REP(15) { pg8::Gemm g{(const pb*)XN, (const pb*)(F.ws + WS_WGU2), M, 2 * FF, D}; pg8::StaticOrder S; S.init(M, 2 * FF, F.G, (int)blockIdx.x);
        pg8::EpiSwiGLU E{(pb*)HID, FF}; pg8::gemm_phase<pg8::EpiSwiGLU, pg8::StaticOrder, PG8_ALIGN, PG8_SP2>(F.lds + RING_OFF, g, S, E); if (BOTH(15)) GRID_BAR(); }
    if (IN(16)) REP(16) { pg8::Gemm g{(const pb*)HID, (const pb*)(F.ws + WS_WD2), M, D, FF}; pg8::StaticOrder S; S.init(M, D, F.G, (int)blockIdx.x);
        pg8::EpiBf16 E{(pb*)Y, D}; pg8::gemm_phase<pg8::EpiBf16, pg8::StaticOrder, PG8_ALIGN, PG8_SP2>(F.lds + RING_OFF, g, S, E); if (BOTH(16)) GRID_BAR(); }
    if (IN(17)) { row_pass<2, true, false>(F, F.ws + WS_X2, Y, out, nullptr, (const float*)args.in[I_GPOST2], ada + 8 * D, 0.5f, nullptr, nullptr, nullptr); }
#undef IN
#undef BOTH
#undef GRID_BAR
}

extern "C" void kernel_launch(void* const* d_in, const int* in_sizes, int n_in, void* d_out, int out_size, void* d_ws, size_t ws_size, hipStream_t stream) {
    static int grid = 0;
    if (grid == 0) {
        if (n_in != 25 || in_sizes[0] != M * D || out_size != M * D || ws_size < WS_END) { fprintf(stderr, "kernel_launch: shape mismatch: n_in %d in0 %d out %d ws %zu (need >= %zu)\n", n_in, n_in > 0 ? in_sizes[0] : -1, out_size, ws_size, (size_t)WS_END); grid = -1; return; }
        int dev = 0, cus = 0, per_cu = 0;
        if (hipGetDevice(&dev) != hipSuccess || hipDeviceGetAttribute(&cus, hipDeviceAttributeMultiprocessorCount, dev) != hipSuccess) { fprintf(stderr, "kernel_launch: device query failed\n"); grid = -1; return; }
        if (hipFuncSetAttribute((const void*)mk_fwd, hipFuncAttributeMaxDynamicSharedMemorySize, LDS_BYTES) != hipSuccess) { fprintf(stderr, "kernel_launch: hipFuncSetAttribute failed\n"); grid = -1; return; }
        if (hipOccupancyMaxActiveBlocksPerMultiprocessor(&per_cu, (const void*)mk_fwd, NWAVES * 64, LDS_BYTES) != hipSuccess || per_cu < 1) { fprintf(stderr, "kernel_launch: occupancy query reports %d workgroups per CU\n", per_cu); (void)hipGetLastError(); grid = -1; return; }
        grid = cus;
    }
    if (grid < 0) return;
    if (hipMemsetAsync((char*)d_ws + WS_CTL, 0, CTL_ZERO_BYTES, stream) != hipSuccess) { fprintf(stderr, "kernel_launch: hipMemsetAsync failed\n"); return; }
    Args a{};
    for (int i = 0; i < 25; ++i) a.in[i] = d_in[i];
    a.out = (float*)d_out; a.ws = (unsigned char*)d_ws;
#if MK_PER_PHASE
    for (int p = 0; p < NPH; ++p) { a.ph_lo = p; a.ph_hi = p + 1; a.li = p;
        hipLaunchKernelGGL(mk_fwd, dim3(grid), dim3(NWAVES * 64), LDS_BYTES, stream, a); }
#else
    a.ph_lo = 0; a.ph_hi = NPH; a.li = 0;
    void* kargs[] = {&a};
    hipError_t e = hipLaunchCooperativeKernel((const void*)mk_fwd, dim3(grid), dim3(NWAVES * 64), kargs, LDS_BYTES, stream);
    if (e != hipSuccess) fprintf(stderr, "kernel_launch: cooperative launch failed: %s (grid %d)\n", hipGetErrorString(e), grid);
#endif
    const hipError_t le = hipPeekAtLastError();
    if (le != hipSuccess) fprintf(stderr, "kernel_launch: launch failed: %s\n", hipGetErrorName(le));
}
```

```cpp
#include <hip/hip_runtime.h>
#ifndef PROBE_EPI2
#define PROBE_EPI2 0
#endif
#include <hip/hip_bf16.h>
#include <cstdio>
#include <cstdint>
#include <cmath>
namespace pg8 {
#define PG8_LAS __attribute__((address_space(3)))
typedef unsigned short bf16_t;
typedef short bf16x8 __attribute__((ext_vector_type(8)));
typedef float f32x4 __attribute__((ext_vector_type(4)));
typedef unsigned u32x4 __attribute__((ext_vector_type(4)));
constexpr int BM = 256, BK = 64, HALF = 128, HTB = HALF * BK * 2  , STAGE_BYTES = 8 * HTB, NXCD = 8, WGM = 4;

__host__ __device__ __forceinline__ int lds_byte(int r, int c) { const int st = (r >> 4) * 2 + (c >> 5), rr = r & 15, cc = c & 31, ob = rr * 64 + cc * 2; return st * 1024 + (ob ^ (((ob >> 9) & 1) << 5)); }
__host__ __device__ __forceinline__ void stage_rc(int b, int& R, int& C) { const int st = b / 1024, sb = b % 1024, swz = sb ^ (((sb >> 9) & 1) << 5); R = (st >> 1) * 16 + swz / 64; C = (st & 1) * 32 + (swz % 64) / 2; }
__host__ __device__ __forceinline__ int perm32(int rho) { const int n = rho >> 4, i = rho & 15; return 8 * (i >> 2) + 4 * n + (i & 3); }

struct Unit { int pm, pn; };
struct Gemm { const bf16_t* A; const bf16_t* Bt; int M, N, K; };

struct StaticOrder {
    int nM, nN, nwg, G, c;
    __host__ __device__ void init(int M, int N, int G_, int c_) { nM = M / BM; nN = N / BM; nwg = nM * nN; G = G_; c = c_; }
    __host__ __device__ bool next(int i, Unit& u) const {
        const long L = (long)i * G + c; if (L >= nwg) return false;
        int wgid = (int)L; { const int q = nwg / NXCD, r = nwg % NXCD, xcd = wgid % NXCD, off = wgid / NXCD; wgid = (xcd < r ? xcd * (q + 1) : r * (q + 1) + (xcd - r) * q) + off; }
        const int nig = WGM * nN, gid = wgid / nig, fm = gid * WGM, gsz = (nM - fm) < WGM ? (nM - fm) : WGM;
        u.pm = fm + ((wgid % nig) % gsz); u.pn = (wgid % nig) / gsz; return true;
    }
    __device__ __forceinline__ void a_ready(const Unit&) const {}
    __device__ __forceinline__ void done(const Unit&) const {}
    __device__ __forceinline__ void krange(const Unit&, int nt_all, int& k0, int& nt) const { k0 = 0; nt = nt_all; }
};
struct UpOrder : StaticOrder {
    __device__ __forceinline__ void krange(const Unit& u, int, int& k0, int& nt) const { if (u.pn < 3) { k0 = 0; nt = 4; } else { k0 = 4; nt = 2; } }
};

__device__ __forceinline__ unsigned cvt_pk_bf16(float lo, float hi) { unsigned r; asm volatile("v_cvt_pk_bf16_f32 %0, %1, %2" : "=v"(r) : "v"(lo), "v"(hi)); return r; }
__device__ __forceinline__ float bf_lo(unsigned w) { return __uint_as_float(w << 16); }
__device__ __forceinline__ float bf_hi(unsigned w) { return __uint_as_float(w & 0xffff0000u); }
__device__ __forceinline__ float sigmoid_f(float x) { return __builtin_amdgcn_rcpf(1.0f + __builtin_amdgcn_exp2f(-1.4426950408889634f * x)); }

struct EpiBf16 {
    static constexpr bool PERM = true, AFTER_DRAIN = false, IDEMP = true; static constexpr int MID_T = 0; static constexpr bool ADJ = true;
    bf16_t* O; int ldc;
    static __device__ __forceinline__ unsigned ror8(unsigned v) { return (unsigned)__builtin_amdgcn_update_dpp(0, (int)v, 0x128  , 0xf, 0xf, true); }
    __device__ __forceinline__ void operator()(const f32x4 (&acc)[2][2][4][2], const Unit& u, int wr, int wc, int fr, int fq) const {
        const bool lo = fr < 8;
        const int rbase = u.pm * BM + wr * 64 + (fr & 7); const int col = u.pn * BM + wc * 64 + 8 * fq + (lo ? 0 : 32);
#pragma unroll
        for (int ai = 0; ai < 2; ++ai)
#pragma unroll
            for (int m = 0; m < 4; ++m) { bf16_t* rowp = O + (size_t)(rbase + ai * HALF + m * 16) * ldc + col;
                u32x4 w0, w1;
                { const f32x4 v0 = acc[ai][0][m][0], v1 = acc[ai][0][m][1]; w0.x = cvt_pk_bf16(v0[0], v0[1]); w0.y = cvt_pk_bf16(v0[2], v0[3]); w0.z = cvt_pk_bf16(v1[0], v1[1]); w0.w = cvt_pk_bf16(v1[2], v1[3]); }
                { const f32x4 v0 = acc[ai][1][m][0], v1 = acc[ai][1][m][1]; w1.x = cvt_pk_bf16(v0[0], v0[1]); w1.y = cvt_pk_bf16(v0[2], v0[3]); w1.z = cvt_pk_bf16(v1[0], v1[1]); w1.w = cvt_pk_bf16(v1[2], v1[3]); }
                u32x4 dA, dB;
#pragma unroll
                for (int q = 0; q < 4; ++q) { const unsigned t1 = ror8(w1[q]), t0 = ror8(w0[q]); dA[q] = lo ? w0[q] : t1; dB[q] = lo ? t0 : w1[q]; }
                *(u32x4*)rowp = dA; *(u32x4*)(rowp + (size_t)8 * ldc) = dB; }
    }
};
struct EpiSwiGLU {
    static constexpr bool PERM = true, AFTER_DRAIN = false, IDEMP = true; static constexpr int MID_T = 0; static constexpr bool ADJ = false;
    bf16_t* O; int ldc;
    __device__ __forceinline__ void operator()(const f32x4 (&acc)[2][2][4][2], const Unit& u, int wr, int wc, int fr, int fq) const {
        typedef float f32x2 __attribute__((ext_vector_type(2)));
        const int row0 = u.pm * BM + wr * 64 + fr; const int col0 = u.pn * HALF + wc * 32 + 8 * fq;
#pragma unroll
        for (int ai = 0; ai < 2; ++ai)
#pragma unroll
            for (int m = 0; m < 4; ++m) { bf16_t* rowp = O + (size_t)(row0 + ai * HALF + m * 16) * ldc + col0;
                f32x2 h[4];
#pragma unroll
                for (int q = 0; q < 4; ++q) { const int n = q >> 1, j = (q & 1) * 2;
                    const f32x2 g = {acc[ai][0][m][n][j], acc[ai][0][m][n][j + 1]}, up = {acc[ai][1][m][n][j], acc[ai][1][m][n][j + 1]};
                    f32x2 e; e.x = __builtin_amdgcn_exp2f(g.x); e.y = __builtin_amdgcn_exp2f(g.y);
                    const f32x2 d = e + 1.0f; f32x2 r; r.x = __builtin_amdgcn_rcpf(d.x); r.y = __builtin_amdgcn_rcpf(d.y);
                    h[q] = (g * up) * r; }
                u32x4 w; w.x = cvt_pk_bf16(h[0].x, h[0].y); w.y = cvt_pk_bf16(h[1].x, h[1].y); w.z = cvt_pk_bf16(h[2].x, h[2].y); w.w = cvt_pk_bf16(h[3].x, h[3].y);
                *(u32x4*)rowp = w; }
    }
};
template <bool ACCUM> struct EpiGate {
    static constexpr bool PERM = true, AFTER_DRAIN = false, IDEMP = !ACCUM; static constexpr int MID_T = 0; static constexpr bool ADJ = false;
    bf16_t* O; int ldc; const bf16_t* G; int ldg; int goff;
    __device__ __forceinline__ void operator()(const f32x4 (&acc)[2][2][4][2], const Unit& u, int wr, int wc, int fr, int fq) const {
        const int row0 = u.pm * BM + wr * 64 + fr; const int col0 = u.pn * BM + wc * 32 + 8 * fq;
#pragma unroll
        for (int ai = 0; ai < 2; ++ai)
#pragma unroll
            for (int m = 0; m < 4; ++m) { const size_t row = (size_t)(row0 + ai * HALF + m * 16);
#pragma unroll
                for (int bj = 0; bj < 2; ++bj) { const int col = col0 + bj * HALF;
                    const u32x4 gv = *(const u32x4*)(G + row * ldg + goff + col);
                    u32x4 prev = {0u, 0u, 0u, 0u}; if (ACCUM) prev = *(const u32x4*)(O + row * ldc + col);
                    float h[8];
#pragma unroll
                    for (int q = 0; q < 4; ++q) { const int n = q >> 1, j = (q & 1) * 2;
                        h[2 * q]     = sigmoid_f(bf_lo(gv[q])) * acc[ai][bj][m][n][j];
                        h[2 * q + 1] = sigmoid_f(bf_hi(gv[q])) * acc[ai][bj][m][n][j + 1];
                        if (ACCUM) { h[2 * q] += bf_lo(prev[q]); h[2 * q + 1] += bf_hi(prev[q]); } }
                    u32x4 w; w.x = cvt_pk_bf16(h[0], h[1]); w.y = cvt_pk_bf16(h[2], h[3]); w.z = cvt_pk_bf16(h[4], h[5]); w.w = cvt_pk_bf16(h[6], h[7]);
                    *(u32x4*)(O + row * ldc + col) = w; } }
    }
};
struct EpiGate2 {
    static constexpr bool PERM = true, AFTER_DRAIN = false, IDEMP = true; static constexpr int MID_T = 8; static constexpr bool ADJ = false;
    bf16_t* O; int ldc; const bf16_t* G; int ldg; int goff;
    static __device__ __forceinline__ float dbf(float gb) { return fminf(1.0f + __builtin_amdgcn_exp2f(-1.4426950408889634f * gb), 1e30f); }
    __device__ __forceinline__ void mid(f32x4 (&acc)[2][2][4][2], const Unit& u, int wr, int wc, int fr, int fq) const {
        const int row0 = u.pm * BM + wr * 64 + fr; const int col0 = u.pn * BM + wc * 32 + 8 * fq;
#pragma unroll
        for (int ai = 0; ai < 2; ++ai)
#pragma unroll
            for (int m = 0; m < 4; ++m) { const size_t row = (size_t)(row0 + ai * HALF + m * 16);
#pragma unroll
                for (int bj = 0; bj < 2; ++bj) { const int col = col0 + bj * HALF;
                    const u32x4 ga = *(const u32x4*)(G + row * ldg + col), gb = *(const u32x4*)(G + row * ldg + goff + col);
#pragma unroll
                    for (int q = 0; q < 4; ++q) { const int n = q >> 1, j = (q & 1) * 2;
                        acc[ai][bj][m][n][j]     *= dbf(bf_lo(gb[q])) * sigmoid_f(bf_lo(ga[q]));
                        acc[ai][bj][m][n][j + 1] *= dbf(bf_hi(gb[q])) * sigmoid_f(bf_hi(ga[q])); } } }
    }
    __device__ __forceinline__ void operator()(const f32x4 (&acc)[2][2][4][2], const Unit& u, int wr, int wc, int fr, int fq) const {
        const int row0 = u.pm * BM + wr * 64 + fr; const int col0 = u.pn * BM + wc * 32 + 8 * fq;
#pragma unroll
        for (int ai = 0; ai < 2; ++ai)
#pragma unroll
            for (int m = 0; m < 4; ++m) { const size_t row = (size_t)(row0 + ai * HALF + m * 16);
#pragma unroll
                for (int bj = 0; bj < 2; ++bj) { const int col = col0 + bj * HALF;
                    const u32x4 gb = *(const u32x4*)(G + row * ldg + goff + col);
                    float h[8];
#pragma unroll
                    for (int q = 0; q < 4; ++q) { const int n = q >> 1, j = (q & 1) * 2;
                        h[2 * q]     = __builtin_amdgcn_rcpf(dbf(bf_lo(gb[q]))) * acc[ai][bj][m][n][j];
                        h[2 * q + 1] = __builtin_amdgcn_rcpf(dbf(bf_hi(gb[q]))) * acc[ai][bj][m][n][j + 1]; }
                    u32x4 w; w.x = cvt_pk_bf16(h[0], h[1]); w.y = cvt_pk_bf16(h[2], h[3]); w.z = cvt_pk_bf16(h[4], h[5]); w.w = cvt_pk_bf16(h[6], h[7]);
                    *(u32x4*)(O + row * ldc + col) = w; } }
    }
};
struct EpiRoute3 {
    static constexpr bool PERM = true, AFTER_DRAIN = false, IDEMP = true; static constexpr int MID_T = 0; static constexpr bool ADJ = false;
    bf16_t* O0; int ld0; int t1; bf16_t* O1; int ld1; int t2; bf16_t* O2; int ld2;
    __device__ __forceinline__ void operator()(const f32x4 (&acc)[2][2][4][2], const Unit& u, int wr, int wc, int fr, int fq) const {
        bf16_t* base; int ldc, colt;
        if (u.pn < t1) { base = O0; ldc = ld0; colt = u.pn * BM; } else if (u.pn < t2) { base = O1; ldc = ld1; colt = (u.pn - t1) * BM; } else { base = O2; ldc = ld2; colt = (u.pn - t2) * BM; }
        const int row0 = u.pm * BM + wr * 64 + fr; const int col0 = colt + wc * 32 + 8 * fq;
#pragma unroll
        for (int ai = 0; ai < 2; ++ai)
#pragma unroll
            for (int m = 0; m < 4; ++m) { bf16_t* rowp = base + (size_t)(row0 + ai * HALF + m * 16) * ldc + col0;
#pragma unroll
                for (int bj = 0; bj < 2; ++bj) { const f32x4 v0 = acc[ai][bj][m][0], v1 = acc[ai][bj][m][1];
                    u32x4 w; w.x = cvt_pk_bf16(v0[0], v0[1]); w.y = cvt_pk_bf16(v0[2], v0[3]); w.z = cvt_pk_bf16(v1[0], v1[1]); w.w = cvt_pk_bf16(v1[2], v1[3]);
                    *(u32x4*)(rowp + bj * HALF) = w; } }
    }
};

struct EpiIn {
    static constexpr bool PERM = true, AFTER_DRAIN = false, IDEMP = true; static constexpr int MID_T = 0; static constexpr bool ADJ = false;
    bf16_t* CN; bf16_t* KR; bf16_t* DQ; bf16_t* GT; const float* g_cq; const float* g_ckv; const float* ropem; const float* roped; PG8_LAS float* red; float eps;
    static __device__ __forceinline__ void st8(bf16_t* p, const float (&h)[8]) { u32x4 w; w.x = cvt_pk_bf16(h[0], h[1]); w.y = cvt_pk_bf16(h[2], h[3]); w.z = cvt_pk_bf16(h[4], h[5]); w.w = cvt_pk_bf16(h[6], h[7]); *(u32x4*)p = w; }
    __device__ __forceinline__ void operator()(const f32x4 (&acc)[2][2][4][2], const Unit& u, int wr, int wc, int fr, int fq) const {
        const int row0 = u.pm * BM + wr * 64 + fr, rl0 = wr * 64 + fr, cl = wc * 32 + 8 * fq;
        if (u.pn >= 4) {
            bf16_t* base; int ldc, colt; if (u.pn < 11) { base = DQ; ldc = 2304; colt = (u.pn - 2) * BM; } else { base = GT; ldc = 2048; colt = (u.pn - 11) * BM; }
#pragma unroll
            for (int ai = 0; ai < 2; ++ai)
#pragma unroll
                for (int m = 0; m < 4; ++m) { bf16_t* rowp = base + (size_t)(row0 + ai * HALF + m * 16) * ldc + colt + cl;
#pragma unroll
                    for (int bj = 0; bj < 2; ++bj) { const f32x4 v0 = acc[ai][bj][m][0], v1 = acc[ai][bj][m][1]; const float h[8] = {v0[0], v0[1], v0[2], v0[3], v1[0], v1[1], v1[2], v1[3]}; st8(rowp + bj * HALF, h); } }
            return; }
        if (u.pn <= 1) {
            const int nbj = (u.pn == 0) ? 2 : 1;
#pragma unroll
            for (int ai = 0; ai < 2; ++ai)
#pragma unroll
                for (int m = 0; m < 4; ++m) { float sq = 0.f;
#pragma unroll
                    for (int bj = 0; bj < 2; ++bj) if (bj < nbj) {
#pragma unroll
                        for (int n = 0; n < 2; ++n) { const f32x4 v = acc[ai][bj][m][n]; sq += (v[0] * v[0] + v[1] * v[1]) + (v[2] * v[2] + v[3] * v[3]); } }
                    sq += __shfl_xor(sq, 16); sq += __shfl_xor(sq, 32);
                    if (fq == 0) red[(ai * HALF + rl0 + m * 16) * 4 + wc] = sq; }
            asm volatile("s_waitcnt lgkmcnt(0)" ::: "memory"); __builtin_amdgcn_s_barrier(); asm volatile("" ::: "memory");
            const float invn = (u.pn == 0) ? (1.0f / 256.0f) : (1.0f / 128.0f); const float* gv = (u.pn == 0) ? g_cq : g_ckv; const int cbase = (u.pn == 0) ? 0 : 256;
#pragma unroll
            for (int ai = 0; ai < 2; ++ai)
#pragma unroll
                for (int m = 0; m < 4; ++m) { const f32x4 pr = *(const PG8_LAS f32x4*)(red + (ai * HALF + rl0 + m * 16) * 4);
                    const float rstd = 1.0f / sqrtf(((pr[0] + pr[1]) + (pr[2] + pr[3])) * invn + eps); const size_t row = (size_t)(row0 + ai * HALF + m * 16);
#pragma unroll
                    for (int bj = 0; bj < 2; ++bj) if (bj < nbj) { const int col = bj * HALF + cl; const f32x4 g0 = *(const f32x4*)(gv + col), g1 = *(const f32x4*)(gv + col + 4);
                        const f32x4 v0 = acc[ai][bj][m][0], v1 = acc[ai][bj][m][1];
                        const float h[8] = {v0[0] * rstd * g0[0], v0[1] * rstd * g0[1], v0[2] * rstd * g0[2], v0[3] * rstd * g0[3], v1[0] * rstd * g1[0], v1[1] * rstd * g1[1], v1[2] * rstd * g1[2], v1[3] * rstd * g1[3]};
                        st8(CN + row * 384 + cbase + col, h); } }
            if (u.pn == 1 && wc == 0) {
                const bool hiH = fq >= 2;
#pragma unroll
                for (int ai = 0; ai < 2; ++ai)
#pragma unroll
                    for (int m = 0; m < 4; ++m) { const size_t row = (size_t)(row0 + ai * HALF + m * 16); const float* rp = ropem + row * 32 + 8 * (fq & 1);
                        const f32x4 c0 = *(const f32x4*)rp, c1 = *(const f32x4*)(rp + 4), s0 = *(const f32x4*)(rp + 16), s1 = *(const f32x4*)(rp + 20);
                        float h[8];
#pragma unroll
                        for (int i = 0; i < 8; ++i) { const float own = acc[ai][1][m][i >> 2][i & 3];
                            const auto rr = __builtin_amdgcn_permlane32_swap(__float_as_uint(own), __float_as_uint(own), false, false);
                            const float oth = __uint_as_float(hiH ? rr[0] : rr[1]); const float cs = (i < 4) ? c0[i & 3] : c1[i & 3], sn = (i < 4) ? s0[i & 3] : s1[i & 3];
                            h[i] = hiH ? (own * cs + oth * sn) : (own * cs - oth * sn); }
                        st8(KR + row * 32 + (hiH ? 16 : 0) + 8 * (fq & 1), h); } }
            return; }
        const int colt = (u.pn - 2) * BM; const bool odd = (fq & 1) != 0;
#pragma unroll
        for (int ai = 0; ai < 2; ++ai)
#pragma unroll
            for (int m = 0; m < 4; ++m) { const size_t row = (size_t)(row0 + ai * HALF + m * 16); const float* rp = roped + row * 16;
                const f32x4 c0 = *(const f32x4*)rp, c1 = *(const f32x4*)(rp + 4), s0 = *(const f32x4*)(rp + 8), s1 = *(const f32x4*)(rp + 12);
#pragma unroll
                for (int bj = 0; bj < 2; ++bj) { const int col = colt + bj * HALF + cl; float h[8];
                    if (colt + bj * HALF < 384) {
#pragma unroll
                        for (int i = 0; i < 8; ++i) { const float own = acc[ai][bj][m][i >> 2][i & 3];
                            const auto rr = __builtin_amdgcn_permlane16_swap(__float_as_uint(own), __float_as_uint(own), false, false);
                            const float oth = __uint_as_float(odd ? rr[0] : rr[1]); const float cs = (i < 4) ? c0[i & 3] : c1[i & 3], sn = (i < 4) ? s0[i & 3] : s1[i & 3];
                            h[i] = odd ? (own * cs + oth * sn) : (own * cs - oth * sn); }
                    } else {
#pragma unroll
                        for (int i = 0; i < 8; ++i) h[i] = acc[ai][bj][m][i >> 2][i & 3]; }
                    st8(DQ + row * 2304 + col, h); } }
    }
};

template <class Epi, class Sched, bool ALIGN_EPI = false, bool SP2 = false, bool OPAQUE_K = false>
__device__ __forceinline__ void gemm_phase(PG8_LAS unsigned char* lds, const Gemm g, const Sched& S, const Epi& E) {
    const int tid = threadIdx.x, wid = __builtin_amdgcn_readfirstlane(tid >> 6), lane = tid & 63, wr = wid >> 2, wc = wid & 3, fr = lane & 15, fq = lane >> 4;
    int K_ = g.K; if constexpr (OPAQUE_K) asm volatile("" : "+s"(K_));
    const int K = K_, nt_all = K / BK;
    unsigned voffA[2], voffB[2];
#pragma unroll
    for (int i = 0; i < 2; ++i) { int R, C; stage_rc(tid * 16 + i * 8192, R, C); const int Rb = Epi::ADJ ? ((R >> 5) * 64 + perm32(R & 31)) : Epi::PERM ? ((R & ~31) + perm32(R & 31)) : R;
        voffA[i] = (unsigned)(R * K + C) * 2u; voffB[i] = (unsigned)(Rb * K + C) * 2u; }
    const size_t kstep = (size_t)(BK * 2);
    const size_t hstep = (size_t)HALF * K * 2;
    const size_t tstep = 2 * hstep;
    const size_t bh1 = Epi::ADJ ? (size_t)32 * K * 2 : hstep;
    const unsigned ldsw = (unsigned)wid * 1024u;
    const int aoff = lds_byte(wr * 64 + fr, fq * 8), boff = lds_byte(wc * 32 + fr, fq * 8);
#define PG8_SA(b, h) (((b) * 2 + (h)) * HTB)
#define PG8_SB(b, h) ((4 + (b) * 2 + (h)) * HTB)
#define PG8_STAGE(bufoff, gbase, voff) do { _Pragma("unroll") for (int _i = 0; _i < 2; ++_i) \
        __builtin_amdgcn_global_load_lds((const unsigned*)((const char*)(gbase) + (voff)[_i]), (PG8_LAS unsigned*)(lds + (bufoff) + ldsw + _i * 8192), 16, 0, 0); } while (0)
#define PG8_LDA(dst, b, h) do { _Pragma("unroll") for (int m = 0; m < 4; ++m) _Pragma("unroll") for (int k = 0; k < 2; ++k) dst[m][k] = *(const PG8_LAS bf16x8*)(lds + PG8_SA(b, h) + aoff + m * 2048 + k * 1024); } while (0)
#define PG8_LDB(dst, b, h) do { _Pragma("unroll") for (int n = 0; n < 2; ++n) _Pragma("unroll") for (int k = 0; k < 2; ++k) dst[n][k] = *(const PG8_LAS bf16x8*)(lds + PG8_SB(b, h) + boff + n * 2048 + k * 1024); } while (0)
#define PG8_MMA(ai, bj, At, Bt) do { __builtin_amdgcn_s_setprio(1); _Pragma("unroll") for (int m = 0; m < 4; ++m) _Pragma("unroll") for (int n = 0; n < 2; ++n) _Pragma("unroll") for (int k = 0; k < 2; ++k) \
        acc[ai][bj][m][n] = __builtin_amdgcn_mfma_f32_16x16x32_bf16(Bt[n][k], At[m][k], acc[ai][bj][m][n], 0, 0, 0); __builtin_amdgcn_s_setprio(0); } while (0)
#define PG8_WAIT_V(n) asm volatile("s_waitcnt vmcnt(" #n ")" ::: "memory")
#define PG8_WAIT_L(n) asm volatile("s_waitcnt lgkmcnt(" #n ")" ::: "memory")
#define PG8_BAR __builtin_amdgcn_s_barrier()
#define PG8_SCHED __builtin_amdgcn_sched_barrier(0)
    Unit cur, nxt; int ui = 0;
    if (!S.next(0, cur)) return;
    f32x4 acc[2][2][4][2];
#pragma unroll
    for (int a = 0; a < 2; ++a)
#pragma unroll
        for (int b = 0; b < 2; ++b)
#pragma unroll
            for (int m = 0; m < 4; ++m)
#pragma unroll
                for (int n = 0; n < 2; ++n) acc[a][b][m][n] = (f32x4){0.f, 0.f, 0.f, 0.f};
    bf16x8 At[4][2], B0[2][2], B1[2][2];
    int k0c, nt; S.krange(cur, nt_all, k0c, nt);
    const char* cA = (const char*)g.A + (size_t)cur.pm * tstep + (size_t)k0c * kstep; const char* cB = (const char*)g.Bt + (size_t)cur.pn * tstep + (size_t)k0c * kstep;
    S.a_ready(cur);
    if constexpr (SP2) {
        PG8_STAGE(PG8_SB(0, 0), cB, voffB); PG8_STAGE(PG8_SB(0, 1), cB + bh1, voffB); PG8_STAGE(PG8_SA(0, 0), cA, voffA); PG8_STAGE(PG8_SA(0, 1), cA + hstep, voffA);
        if (wr == 1) PG8_BAR;
        PG8_WAIT_V(2); PG8_BAR;
        PG8_STAGE(PG8_SB(1, 0), cB + kstep, voffB); PG8_STAGE(PG8_SA(1, 0), cA + kstep, voffA); PG8_STAGE(PG8_SB(1, 1), cB + bh1 + kstep, voffB);
        PG8_WAIT_V(6); PG8_BAR;
    } else {
        PG8_STAGE(PG8_SB(0, 0), cB, voffB); PG8_STAGE(PG8_SA(0, 0), cA, voffA); PG8_STAGE(PG8_SB(0, 1), cB + bh1, voffB); PG8_STAGE(PG8_SA(0, 1), cA + hstep, voffA);
        if (wr == 1) PG8_BAR;
        PG8_WAIT_V(4); PG8_BAR;
        PG8_STAGE(PG8_SB(1, 0), cB + kstep, voffB); PG8_STAGE(PG8_SA(1, 0), cA + kstep, voffA); PG8_STAGE(PG8_SB(1, 1), cB + bh1 + kstep, voffB);
        PG8_WAIT_V(6); PG8_BAR;
    }
    for (;;) {
        const bool has_next = S.next(ui + 1, nxt);
        int k0n = 0, ntn = nt; if (has_next) S.krange(nxt, nt_all, k0n, ntn);
        const char* nA = has_next ? (const char*)g.A + (size_t)nxt.pm * tstep + (size_t)k0n * kstep : cA; const char* nB = has_next ? (const char*)g.Bt + (size_t)nxt.pn * tstep + (size_t)k0n * kstep : cB;
        for (int t = 0; t < nt; t += 2) {
            if constexpr (Epi::MID_T > 0) { if (t == Epi::MID_T) E.mid(acc, cur, wr, wc, fr, fq); }
            const bool last = (t == nt - 2);
            const char* a1 = cA + (size_t)(t + 1) * kstep;
            const char* a2 = last ? nA : cA + (size_t)(t + 2) * kstep; const char* b2 = last ? nB : cB + (size_t)(t + 2) * kstep;
            const char* a3 = a2 + kstep; const char* b3 = b2 + kstep;
            if (last && has_next) S.a_ready(nxt);
            if constexpr (SP2) {
            PG8_LDB(B0, 0, 0); PG8_LDB(B1, 0, 1); PG8_SCHED; PG8_LDA(At, 0, 0); PG8_STAGE(PG8_SA(1, 1), a1 + hstep, voffA);
            PG8_WAIT_V(8); PG8_WAIT_L(0); PG8_BAR; PG8_MMA(0, 0, At, B0); PG8_MMA(0, 1, At, B1); PG8_BAR; PG8_SCHED;
            PG8_LDA(At, 0, 1); PG8_STAGE(PG8_SB(0, 0), b2, voffB); PG8_STAGE(PG8_SB(0, 1), b2 + bh1, voffB); PG8_STAGE(PG8_SA(0, 0), a2, voffA);
            PG8_WAIT_V(8); PG8_WAIT_L(0); PG8_BAR; PG8_MMA(1, 0, At, B0); PG8_MMA(1, 1, At, B1); PG8_BAR; PG8_SCHED;
            PG8_LDB(B0, 1, 0); PG8_LDB(B1, 1, 1); PG8_SCHED; PG8_LDA(At, 1, 0); PG8_STAGE(PG8_SA(0, 1), a2 + hstep, voffA);
            PG8_WAIT_V(8); PG8_WAIT_L(0); PG8_BAR; PG8_MMA(0, 0, At, B0); PG8_MMA(0, 1, At, B1); PG8_BAR; PG8_SCHED;
            PG8_LDA(At, 1, 1); PG8_STAGE(PG8_SB(1, 0), b3, voffB); PG8_STAGE(PG8_SB(1, 1), b3 + bh1, voffB); PG8_STAGE(PG8_SA(1, 0), a3, voffA);
            PG8_WAIT_V(8); PG8_WAIT_L(0); PG8_BAR; PG8_MMA(1, 0, At, B0); PG8_MMA(1, 1, At, B1); PG8_BAR; PG8_SCHED;
            } else {
            PG8_LDB(B0, 0, 0); PG8_SCHED; PG8_LDA(At, 0, 0); PG8_STAGE(PG8_SA(1, 1), a1 + hstep, voffA);
            PG8_WAIT_L(8); PG8_BAR; PG8_WAIT_L(0); PG8_MMA(0, 0, At, B0); PG8_BAR; PG8_SCHED;
            PG8_LDB(B1, 0, 1); PG8_STAGE(PG8_SB(0, 0), b2, voffB);
            PG8_BAR; PG8_WAIT_L(0); PG8_MMA(0, 1, At, B1); PG8_BAR;
            PG8_LDA(At, 0, 1); PG8_STAGE(PG8_SA(0, 0), a2, voffA);
            PG8_BAR; PG8_WAIT_L(0); PG8_MMA(1, 0, At, B0); PG8_BAR; PG8_SCHED;
            PG8_STAGE(PG8_SB(0, 1), b2 + bh1, voffB);
            PG8_WAIT_V(6); PG8_BAR; PG8_MMA(1, 1, At, B1); PG8_BAR;
            PG8_LDB(B0, 1, 0); PG8_SCHED; PG8_LDA(At, 1, 0); PG8_STAGE(PG8_SA(0, 1), a2 + hstep, voffA);
            PG8_WAIT_L(8); PG8_BAR; PG8_WAIT_L(0); PG8_MMA(0, 0, At, B0); PG8_BAR; PG8_SCHED;
            PG8_LDB(B1, 1, 1); PG8_STAGE(PG8_SB(1, 0), b3, voffB);
            PG8_BAR; PG8_WAIT_L(0); PG8_MMA(0, 1, At, B1); PG8_BAR;
            PG8_LDA(At, 1, 1); PG8_STAGE(PG8_SA(1, 0), a3, voffA);
            PG8_BAR; PG8_WAIT_L(0); PG8_MMA(1, 0, At, B0); PG8_BAR; PG8_SCHED;
            PG8_STAGE(PG8_SB(1, 1), b3 + bh1, voffB);
            PG8_WAIT_V(6); PG8_BAR; PG8_MMA(1, 1, At, B1); PG8_BAR;
            }
        }
        if constexpr (ALIGN_EPI) { if (wr == 0) PG8_BAR; }
        if constexpr (!Epi::AFTER_DRAIN) { E(acc, cur, wr, wc, fr, fq);
#if defined(PROBE_EPI2) && PROBE_EPI2
            if constexpr (Epi::IDEMP) { asm volatile("" ::: "memory"); E(acc, cur, wr, wc, fr, fq); }
#endif
            S.done(cur); }
        if (!has_next) break;
#pragma unroll
        for (int a = 0; a < 2; ++a)
#pragma unroll
            for (int b = 0; b < 2; ++b)
#pragma unroll
                for (int m = 0; m < 4; ++m)
#pragma unroll
                    for (int n = 0; n < 2; ++n) acc[a][b][m][n] = (f32x4){0.f, 0.f, 0.f, 0.f};
        cur = nxt; cA = nA; cB = nB; nt = ntn; ++ui;
        if constexpr (ALIGN_EPI) { if (wr == 1) PG8_BAR; }
    }
    PG8_WAIT_V(0);
    if constexpr (!ALIGN_EPI) { if (wr == 0) PG8_BAR; }
    PG8_BAR;
    if constexpr (Epi::AFTER_DRAIN) { E.fused(acc, cur, wr, wc, fr, fq, lds, wid, lane); S.done(cur); }
#undef PG8_SA
#undef PG8_SB
#undef PG8_STAGE
#undef PG8_LDA
#undef PG8_LDB
#undef PG8_MMA
#undef PG8_WAIT_V
#undef PG8_WAIT_L
#undef PG8_BAR
#undef PG8_SCHED
}
}

#ifndef PG8_SP2
#define PG8_SP2 true
#endif
#ifndef PG8_ALIGN
#define PG8_ALIGN true
#endif
namespace mla {
#define MLA_LAS __attribute__((address_space(3)))
using bf16x8 = __attribute__((ext_vector_type(8))) short;
using s16x4  = __attribute__((ext_vector_type(4))) short;
using f32x16 = __attribute__((ext_vector_type(16))) float;
using u32x4  = __attribute__((ext_vector_type(4))) unsigned;
using u32x2  = __attribute__((ext_vector_type(2))) unsigned;
using f32x4v = __attribute__((ext_vector_type(4))) float;
typedef unsigned short bf16_t;
constexpr int NW = 8, QBLK = 32, KVBLK = 64, DQK = 96, DV = 64, SEQ = 4096, NHEAD = 8;
constexpr int LDQ = 1792, LDO = 768, LDKR = 32, KOFF = 768, HSTRIDE = 128;
constexpr float SCALE = 0.10206207261596575f;
constexpr float THR = 8.f;
constexpr int SHM_V = KVBLK * DV * 2, SHM_K = KVBLK * 256, SHM_ATTN = 2 * SHM_V + 2 * SHM_K + NW * 64 * 4;
#define MLA_KSWZ(row, colB) ((row) * 256 + ((colB) ^ (((row) & 15) << 4)))
#define MLA_SBAR() __builtin_amdgcn_sched_barrier(0)
__device__ __forceinline__ int crow(int r, int hi) { return (r & 3) + 8 * (r >> 2) + 4 * hi; }
__device__ __forceinline__ unsigned cvtpk(float lo, float hi) { unsigned r; asm volatile("v_cvt_pk_bf16_f32 %0, %1, %2" : "=v"(r) : "v"(lo), "v"(hi)); return r; }
__device__ __forceinline__ unsigned pair_pack(float e, float f, bool odd) {
  const float send = odd ? e : f;
  const float recv = __uint_as_float((unsigned)__builtin_amdgcn_update_dpp(0, (int)__float_as_uint(send), 0xB1  , 0xf, 0xf, true));
  return odd ? cvtpk(recv, f) : cvtpk(e, recv);
}

constexpr float THR2 = THR * 1.4426950408889634f, THR0 = 16.0f;
template <bool FIRST>
__device__ __forceinline__ void partialSM(f32x16& p0, f32x16& p1, float& m_reg, bool& zref, float& alpha, float& l_reg) {
  if (!FIRST && !zref) {
#pragma unroll
    for (int r = 0; r < 16; ++r) { p0[r] -= m_reg; p1[r] -= m_reg; } }
  float pmax = p0[0];
#pragma unroll
  for (int r = 1; r < 16; ++r) pmax = fmaxf(pmax, p0[r]);
#pragma unroll
  for (int r = 0; r < 16; ++r) pmax = fmaxf(pmax, p1[r]);
  { auto rr = __builtin_amdgcn_permlane32_swap(__float_as_uint(pmax), __float_as_uint(pmax), false, false);
    pmax = fmaxf(__uint_as_float(rr[0]), __uint_as_float(rr[1])); }
  alpha = 1.f;
  if (FIRST ? !__builtin_expect(__all(fabsf(pmax) <= THR0), 1) : !__builtin_expect(__all(pmax <= THR2), 1)) {
    const float dl = FIRST ? pmax : fmaxf(pmax, 0.f);
    m_reg += dl; alpha = FIRST ? 1.f : __builtin_amdgcn_exp2f(-dl);
    l_reg *= alpha;
#pragma unroll
    for (int r = 0; r < 16; ++r) { p0[r] -= dl; p1[r] -= dl; }
    zref = zref && __all(m_reg == 0.f);
  }
#pragma unroll
  for (int r = 0; r < 16; ++r) p0[r] = __builtin_amdgcn_exp2f(p0[r]);
}
__device__ __forceinline__ void finishSM(f32x16& p0, f32x16& p1, float& l_reg, bf16x8& pa0, bf16x8& pa1, bf16x8& pa2, bf16x8& pa3) {
#pragma unroll
  for (int r = 0; r < 16; ++r) p1[r] = __builtin_amdgcn_exp2f(p1[r]);
  typedef float f32x2s __attribute__((ext_vector_type(2)));
  f32x2s sa = {0.f, 0.f}, sb = {0.f, 0.f};
#pragma unroll
  for (int r = 0; r < 16; r += 4) { sa += (f32x2s){p0[r], p0[r + 1]}; sb += (f32x2s){p0[r + 2], p0[r + 3]}; }
#pragma unroll
  for (int r = 0; r < 16; r += 4) { sa += (f32x2s){p1[r], p1[r + 1]}; sb += (f32x2s){p1[r + 2], p1[r + 3]}; }
  sa += sb; l_reg += sa.x + sa.y;
#define MLA_PK4(P, BASE, OUT) do { unsigned a0 = cvtpk(P[BASE + 0], P[BASE + 1]), a1 = cvtpk(P[BASE + 2], P[BASE + 3]);   \
    unsigned b0 = cvtpk(P[BASE + 4], P[BASE + 5]), b1 = cvtpk(P[BASE + 6], P[BASE + 7]);                              \
    u32x4 w = {a0, a1, b0, b1}; OUT = __builtin_bit_cast(bf16x8, w); } while (0)
  MLA_PK4(p0, 0, pa0); MLA_PK4(p0, 8, pa1); MLA_PK4(p1, 0, pa2); MLA_PK4(p1, 8, pa3);
#undef MLA_PK4
}
__device__ __forceinline__ void qkt(f32x16& p0, f32x16& p1, const MLA_LAS char* Ks, const bf16x8* qr, int r32, int hi) {
#pragma unroll
  for (int d0 = 0; d0 < DQK / 16; ++d0) { const int cb = (d0 * 16 + hi * 8) * 2;
    const bf16x8 b0 = *reinterpret_cast<const MLA_LAS bf16x8*>(Ks + MLA_KSWZ(r32, cb));
    const bf16x8 b1 = *reinterpret_cast<const MLA_LAS bf16x8*>(Ks + MLA_KSWZ(32 + r32, cb));
    if (d0 == 0) { p0 = __builtin_amdgcn_mfma_f32_32x32x16_bf16(b0, qr[0], f32x16{}, 0, 0, 0); p1 = __builtin_amdgcn_mfma_f32_32x32x16_bf16(b1, qr[0], f32x16{}, 0, 0, 0); }
    else { p0 = __builtin_amdgcn_mfma_f32_32x32x16_bf16(b0, qr[d0], p0, 0, 0, 0); p1 = __builtin_amdgcn_mfma_f32_32x32x16_bf16(b1, qr[d0], p1, 0, 0, 0); }
  }
}
struct KPre { bf16x8 f[6]; };
__device__ __forceinline__ void kpre_load(KPre& kp, const MLA_LAS char* Ks, int r32, int hi) {
#pragma unroll
  for (int d0 = 0; d0 < 6; ++d0) kp.f[d0] = *reinterpret_cast<const MLA_LAS bf16x8*>(Ks + MLA_KSWZ(32 + r32, (d0 * 16 + hi * 8) * 2));
}
__device__ __forceinline__ void qkt_pre(f32x16& p0, f32x16& p1, const MLA_LAS char* Ks, const bf16x8* qr, int r32, int hi, const KPre& kp) {
#define MLA_KF(row, d0) (*reinterpret_cast<const MLA_LAS bf16x8*>(Ks + MLA_KSWZ((row) + r32, ((d0) * 16 + hi * 8) * 2)))
#define MLA_PIN() __builtin_amdgcn_sched_barrier(0x6)
  const bf16x8 a0 = MLA_KF(0, 0), a1 = MLA_KF(0, 1), a2 = MLA_KF(0, 2), a3 = MLA_KF(0, 3);
  MLA_PIN();
  p1 = __builtin_amdgcn_mfma_f32_32x32x16_bf16(kp.f[0], qr[0], f32x16{}, 0, 0, 0);
  p1 = __builtin_amdgcn_mfma_f32_32x32x16_bf16(kp.f[1], qr[1], p1, 0, 0, 0);
  p1 = __builtin_amdgcn_mfma_f32_32x32x16_bf16(kp.f[2], qr[2], p1, 0, 0, 0);
  p1 = __builtin_amdgcn_mfma_f32_32x32x16_bf16(kp.f[3], qr[3], p1, 0, 0, 0);
  p1 = __builtin_amdgcn_mfma_f32_32x32x16_bf16(kp.f[4], qr[4], p1, 0, 0, 0);
  p1 = __builtin_amdgcn_mfma_f32_32x32x16_bf16(kp.f[5], qr[5], p1, 0, 0, 0);
  MLA_PIN();
  const bf16x8 a4 = MLA_KF(0, 4), a5 = MLA_KF(0, 5);
  MLA_PIN();
  p0 = __builtin_amdgcn_mfma_f32_32x32x16_bf16(a0, qr[0], f32x16{}, 0, 0, 0);
  p0 = __builtin_amdgcn_mfma_f32_32x32x16_bf16(a1, qr[1], p0, 0, 0, 0);
  p0 = __builtin_amdgcn_mfma_f32_32x32x16_bf16(a2, qr[2], p0, 0, 0, 0);
  p0 = __builtin_amdgcn_mfma_f32_32x32x16_bf16(a3, qr[3], p0, 0, 0, 0);
  p0 = __builtin_amdgcn_mfma_f32_32x32x16_bf16(a4, qr[4], p0, 0, 0, 0);
  p0 = __builtin_amdgcn_mfma_f32_32x32x16_bf16(a5, qr[5], p0, 0, 0, 0);
#undef MLA_KF
#undef MLA_PIN
}
__device__ __forceinline__ int v_st(int k, int c) { const int kk = k; return ((kk >> 3) * 2 + (c >> 5)) * 512 + ((kk & 7) * 32 + (c & 31)) * 2; }
__device__ __forceinline__ int v_rd_base(int lane) { return ((lane & 3) << 3) | (((lane >> 2) & 3) << 6) | (((lane >> 4) & 1) << 5) | (((lane >> 5) & 1) << 8); }
constexpr int v_rd_off(int d0, int ks, int half) { return d0 * 512 + ks * 2048 + half * 1024; }
typedef short v4i16_t __attribute__((ext_vector_type(4)));
__device__ __forceinline__ s16x4 vtr(const MLA_LAS char* p) { return __builtin_bit_cast(s16x4, __builtin_amdgcn_ds_read_tr16_b64_v4i16((MLA_LAS v4i16_t*)p)); }
template <int D0> __device__ __forceinline__ void pv_one_b(f32x16& od, const MLA_LAS char* vp, bf16x8 pa0, bf16x8 pa1, bf16x8 pa2, bf16x8 pa3) {
  const s16x4 l0 = vtr(vp + v_rd_off(D0, 0, 0)), h0 = vtr(vp + v_rd_off(D0, 0, 1)), l1 = vtr(vp + v_rd_off(D0, 1, 0)), h1 = vtr(vp + v_rd_off(D0, 1, 1));
  const s16x4 l2 = vtr(vp + v_rd_off(D0, 2, 0)), h2 = vtr(vp + v_rd_off(D0, 2, 1)), l3 = vtr(vp + v_rd_off(D0, 3, 0)), h3 = vtr(vp + v_rd_off(D0, 3, 1));
#define MLA_PKB(L, H) (bf16x8){L[0], L[1], L[2], L[3], H[0], H[1], H[2], H[3]}
  od = __builtin_amdgcn_mfma_f32_32x32x16_bf16(pa0, MLA_PKB(l0, h0), od, 0, 0, 0);
  od = __builtin_amdgcn_mfma_f32_32x32x16_bf16(pa1, MLA_PKB(l1, h1), od, 0, 0, 0);
  od = __builtin_amdgcn_mfma_f32_32x32x16_bf16(pa2, MLA_PKB(l2, h2), od, 0, 0, 0);
  od = __builtin_amdgcn_mfma_f32_32x32x16_bf16(pa3, MLA_PKB(l3, h3), od, 0, 0, 0);
#undef MLA_PKB
}
__device__ __forceinline__ void pv_d0_b(f32x16* o, const MLA_LAS char* vp, bf16x8 pa0, bf16x8 pa1, bf16x8 pa2, bf16x8 pa3) {
  pv_one_b<0>(o[0], vp, pa0, pa1, pa2, pa3); pv_one_b<1>(o[1], vp, pa0, pa1, pa2, pa3);
}
__device__ __forceinline__ unsigned short f2bf_rne(float f) { unsigned u = __builtin_bit_cast(unsigned, f); return (unsigned short)((u + 0x7fffu + ((u >> 16) & 1u)) >> 16); }

#ifndef MLA_FORCE_SAFE
#define MLA_FORCE_SAFE 0
#endif
template <bool FAST>
__device__ __forceinline__ bool attn_unit_stag(const bf16_t* __restrict__ QKVM, const bf16_t* __restrict__ KR, bf16_t* __restrict__ OB, const float* __restrict__ ROPEM, int b, int h, int q0, MLA_LAS char* lds) {
  const int tid = threadIdx.x, wid = __builtin_amdgcn_readfirstlane(tid >> 6), lane = tid & 63, r32 = lane & 31, hi = lane >> 5, grp = wid >> 2;
  MLA_LAS char* V_lds = lds; MLA_LAS char* K_lds = lds + 2 * SHM_V;
  MLA_LAS float* ws = (MLA_LAS float*)(lds + 2 * SHM_V + 2 * SHM_K) + wid * 64; MLA_LAS float* li_l = ws; MLA_LAS float* al_l = ws + 32;
  const long tok0 = (long)b * SEQ;
  float m_reg = 0.f, l_reg = 0; f32x16 o[2] = {}; bf16x8 qr[6];
  const bf16_t* Qw = QKVM + (tok0 + q0 + wid * QBLK + r32) * LDQ + h * DQK + hi * 8;
#pragma unroll
  for (int d0 = 0; d0 < 6; ++d0) qr[d0] = *reinterpret_cast<const bf16x8*>(Qw + d0 * 16);
  { const float* rp = ROPEM + (tok0 + q0 + wid * QBLK + r32) * 32 + 8 * hi;
    const f32x4v c0 = *reinterpret_cast<const f32x4v*>(rp), c1 = *reinterpret_cast<const f32x4v*>(rp + 4), s0 = *reinterpret_cast<const f32x4v*>(rp + 16), s1 = *reinterpret_cast<const f32x4v*>(rp + 20);
#pragma unroll
    for (int j = 0; j < 8; ++j) { const float cs = j < 4 ? c0[j & 3] : c1[j & 3], sn = j < 4 ? s0[j & 3] : s1[j & 3];
      const float t1 = __uint_as_float((unsigned)(unsigned short)qr[4][j] << 16), t2 = __uint_as_float((unsigned)(unsigned short)qr[5][j] << 16);
      qr[4][j] = (short)f2bf_rne(t1 * cs - t2 * sn); qr[5][j] = (short)f2bf_rne(t2 * cs + t1 * sn); } }
  const int sr = tid >> 3, sc8 = tid & 7;
  const int vst = v_st(sr, sc8 * 8), kst = MLA_KSWZ(sr, sc8 * 16), krst = MLA_KSWZ(sr, 128 + sc8 * 8);
  const bf16_t* Kg = QKVM + (tok0 + sr) * LDQ + KOFF + h * HSTRIDE + sc8 * 8;
  const bf16_t* KRg = KR + (tok0 + sr) * LDKR + sc8 * 4;
  const int vrb = v_rd_base(lane);
  constexpr int NT = SEQ / KVBLK;
  struct StageSet { bf16x8 ks, vs; u32x2 kr; };
  StageSet sE, sO;
  sE.ks = bf16x8{}; sE.vs = bf16x8{}; sE.kr = u32x2{}; sO = sE;
#define STG_LOAD(S, w) do { if ((w) < NT) { S.ks = *reinterpret_cast<const bf16x8*>(Kg + (long)(w) * KVBLK * LDQ); S.kr = *reinterpret_cast<const u32x2*>(KRg + (long)(w) * KVBLK * LDKR); } \
    if ((w) >= 1) S.vs = *reinterpret_cast<const bf16x8*>(Kg + (long)((w) - 1) * KVBLK * LDQ + 64); } while (0)
#define STG_WRITE(S, w) do { const int sl_ = (w) & 1; if ((w) < NT) { *(MLA_LAS bf16x8*)(K_lds + sl_ * SHM_K + kst) = S.ks; *(MLA_LAS u32x2*)(K_lds + sl_ * SHM_K + krst) = S.kr; } \
    if ((w) >= 1) *(MLA_LAS bf16x8*)(V_lds + sl_ * SHM_V + vst) = S.vs; } while (0)
#define STG_RESC(a) do { if (__any((a) < 1.f)) { if (hi == 0) al_l[r32] = (a); asm volatile("s_waitcnt lgkmcnt(0)" ::: "memory"); \
    _Pragma("unroll") for (int d = 0; d < 2; ++d) _Pragma("unroll") for (int r = 0; r < 16; ++r) o[d][r] *= al_l[crow(r, hi)]; } } while (0)
  f32x16 pA0 = f32x16{}, pA1 = f32x16{}, pB0 = f32x16{}, pB1 = f32x16{};
  float alpha = 1.f; bf16x8 pa0 = bf16x8{}, pa1 = bf16x8{}, pa2 = bf16x8{}, pa3 = bf16x8{};
  KPre kp;
  bool zref = true;
#define STG_XQ(u, C0, C1) do { __builtin_amdgcn_s_setprio(1); qkt(C0, C1, K_lds + ((u) & 1) * SHM_K, qr, r32, hi); __builtin_amdgcn_s_setprio(0); } while (0)
#define STG_XQF(u, C0, C1, P0, P1) do { __builtin_amdgcn_s_setprio(1); qkt_pre(C0, C1, K_lds + ((u) & 1) * SHM_K, qr, r32, hi, kp); \
    finishSM(P0, P1, l_reg, pa0, pa1, pa2, pa3); pv_d0_b(o, V_lds + ((u) & 1) * SHM_V + vrb, pa0, pa1, pa2, pa3); __builtin_amdgcn_s_setprio(0); } while (0)
#define STG_XF(u, P0, P1) do { __builtin_amdgcn_s_setprio(1); finishSM(P0, P1, l_reg, pa0, pa1, pa2, pa3); pv_d0_b(o, V_lds + ((u) & 1) * SHM_V + vrb, pa0, pa1, pa2, pa3); __builtin_amdgcn_s_setprio(0); } while (0)
#define STG_STAGE(S, w) do { STG_WRITE(S, w); if ((w) + 2 <= NT) STG_LOAD(S, (w) + 2); } while (0)
#define STG_STAGE_U(S, w) do { const int sl_ = (w) & 1; *(MLA_LAS bf16x8*)(K_lds + sl_ * SHM_K + kst) = S.ks; *(MLA_LAS u32x2*)(K_lds + sl_ * SHM_K + krst) = S.kr; *(MLA_LAS bf16x8*)(V_lds + sl_ * SHM_V + vst) = S.vs; \
    S.ks = *reinterpret_cast<const bf16x8*>(Kg + (long)((w) + 2) * KVBLK * LDQ); S.kr = *reinterpret_cast<const u32x2*>(KRg + (long)((w) + 2) * KVBLK * LDKR); S.vs = *reinterpret_cast<const bf16x8*>(Kg + (long)((w) + 1) * KVBLK * LDQ + 64); } while (0)
#define STG_SM(FIRST, P0, P1, un) do { if constexpr (FAST) { _Pragma("unroll") for (int r_ = 0; r_ < 16; ++r_) P0[r_] = __builtin_amdgcn_exp2f(P0[r_]); } \
    else { partialSM<FIRST>(P0, P1, m_reg, zref, alpha, l_reg); STG_RESC(alpha); } kpre_load(kp, K_lds + ((un) & 1) * SHM_K, r32, hi); } while (0)
  STG_LOAD(sE, 0); STG_WRITE(sE, 0); STG_LOAD(sO, 1); STG_LOAD(sE, 2); __syncthreads();
  if (grp == 0) {
    STG_XQ(0, pA0, pA1);                                     __syncthreads();
    STG_STAGE(sO, 1); STG_SM(true, pA0, pA1, 1);             __syncthreads();
    STG_XQF(1, pB0, pB1, pA0, pA1);                          __syncthreads();
    STG_STAGE(sE, 2); STG_SM(false, pB0, pB1, 2);            __syncthreads();
#define STG_IT0(i, STAGE) do { STG_XQF(i, pA0, pA1, pB0, pB1); __syncthreads(); STAGE(sO, (i) + 1); STG_SM(false, pA0, pA1, (i) + 1); __syncthreads(); \
      STG_XQF((i) + 1, pB0, pB1, pA0, pA1); __syncthreads(); STAGE(sE, (i) + 2); STG_SM(false, pB0, pB1, (i) + 2); __syncthreads(); } while (0)
#pragma unroll 1
    for (int i = 2; i < NT - 4; i += 2) STG_IT0(i, STG_STAGE_U);
    STG_IT0(NT - 4, STG_STAGE); STG_IT0(NT - 2, STG_STAGE);
#undef STG_IT0
    STG_XF(NT, pB0, pB1);                                    __syncthreads();
                                                             __syncthreads();
  } else {
    STG_STAGE(sO, 1);                                        __syncthreads();
    STG_XQ(0, pA0, pA1);                                     __syncthreads();
    STG_STAGE(sE, 2); STG_SM(true, pA0, pA1, 1);             __syncthreads();
    STG_XQF(1, pB0, pB1, pA0, pA1);                          __syncthreads();
#define STG_IT1(i, STAGE) do { STAGE(sO, (i) + 1); STG_SM(false, pB0, pB1, (i)); __syncthreads(); STG_XQF(i, pA0, pA1, pB0, pB1); __syncthreads(); \
      STAGE(sE, (i) + 2); STG_SM(false, pA0, pA1, (i) + 1); __syncthreads(); STG_XQF((i) + 1, pB0, pB1, pA0, pA1); __syncthreads(); } while (0)
#pragma unroll 1
    for (int i = 2; i < NT - 4; i += 2) STG_IT1(i, STG_STAGE_U);
    STG_IT1(NT - 4, STG_STAGE); STG_IT1(NT - 2, STG_STAGE);
#undef STG_IT1
    STG_SM(false, pB0, pB1, NT);                             __syncthreads();
    STG_XF(NT, pB0, pB1);                                    __syncthreads();
  }
  { auto rr = __builtin_amdgcn_permlane32_swap(__float_as_uint(l_reg), __float_as_uint(l_reg), false, false); l_reg = __uint_as_float(rr[0]) + __uint_as_float(rr[1]); }
  bool unit_ok = true;
  if constexpr (FAST) {
    MLA_LAS unsigned* okf = (MLA_LAS unsigned*)(lds + SHM_ATTN);
    const bool okw = !MLA_FORCE_SAFE && __all(l_reg >= 0x1p-80f && l_reg <= 0x1p80f);
    if (lane == 0) okf[wid] = okw ? 1u : 0u;
    asm volatile("s_waitcnt lgkmcnt(0)" ::: "memory"); __syncthreads();
    unsigned acc_ok = 1u;
#pragma unroll
    for (int w = 0; w < NW; ++w) acc_ok &= okf[w];
    unit_ok = __builtin_amdgcn_readfirstlane(acc_ok) != 0u;
  }
  if (hi == 0) li_l[r32] = l_reg; asm volatile("s_waitcnt lgkmcnt(0)" ::: "memory");
  float rli[16];
#pragma unroll
  for (int r = 0; r < 16; ++r) rli[r] = __builtin_amdgcn_rcpf(li_l[crow(r, hi)]);
  bf16_t* Ow = OB + (tok0 + q0 + wid * QBLK) * LDO + h * DV;
#pragma unroll
  for (int r = 0; r < 16; r += 2) { const bool odd = (r32 & 1) != 0; const int orow = crow(r, hi) + (odd ? 1 : 0);
#pragma unroll
    for (int d0 = 0; d0 < 2; ++d0) *reinterpret_cast<unsigned*>(Ow + (long)orow * LDO + d0 * 32 + (r32 & ~1)) = pair_pack(o[d0][r] * rli[r], o[d0][r + 1] * rli[r + 1], odd); }
#undef STG_LOAD
#undef STG_WRITE
#undef STG_RESC
#undef STG_XQ
#undef STG_XQF
#undef STG_XF
#undef STG_STAGE
#undef STG_STAGE_U
#undef STG_SM
  return unit_ok;
}
}


#ifndef DIL_FORCE_SAFE
#define DIL_FORCE_SAFE 0
#endif
namespace dil2 {
using mla::bf16x8; using mla::s16x4; using mla::f32x16; using mla::u32x4; using mla::crow; using mla::cvtpk; using mla::v_st; using mla::v_rd_base; using mla::v_rd_off;
typedef unsigned short bf16_t;
constexpr int LDD = 2304, SEQ = 4096, MTOK = 8 * 4096;
constexpr float C = 0.125f * 1.4426950408889634f;
constexpr int NKT = 12, TB = 4096, LDS_K = 0, LDS_V = NKT * TB, LDS_SCR = 2 * NKT * TB, LDS_BYTES = LDS_SCR + 8 * 256;
constexpr int NSTEPS = 8 * 3 * 4 * 16;
struct Step { int b, g, hs, r, i0; };
__device__ __forceinline__ Step decode(int sidx) { Step S; const int st = sidx & 15; S.hs = (sidx >> 4) & 3; const int bg = sidx >> 6; S.g = bg % 3; S.b = bg / 3;
  const int sh = 2 * S.g; S.r = st >> (4 - sh); S.i0 = 8 * (st & ((16 >> sh) - 1)); return S; }
struct KV { u32x4 k[6], v[6]; };
__device__ __forceinline__ void kv_load(KV& R, const bf16_t* __restrict__ DQ, const Step& S, int tid) {
  const int sh = 2 * S.g, dil = 1 << sh, nb32 = (SEQ >> sh) >> 5;
  const int row = (tid >> 3) & 31, chunk = tid & 7; const long rowbase = (long)S.b * SEQ;
  const int hk = 12 + S.g * 4 + S.hs;
  const int kcol = chunk < 2 ? 16 * hk + 8 * chunk : 384 + 48 * hk + 8 * (chunk - 2), vcol = 1536 + (S.g * 4 + S.hs) * 64 + chunk * 8;
#pragma unroll
  for (int j = 0; j < 6; ++j) { const int kt = 2 * j + (tid >> 8); int ti = S.i0 - 2 + kt; ti = ti < 0 ? 0 : (ti >= nb32 ? nb32 - 1 : ti);
    const bf16_t* p = DQ + (rowbase + S.r + (long)dil * (32 * ti + row)) * LDD;
    R.k[j] = *reinterpret_cast<const u32x4*>(p + kcol); R.v[j] = *reinterpret_cast<const u32x4*>(p + vcol); }
}
__device__ __forceinline__ void kv_write(const KV& R, MLA_LAS char* lds, int tid) {
  const int row = (tid >> 3) & 31, chunk = tid & 7;
  const int ko = row * 128 + ((chunk ^ ((row >> 1) & 7)) << 4), vo = v_st(row, chunk * 8);
#pragma unroll
  for (int j = 0; j < 6; ++j) { const int kt = 2 * j + (tid >> 8);
    *(MLA_LAS u32x4*)(lds + LDS_K + kt * TB + ko) = R.k[j]; *(MLA_LAS u32x4*)(lds + LDS_V + kt * TB + vo) = R.v[j]; }
}
template <bool USE_MAX>
__device__ __forceinline__ bool block(const bf16_t* __restrict__ DQ, bf16_t* __restrict__ PART, float* __restrict__ LSE, const Step& S, int w, MLA_LAS char* lds, int lane) {
  const int r32 = lane & 31, hi = lane >> 5;
  const int sh = 2 * S.g, dil = 1 << sh, nb32 = (SEQ >> sh) >> 5;
  const int i = S.i0 + w; const long rowbase = (long)S.b * SEQ;
  const long tq = rowbase + S.r + (long)dil * (32 * i + r32);
  const int hq = S.g * 4 + S.hs; const bf16_t* Qrow = DQ + tq * LDD + hi * 8;
  bf16x8 qf[4];
  qf[0] = *reinterpret_cast<const bf16x8*>(Qrow + 16 * hq);
#pragma unroll
  for (int d0 = 1; d0 < 4; ++d0) qf[d0] = *reinterpret_cast<const bf16x8*>(Qrow + 384 + 48 * hq + 16 * (d0 - 1));
  MLA_LAS float* scr = (MLA_LAS float*)(lds + LDS_SCR + w * 256);
  const int ksw = (r32 >> 1) & 7;
  f32x16 p[5]; bool vld[5]; float mx = 0.f, ls = 0.f;
  { constexpr bool use_max = USE_MAX;
#pragma unroll
    for (int kb = 0; kb < 5; ++kb) { const int ti = i - 2 + kb; vld[kb] = (ti >= 0) && (ti < nb32);
      const MLA_LAS char* kt = lds + LDS_K + (w + kb) * TB + r32 * 128;
      p[kb] = f32x16{};
#pragma unroll
      for (int d0 = 0; d0 < 4; ++d0) { const bf16x8 kf = *reinterpret_cast<const MLA_LAS bf16x8*>(kt + (((2 * d0 + hi) ^ ksw) << 4));
        p[kb] = __builtin_amdgcn_mfma_f32_32x32x16_bf16(kf, qf[d0], p[kb], 0, 0, 0); } }
#pragma unroll
    for (int kb = 0; kb < 5; ++kb)
#pragma unroll
      for (int rr = 0; rr < 16; ++rr) { bool ok = vld[kb]; if (kb == 0) ok = ok && (crow(rr, hi) >= r32); if (kb == 4) ok = ok && (crow(rr, hi) <= r32);
        p[kb][rr] = ok ? p[kb][rr] : -1e30f; }
    mx = 0.f;
    if constexpr (use_max) {
      mx = -1e30f;
#pragma unroll
      for (int kb = 0; kb < 5; ++kb)
#pragma unroll
        for (int rr = 0; rr < 16; ++rr) mx = fmaxf(mx, p[kb][rr]);
      { auto sw = __builtin_amdgcn_permlane32_swap(__float_as_uint(mx), __float_as_uint(mx), false, false); mx = fmaxf(__uint_as_float(sw[0]), __uint_as_float(sw[1])); }
#pragma unroll
      for (int kb = 0; kb < 5; ++kb)
#pragma unroll
        for (int rr = 0; rr < 16; ++rr) p[kb][rr] -= mx;
    }
    ls = 0.f;
#pragma unroll
    for (int kb = 0; kb < 5; ++kb)
#pragma unroll
      for (int rr = 0; rr < 16; ++rr) { const float e = __builtin_amdgcn_exp2f(p[kb][rr]); p[kb][rr] = e; ls += e; }
    { auto sw = __builtin_amdgcn_permlane32_swap(__float_as_uint(ls), __float_as_uint(ls), false, false); ls = __uint_as_float(sw[0]) + __uint_as_float(sw[1]); }
  }
  if (!USE_MAX) { if (DIL_FORCE_SAFE || !__all(ls >= 0x1p-80f && ls <= 0x1p80f)) return false; }
  bf16x8 pa[10];
#define DIL2_PK4(P, BASE, OUT) do { unsigned a0 = cvtpk(P[BASE + 0], P[BASE + 1]), a1 = cvtpk(P[BASE + 2], P[BASE + 3]);   \
    unsigned b0 = cvtpk(P[BASE + 4], P[BASE + 5]), b1 = cvtpk(P[BASE + 6], P[BASE + 7]);                              \
    u32x4 wv = {a0, a1, b0, b1}; OUT = __builtin_bit_cast(bf16x8, wv); } while (0)
#pragma unroll
  for (int kb = 0; kb < 5; ++kb) { DIL2_PK4(p[kb], 0, pa[2 * kb]); DIL2_PK4(p[kb], 8, pa[2 * kb + 1]); }
#undef DIL2_PK4
  f32x16 od[2] = {};
  const MLA_LAS char* vbase = lds + LDS_V + v_rd_base(lane);
#pragma unroll
  for (int kb = 0; kb < 5; ++kb) { const MLA_LAS char* vb = vbase + (w + kb) * TB;
#define DIL2_PK(L_, H_) (bf16x8){L_[0], L_[1], L_[2], L_[3], H_[0], H_[1], H_[2], H_[3]}
    const s16x4 l0 = mla::vtr(vb + v_rd_off(0, 0, 0)), h0 = mla::vtr(vb + v_rd_off(0, 0, 1)), l1 = mla::vtr(vb + v_rd_off(0, 1, 0)), h1 = mla::vtr(vb + v_rd_off(0, 1, 1));
    const s16x4 l2 = mla::vtr(vb + v_rd_off(1, 0, 0)), h2 = mla::vtr(vb + v_rd_off(1, 0, 1)), l3 = mla::vtr(vb + v_rd_off(1, 1, 0)), h3 = mla::vtr(vb + v_rd_off(1, 1, 1));
    od[0] = __builtin_amdgcn_mfma_f32_32x32x16_bf16(pa[2 * kb], DIL2_PK(l0, h0), od[0], 0, 0, 0);
    od[0] = __builtin_amdgcn_mfma_f32_32x32x16_bf16(pa[2 * kb + 1], DIL2_PK(l1, h1), od[0], 0, 0, 0);
    od[1] = __builtin_amdgcn_mfma_f32_32x32x16_bf16(pa[2 * kb], DIL2_PK(l2, h2), od[1], 0, 0, 0);
    od[1] = __builtin_amdgcn_mfma_f32_32x32x16_bf16(pa[2 * kb + 1], DIL2_PK(l3, h3), od[1], 0, 0, 0);
#undef DIL2_PK
  }
  if (hi == 0) { scr[r32] = ls; LSE[((long)S.g * MTOK + tq) * 4 + S.hs] = mx + __builtin_amdgcn_logf(ls); }
  asm volatile("s_waitcnt lgkmcnt(0)" ::: "memory");
  float rli[16];
#pragma unroll
  for (int rr = 0; rr < 16; ++rr) rli[rr] = __builtin_amdgcn_rcpf(scr[crow(rr, hi)]);
  bf16_t* Pw = PART + ((long)S.g * MTOK + rowbase + S.r + (long)dil * (32 * i)) * 256 + S.hs * 64 + r32;
#pragma unroll
  for (int rr = 0; rr < 16; rr += 2) { const bool odd = (r32 & 1) != 0; const long ro = (long)dil * (crow(rr, hi) + (odd ? 1 : 0)) * 256 - (odd ? 1 : 0);
#pragma unroll
    for (int d0 = 0; d0 < 2; ++d0) *reinterpret_cast<unsigned*>(Pw + ro + d0 * 32) = mla::pair_pack(od[d0][rr] * rli[rr], od[d0][rr + 1] * rli[rr + 1], odd); }
  return true;
}
}

#define GAS __attribute__((address_space(1)))
#define LAS __attribute__((address_space(3)))
typedef unsigned short bf16;
typedef unsigned v4u __attribute__((ext_vector_type(4)));
typedef float f32x4 __attribute__((ext_vector_type(4)));
typedef short bf16x8 __attribute__((ext_vector_type(8)));
typedef GAS unsigned gu32;
typedef GAS unsigned long long gu64;
#define RLX_AGENT __ATOMIC_RELAXED, __HIP_MEMORY_SCOPE_AGENT
#define LDS_WAIT() asm volatile("s_waitcnt lgkmcnt(0)" ::: "memory")
#define VM_WAIT() asm volatile("s_waitcnt vmcnt(0)" ::: "memory")
__device__ __forceinline__ unsigned long long rt() { return __builtin_amdgcn_s_memrealtime(); }
__device__ __forceinline__ unsigned f2bf(float f) { unsigned u = __builtin_bit_cast(unsigned, f); return (u + 0x7fffu + ((u >> 16) & 1u)) >> 16; }
__device__ __forceinline__ unsigned pk2(float lo, float hi) { return f2bf(lo) | (f2bf(hi) << 16); }

#define XB_TMO      128
#define XB_XCNT(j)  (256  + 64 * (j))
#define XB_XSUB(j)  (1280 + 64 * (j))
#define XB_XGEN(j)  (2304 + 64 * (j))
#define XB_TOP      3328
#define XB_TOPGEN   3392
#define XCD_BAR_WORDS 3456
#define XB_SPIN_CAP (1u << 18)

__device__ __forceinline__ unsigned xb_ld(unsigned* p)              { return __hip_atomic_load(p, __ATOMIC_RELAXED, __HIP_MEMORY_SCOPE_AGENT); }
__device__ __forceinline__ unsigned xb_add(unsigned* p, unsigned v) { return __hip_atomic_fetch_add(p, v, __ATOMIC_RELAXED, __HIP_MEMORY_SCOPE_AGENT); }
__device__ __forceinline__ unsigned xb_xcc_id() { return (unsigned)__builtin_amdgcn_s_getreg((3 << 11) | 20) & 0xFu; }
#define XB_SPIN(cond, bar) do { unsigned _sp = 0; while (cond) { __builtin_amdgcn_s_sleep(1); \
    if ((++_sp & 255u) == 0u) { if (xb_ld(&(bar)[XB_TMO])) break; if (_sp > XB_SPIN_CAP) { atomicAdd(&(bar)[XB_TMO], 1u); break; } } } } while (0)

struct XcdBarrier {
    unsigned* bar; unsigned x;
    volatile LAS unsigned* st;
};

__device__ __forceinline__ XcdBarrier xcd_barrier_post(unsigned* bar, volatile LAS unsigned* st) {
    XcdBarrier b; b.bar = bar; b.x = xb_xcc_id(); b.st = st;
    if (threadIdx.x == 0) (void)xb_add(&bar[XB_XCNT(b.x)], 1u);
    return b;
}
__device__ __forceinline__ void xcd_barrier_complete(unsigned* bar, unsigned x, unsigned& nloc, unsigned& nx) {
    const unsigned G = gridDim.x * gridDim.y * gridDim.z;
    unsigned sum, cnt, mine, sp = 0u;
    for (;;) {
        sum = 0u; cnt = 0u; mine = 0u;
#pragma unroll
        for (unsigned j = 0; j < 16; ++j) { const unsigned c = xb_ld(&bar[XB_XCNT(j)]); sum += c; cnt += (c > 0u) ? 1u : 0u; mine = (j == x) ? c : mine; }
        if (sum == G) break;
        __builtin_amdgcn_s_sleep(1);
        if ((++sp & 255u) == 0u) { if (xb_ld(&bar[XB_TMO])) break; if (sp > XB_SPIN_CAP) { atomicAdd(&bar[XB_TMO], 1u); break; } }
    }
    nloc = mine > 0u ? mine : 1u; nx = cnt > 0u ? cnt : 1u;
}

__device__ __forceinline__ void xcd_barrier(const XcdBarrier& b) {
    asm volatile("s_waitcnt vmcnt(0)" ::: "memory");
    __syncthreads();
    if (threadIdx.x == 0) {
        unsigned* bar = b.bar;
        __builtin_amdgcn_s_waitcnt(0);
        unsigned nloc = b.st[0], nx = b.st[1];
        if (nloc == 0u) { xcd_barrier_complete(bar, b.x, nloc, nx); b.st[0] = nloc; b.st[1] = nx; }
        const unsigned old = xb_add(&bar[XB_XSUB(b.x)], 1u);
        const unsigned gen = old / nloc;
        if (old + 1u == (gen + 1u) * nloc) {
            __builtin_amdgcn_fence(__ATOMIC_RELEASE, "agent");
            asm volatile("s_waitcnt vmcnt(0)" ::: "memory");
            const unsigned og = xb_add(&bar[XB_TOP], 1u);
            const unsigned tg = og / nx;
            if (og + 1u == (tg + 1u) * nx) xb_add(&bar[XB_TOPGEN], 1u);
            else XB_SPIN(xb_ld(&bar[XB_TOPGEN]) == tg, bar);
            __builtin_amdgcn_fence(__ATOMIC_ACQUIRE, "agent");
            xb_add(&bar[XB_XGEN(b.x)], 1u);
            asm volatile("s_waitcnt vmcnt(0)" ::: "memory");
        } else {
            XB_SPIN(xb_ld(&bar[XB_XGEN(b.x)]) == gen, bar);
            __builtin_amdgcn_fence(__ATOMIC_ACQUIRE, "agent");
            asm volatile("s_waitcnt vmcnt(0)" ::: "memory");
        }
    }
    __syncthreads();
}


constexpr int NWAVES = 8;
#ifndef MK_PER_PHASE
#define MK_PER_PHASE 0
#endif
#ifndef PROBE_REPEAT
#define PROBE_REPEAT -1
#endif
#define REP(k) for (int rep_ = 0; rep_ < ((PROBE_REPEAT) == (k) ? 2 : 1); ++rep_)
constexpr int NPH = 18;

constexpr int BATCH = 8, SEQ = 4096, D = 1024, M = BATCH * SEQ, FF = 2816;
constexpr int NADA = 9216;
constexpr int N_CKV = 512, N_DQKV = 2304, N_GATES = 2048, N_IN = N_CKV + N_DQKV + N_GATES, K_UP = 384, N_UP = 1792, K_OM = 512, K_ODL = 256, K_OMD = K_OM + K_ODL;
constexpr float EPS = 1e-6f;

constexpr size_t MiB = 1u << 20;
constexpr size_t WS_CTL = 0, CTL_ZERO_BYTES = 64 * 1024;
constexpr size_t WS_WGU1 = 1 * MiB, WS_WD1 = WS_WGU1 + (size_t)2 * FF * D * 2, WS_WGU2 = WS_WD1 + (size_t)D * FF * 2, WS_WD2 = WS_WGU2 + (size_t)2 * FF * D * 2,
                 WS_WINA = WS_WD2 + (size_t)D * FF * 2, WS_WINB = WS_WINA + (size_t)512 * 1024 * 2, WS_WINC = WS_WINB + (size_t)2304 * 1024 * 2,
                 WS_WUP = WS_WINC + (size_t)2048 * 1024 * 2, WS_WOM = WS_WUP + (size_t)1792 * 384 * 2, WS_WODL = WS_WOM + (size_t)1024 * 512 * 2, WS_WOUT = WS_WODL + (size_t)1024 * 256 * 2,
                 WS_ADA = WS_WOUT + (size_t)1024 * 1024 * 2, WS_KR = WS_ADA + (size_t)8 * 9216 * 4, WS_ROPEM = WS_KR + (size_t)32768 * 32 * 2, WS_WEND = WS_ROPEM + (size_t)32768 * 32 * 4;
static_assert(WS_WEND <= 56 * MiB && (WS_WD1 % 256) == 0 && (WS_WINA % 256) == 0 && (WS_WUP % 256) == 0 && (WS_WOM % 256) == 0 && (WS_ADA % 256) == 0 && (WS_KR % 256) == 0 && (WS_ROPEM % 256) == 0, "weight area");
constexpr size_t WS_GATES = 56 * MiB, WS_HID = 56 * MiB, WS_DQKV = 184 * MiB, WS_MG = 184 * MiB, WS_X2 = 232 * MiB  , WS_XN = 328 * MiB, WS_Y = 392 * MiB, WS_QKVM = 328 * MiB,
                 WS_PART = 328 * MiB, WS_LSE = 376 * MiB, WS_O = 440 * MiB, WS_ODIL = 472 * MiB, WS_CKV = 456 * MiB, WS_ROPED = 456 * MiB  , WS_CN = 488 * MiB, WS_END = 512 * MiB;
static_assert(WS_HID + (size_t)M * FF * 2 <= WS_XN && WS_GATES + (size_t)M * N_GATES * 2 <= WS_DQKV && WS_DQKV + (size_t)M * N_DQKV * 2 <= WS_XN && WS_XN + (size_t)M * D * 2 <= WS_Y && WS_Y + (size_t)M * D * 2 <= WS_CKV, "ws map 4");
static_assert(WS_QKVM + (size_t)M * N_UP * 2 <= WS_O && WS_O + (size_t)M * K_OMD * 2 <= WS_CN && WS_CKV + (size_t)M * N_CKV * 2 <= WS_CN && WS_CN + (size_t)M * K_UP * 2 <= WS_END && WS_MG + (size_t)M * D * 2 <= WS_XN, "ws map 5");
constexpr int CW_BAR = 4096;
static_assert((CW_BAR + XCD_BAR_WORDS) * 4 <= (int)CTL_ZERO_BYTES, "barrier words inside the memset region");

constexpr int RING_OFF = 0, RING_BYTES = 131072;
constexpr int LDSCTL_OFF = RING_BYTES, MISC_OFF = LDSCTL_OFF + 320, EPI_RED_OFF = RING_BYTES + 4096, DIL_REDO_OFF = EPI_RED_OFF + 4096;
constexpr int LDS_BYTES = 147456;
static_assert(MISC_OFF + 128 <= EPI_RED_OFF && DIL_REDO_OFF + 64 <= LDS_BYTES && mla::SHM_ATTN <= RING_BYTES && dil2::LDS_BYTES <= RING_BYTES, "LDS map");
static_assert(WS_PART + (size_t)3 * M * 256 * 2 <= WS_LSE && WS_LSE + (size_t)3 * M * 4 * 4 <= WS_O, "ws map 6");

typedef unsigned v2u __attribute__((ext_vector_type(2)));
struct Frame {
    LAS unsigned char* lds;
    volatile LAS unsigned* MISC;
    gu32* ctl;
    int tid, lane, wave;
    int vcu, G;
    unsigned char* ws;
    bf16* part; float* lse;
};
__device__ __forceinline__ float wave_sum(float v) {
#pragma unroll
    for (int o = 1; o < 64; o <<= 1) v += __shfl_xor(v, o);
    return v;
}
__device__ __forceinline__ float bflo(unsigned w) { return __uint_as_float(w << 16); }
__device__ __forceinline__ float bfhi(unsigned w) { return __uint_as_float(w & 0xffff0000u); }
__device__ __forceinline__ float bf1(bf16 h) { return __uint_as_float((unsigned)h << 16); }

__device__ __forceinline__ void transpose_item(const float* W, int N, int k0, int n0, bf16* WT, int ldk, int drow0, int kd0, LAS float* scr, int lane, float wscale = 1.0f, int srow = -1) {
#pragma unroll 8
    for (int i = 0; i < 32; ++i) { const int kk = 2 * i + (lane >> 5); scr[kk * 33 + (lane & 31)] = W[(size_t)(k0 + kk) * N + n0 + (lane & 31)] * wscale; }
    LDS_WAIT(); asm volatile("" ::: "memory");
    const int c = lane & 7;
#pragma unroll
    for (int j = 0; j < 4; ++j) { const int n = (lane >> 3) + 8 * j; const LAS float* s = scr + (8 * c) * 33 + n;
        v4u o; o.x = pk2(s[0 * 33], s[1 * 33]); o.y = pk2(s[2 * 33], s[3 * 33]); o.z = pk2(s[4 * 33], s[5 * 33]); o.w = pk2(s[6 * 33], s[7 * 33]);
        const int drow = (srow >= 0 && n >= 16) ? srow + n - 16 : drow0 + n;
        *(GAS v4u*)(WT + (size_t)drow * ldk + kd0 + 8 * c) = o; }
    LDS_WAIT(); asm volatile("" ::: "memory");
}
__device__ __forceinline__ void zero_bytes(unsigned char* p, int nbytes, int lane) {
    const v4u z = {0u, 0u, 0u, 0u};
    for (int o = lane * 16; o < nbytes; o += 1024) *(GAS v4u*)(p + o) = z;
}
__device__ __forceinline__ int pair_row(int n0) { return 256 * (n0 >> 7) + (n0 & 127); }

struct Args { const void* in[25]; float* out; unsigned char* ws; int ph_lo, ph_hi, li, pad; };
enum { I_X = 0, I_C, I_POS, I_WADA, I_BADA, I_GPRE1, I_WG1, I_WU1, I_WD1, I_GPOST1, I_GPREM, I_WIN, I_GCQ, I_WUQ, I_GCKV, I_WUKV, I_WOMLA, I_WODIL, I_WOUT, I_GPOSTM, I_GPRE2, I_WG2, I_WU2, I_WD2, I_GPOST2 };

__device__ __forceinline__ void p0_prologue(Frame& F, const Args& A) {
    const float* c = (const float*)A.in[I_C]; const float* w_ada = (const float*)A.in[I_WADA]; const float* b_ada = (const float*)A.in[I_BADA];
    float* ada = (float*)(F.ws + WS_ADA);
    for (int g = F.vcu; g < NADA / 64; g += F.G) {
        LAS float* sc = (LAS float*)(F.lds + RING_OFF); LAS float* red = (LAS float*)(F.lds + RING_OFF + 32768);
        for (int i = F.tid; i < BATCH * D; i += NWAVES * 64) { const float v = c[i]; sc[i] = v / (1.0f + __expf(-v)); }
        __syncthreads();
        float acc[BATCH];
#pragma unroll
        for (int b = 0; b < BATCH; ++b) acc[b] = 0.f;
        const int col = 64 * g + F.lane;
#pragma unroll 1
        for (int k0 = 0; k0 < 128; k0 += 32) {
            float w[32];
#pragma unroll
            for (int j = 0; j < 32; ++j) w[j] = w_ada[(size_t)(128 * F.wave + k0 + j) * NADA + col];
#pragma unroll
            for (int j = 0; j < 32; ++j) { const int k = 128 * F.wave + k0 + j;
#pragma unroll
                for (int b = 0; b < BATCH; ++b) acc[b] += sc[b * D + k] * w[j]; } }
#pragma unroll
        for (int b = 0; b < BATCH; ++b) red[(F.wave * BATCH + b) * 64 + F.lane] = acc[b];
        __syncthreads();
        { const int b = F.tid >> 6; float s = 0.f;
#pragma unroll
          for (int w8 = 0; w8 < NWAVES; ++w8) s += red[(w8 * BATCH + b) * 64 + F.lane];
          ada[(size_t)b * NADA + col] = s + b_ada[col]; }
        __syncthreads();
    }
    LAS float* scr = (LAS float*)(F.lds + RING_OFF + F.wave * 16384);
    const int gw = F.vcu * NWAVES + F.wave, NGW = F.G * NWAVES;
    bf16* WGU1 = (bf16*)(F.ws + WS_WGU1); bf16* WD1 = (bf16*)(F.ws + WS_WD1); bf16* WGU2 = (bf16*)(F.ws + WS_WGU2); bf16* WD2 = (bf16*)(F.ws + WS_WD2);
    bf16* WINA = (bf16*)(F.ws + WS_WINA); bf16* WINB = (bf16*)(F.ws + WS_WINB); bf16* WINC = (bf16*)(F.ws + WS_WINC);
    bf16* WUP = (bf16*)(F.ws + WS_WUP); bf16* WOM = (bf16*)(F.ws + WS_WOM); bf16* WODL = (bf16*)(F.ws + WS_WODL); bf16* WOUT = (bf16*)(F.ws + WS_WOUT);
    constexpr int I_GU = (D / 64) * (FF / 32);
    constexpr int I_DN = (FF / 64) * (D / 32);
    constexpr int I_IN = (D / 64) * (4768 / 32);
    constexpr int I_UQ = (256 / 64) * (768 / 32);
    constexpr int I_UKV = (128 / 64) * (1024 / 32);
    constexpr int I_OM = (512 / 64) * (D / 32);
    constexpr int I_ODL = (256 / 64) * (D / 32);
    constexpr int I_OUT = (D / 64) * (D / 32);
    constexpr int Z_A = 96, Z_UP = N_UP;
    constexpr int NITEMS = 4 * I_GU + 2 * I_DN + I_IN + I_UQ + I_UKV + I_OM + I_ODL + I_OUT + Z_A + Z_UP;
    for (int it = gw; it < NITEMS; it += NGW) {
        int r = it;
        if (r < 4 * I_GU) {
            const int which = r / I_GU; r -= which * I_GU; const int nblk = FF / 32, kb = r / nblk, nb = r % nblk, n0 = 32 * nb;
            const float* W = which == 0 ? (const float*)A.in[I_WG1] : which == 1 ? (const float*)A.in[I_WU1] : which == 2 ? (const float*)A.in[I_WG2] : (const float*)A.in[I_WU2];
            transpose_item(W, FF, 64 * kb, n0, which < 2 ? WGU1 : WGU2, D, pair_row(n0) + (which & 1) * 128, 64 * kb, scr, F.lane, (which & 1) ? -0.6931471805599453f : -1.4426950408889634f); continue; }
        r -= 4 * I_GU;
        if (r < 2 * I_DN) { const int which = r / I_DN; r -= which * I_DN; const int nblk = D / 32, kb = r / nblk, nb = r % nblk;
            transpose_item(which ? (const float*)A.in[I_WD2] : (const float*)A.in[I_WD1], D, 64 * kb, 32 * nb, which ? WD2 : WD1, FF, 32 * nb, 64 * kb, scr, F.lane); continue; }
        r -= 2 * I_DN;
        if (r < I_IN) { const int nblk = 4768 / 32, kb = r / nblk, nb = r % nblk, n0 = 32 * nb;
            bf16* dst; int drow, srow = -1;
            if (n0 < 416) { dst = WINA; drow = n0; } else if (n0 < 2720) { dst = WINB; const int q = n0 - 416;
                if (q < 1536) { const int h = q >> 6; if ((q & 63) == 0) { drow = 16 * h; srow = 384 + 48 * h; } else drow = 384 + 48 * h + 16; } else drow = q; }
            else { dst = WINC; drow = n0 - 2720; }
            const float wsc = (n0 >= 416 && n0 < 416 + 768) ? dil2::C : 1.0f;
            transpose_item((const float*)A.in[I_WIN], 4768, 64 * kb, n0, dst, D, drow, 64 * kb, scr, F.lane, wsc, srow); continue; }
        r -= I_IN;
        if (r < I_UQ) { const int nblk = 768 / 32, kb = r / nblk, nb = r % nblk;
            transpose_item((const float*)A.in[I_WUQ], 768, 64 * kb, 32 * nb, WUP, K_UP, 32 * nb, 64 * kb, scr, F.lane, mla::SCALE * 1.4426950408889634f); continue; }
        r -= I_UQ;
        if (r < I_UKV) { const int nblk = 1024 / 32, kb = r / nblk, nb = r % nblk;
            transpose_item((const float*)A.in[I_WUKV], 1024, 64 * kb, 32 * nb, WUP, K_UP, 768 + 32 * nb, 256 + 64 * kb, scr, F.lane); continue; }
        r -= I_UKV;
        if (r < I_OM) { const int nblk = D / 32, kb = r / nblk, nb = r % nblk;
            transpose_item((const float*)A.in[I_WOMLA], D, 64 * kb, 32 * nb, WOM, K_OMD, 32 * nb, 64 * kb, scr, F.lane); continue; }
        r -= I_OM;
        if (r < I_ODL) { const int nblk = D / 32, kb = r / nblk, nb = r % nblk;
            transpose_item((const float*)A.in[I_WODIL], D, 64 * kb, 32 * nb, WOM, K_OMD, 32 * nb, K_OM + 64 * kb, scr, F.lane); continue; }
        r -= I_ODL;
        if (r < I_OUT) { const int nblk = D / 32, kb = r / nblk, nb = r % nblk;
            transpose_item((const float*)A.in[I_WOUT], D, 64 * kb, 32 * nb, WOUT, D, 32 * nb, 64 * kb, scr, F.lane); continue; }
        r -= I_OUT;
        if (r < Z_A) { zero_bytes((unsigned char*)(WINA + (size_t)(416 + r) * D), D * 2, F.lane); continue; }
        r -= Z_A;
        { unsigned char* row = (unsigned char*)(WUP + (size_t)r * K_UP); if (r < 768) zero_bytes(row + 512, 256, F.lane); else zero_bytes(row, 512, F.lane); }
    }
}

struct RowBuf { f32x4 x[4]; v2u xb[4]; v2u y[4]; int pos; };
struct RopeTab { const int* positions; float* ropem; float* roped; float inv; };
template <int MODE, bool XI_BF>
__device__ __forceinline__ void rp_load(RowBuf& B, const float* xi, const bf16* xib, const bf16* y, int m, int lane, const RopeTab& RT) {
    if (MODE == 0) B.pos = RT.positions[m];
#pragma unroll
    for (int j = 0; j < 4; ++j) {
        if (XI_BF) B.xb[j] = *(const GAS v2u*)(xib + (size_t)m * D + 256 * j + 4 * lane); else B.x[j] = *(const GAS f32x4*)(xi + (size_t)m * D + 256 * j + 4 * lane);
        if (MODE != 0) B.y[j] = *(const GAS v2u*)(y + (size_t)m * D + 256 * j + 4 * lane); }
}
template <int MODE, bool XI_BF, bool XO_BF>
__device__ __forceinline__ void rp_process(int m, int lane, f32x4 (&v)[4], const v2u (&yw)[4], float* xo, bf16* xob, bf16* XN, const float* g_post, const float* gate, float cg,
                                           const float* g_pre, const float* shift, const float* scale, int pos, const RopeTab& RT) {
    const int b = m >> 12;
    if (MODE == 0) {
        float sn, cs; sincosf((float)pos * RT.inv, &sn, &cs);
        if (lane < 16) { RT.ropem[(size_t)m * 32 + lane] = cs; RT.ropem[(size_t)m * 32 + 16 + lane] = sn; }
        else if (lane < 24) { RT.roped[(size_t)m * 16 + (lane - 16)] = cs; RT.roped[(size_t)m * 16 + 8 + (lane - 16)] = sn; }
    }
    if (MODE != 0) {
        f32x4 yv[4]; float s = 0.f;
#pragma unroll
        for (int j = 0; j < 4; ++j) { const v2u w = yw[j];
            yv[j] = (f32x4){bflo(w.x), bfhi(w.x), bflo(w.y), bfhi(w.y)}; s += (yv[j].x * yv[j].x + yv[j].y * yv[j].y) + (yv[j].z * yv[j].z + yv[j].w * yv[j].w); }
        const float rstd = 1.0f / sqrtf(wave_sum(s) * (1.0f / D) + EPS);
#pragma unroll
        for (int j = 0; j < 4; ++j) { const int col = 256 * j + 4 * lane;
            const f32x4 gp = *(const GAS f32x4*)(g_post + col), gt = *(const GAS f32x4*)(gate + (size_t)b * NADA + col);
            v[j] = v[j] + (gt * cg) * (yv[j] * rstd * gp);
            if (XO_BF) { v2u o; o.x = pk2(v[j].x, v[j].y); o.y = pk2(v[j].z, v[j].w); *(GAS v2u*)(xob + (size_t)m * D + col) = o; }
            else *(GAS f32x4*)(xo + (size_t)m * D + col) = v[j]; }
    }
    if (MODE != 2) {
        float s = 0.f;
#pragma unroll
        for (int j = 0; j < 4; ++j) s += (v[j].x * v[j].x + v[j].y * v[j].y) + (v[j].z * v[j].z + v[j].w * v[j].w);
        const float rstd = 1.0f / sqrtf(wave_sum(s) * (1.0f / D) + EPS);
#pragma unroll
        for (int j = 0; j < 4; ++j) { const int col = 256 * j + 4 * lane;
            const f32x4 gp = *(const GAS f32x4*)(g_pre + col), sh = *(const GAS f32x4*)(shift + (size_t)b * NADA + col), sc = *(const GAS f32x4*)(scale + (size_t)b * NADA + col);
            const f32x4 h = (v[j] * rstd * gp) * (sc + 1.0f) + sh;
            v2u o; o.x = pk2(h.x, h.y); o.y = pk2(h.z, h.w);
            *(GAS v2u*)(XN + (size_t)m * D + col) = o; }
    }
}
template <int MODE, bool XI_BF = false, bool XO_BF = false>
__device__ __forceinline__ void row_pass(Frame& F, const void* xi_, const bf16* y, void* xo_, bf16* XN, const float* g_post, const float* gate, float cg,
                                         const float* g_pre, const float* shift, const float* scale, const RopeTab RT = RopeTab{nullptr, nullptr, nullptr, 0.f}) {
    const float* xi = (const float*)xi_; const bf16* xib = (const bf16*)xi_; float* xo = (float*)xo_; bf16* xob = (bf16*)xo_;
    int gw = F.vcu * NWAVES + F.wave, lane = F.lane; const int NGW = F.G * NWAVES;
    asm volatile("" : "+s"(gw), "+v"(lane));
    RowBuf A, B;
    if (gw < M) rp_load<MODE, XI_BF>(A, xi, xib, y, gw, lane, RT);
    if (gw + NGW < M) rp_load<MODE, XI_BF>(B, xi, xib, y, gw + NGW, lane, RT);
    for (int m = gw; m < M; m += 2 * NGW) {
        { f32x4 v[4]; v2u yw[4];
#pragma unroll
          for (int j = 0; j < 4; ++j) { if (XI_BF) v[j] = (f32x4){bflo(A.xb[j].x), bfhi(A.xb[j].x), bflo(A.xb[j].y), bfhi(A.xb[j].y)}; else v[j] = A.x[j]; yw[j] = A.y[j]; }
          const int posA = (MODE == 0) ? A.pos : 0;
          if (m + 2 * NGW < M) rp_load<MODE, XI_BF>(A, xi, xib, y, m + 2 * NGW, lane, RT);
          rp_process<MODE, XI_BF, XO_BF>(m, lane, v, yw, xo, xob, XN, g_post, gate, cg, g_pre, shift, scale, posA, RT); }
        if (m + NGW < M) { f32x4 v[4]; v2u yw[4];
#pragma unroll
          for (int j = 0; j < 4; ++j) { if (XI_BF) v[j] = (f32x4){bflo(B.xb[j].x), bfhi(B.xb[j].x), bflo(B.xb[j].y), bfhi(B.xb[j].y)}; else v[j] = B.x[j]; yw[j] = B.y[j]; }
          const int posB = (MODE == 0) ? B.pos : 0;
          if (m + 3 * NGW < M) rp_load<MODE, XI_BF>(B, xi, xib, y, m + 3 * NGW, lane, RT);
          rp_process<MODE, XI_BF, XO_BF>(m + NGW, lane, v, yw, xo, xob, XN, g_post, gate, cg, g_pre, shift, scale, posB, RT); }
    }
}


struct PrepBuf { int pos; v2u cq; unsigned ckv; unsigned short t1, t2; v4u a, b; };
__device__ __forceinline__ void prep_load(PrepBuf& P, const int* positions, const bf16* CKV, const bf16* DQ, int m, int lane) {
    P.pos = positions[m];
    P.cq = *(const GAS v2u*)(CKV + (size_t)m * N_CKV + 4 * lane);
    P.ckv = *(const GAS unsigned*)(CKV + (size_t)m * N_CKV + 256 + 2 * lane);
    P.t1 = 0; P.t2 = 0; if (lane < 16) { P.t1 = CKV[(size_t)m * N_CKV + 384 + lane]; P.t2 = CKV[(size_t)m * N_CKV + 400 + lane]; }
    P.a = (v4u){0u, 0u, 0u, 0u}; P.b = P.a; if (lane < 24) { const GAS v4u* qp = (const GAS v4u*)(DQ + (size_t)m * N_DQKV + lane * 16); P.a = qp[0]; P.b = qp[1]; }
}
__device__ __forceinline__ void mix_prep(Frame& F, const Args& A) {
    const bf16* CKV = (const bf16*)(F.ws + WS_CKV); bf16* CN = (bf16*)(F.ws + WS_CN); bf16* KR = (bf16*)(F.ws + WS_KR); bf16* DQ = (bf16*)(F.ws + WS_DQKV); float* ROPEM = (float*)(F.ws + WS_ROPEM);
    const float* g_cq = (const float*)A.in[I_GCQ]; const float* g_ckv = (const float*)A.in[I_GCKV]; const int* positions = (const int*)A.in[I_POS];
    const int gw = F.vcu * NWAVES + F.wave, NGW = F.G * NWAVES, lane = F.lane;
    const f32x4 gq = *(const GAS f32x4*)(g_cq + 4 * lane); const float gk0 = g_ckv[2 * lane], gk1 = g_ckv[2 * lane + 1];
    const float inv = lane < 16 ? exp2f(-(float)lane * (13.287712379549449f / 16.0f)) : exp2f(-(float)(lane & 7) * (18.931568569324174f / 8.0f));
    PrepBuf N; if (gw < M) prep_load(N, positions, CKV, DQ, gw, lane);
    for (int m = gw; m < M; m += NGW) {
        const PrepBuf C = N;
        if (m + NGW < M) prep_load(N, positions, CKV, DQ, m + NGW, lane);
        const float pos = (float)C.pos;
        float sn, cs; sincosf(pos * inv, &sn, &cs);
        { const float a0 = bflo(C.cq.x), a1 = bfhi(C.cq.x), a2 = bflo(C.cq.y), a3 = bfhi(C.cq.y);
          const float rstd = 1.0f / sqrtf(wave_sum((a0 * a0 + a1 * a1) + (a2 * a2 + a3 * a3)) * (1.0f / 256.0f) + EPS);
          v2u o; o.x = pk2(a0 * rstd * gq.x, a1 * rstd * gq.y); o.y = pk2(a2 * rstd * gq.z, a3 * rstd * gq.w);
          *(GAS v2u*)(CN + (size_t)m * K_UP + 4 * lane) = o; }
        { const float a0 = bflo(C.ckv), a1 = bfhi(C.ckv);
          const float rstd = 1.0f / sqrtf(wave_sum(a0 * a0 + a1 * a1) * (1.0f / 128.0f) + EPS);
          *(GAS unsigned*)(CN + (size_t)m * K_UP + 256 + 2 * lane) = pk2(a0 * rstd * gk0, a1 * rstd * gk1); }
        if (lane < 16) {
            const float t1 = bf1(C.t1), t2 = bf1(C.t2);
            KR[(size_t)m * 32 + lane] = (bf16)f2bf(t1 * cs - t2 * sn); KR[(size_t)m * 32 + 16 + lane] = (bf16)f2bf(t2 * cs + t1 * sn);
            ROPEM[(size_t)m * 32 + lane] = cs; ROPEM[(size_t)m * 32 + 16 + lane] = sn;
        }
        {
            float cj[8], sj[8];
#pragma unroll
            for (int j = 0; j < 8; ++j) { cj[j] = __shfl(cs, 16 + j); sj[j] = __shfl(sn, 16 + j); }
            if (lane < 24) { GAS v4u* qp = (GAS v4u*)(DQ + (size_t)m * N_DQKV + lane * 16);
                v4u oa, ob;
#pragma unroll
                for (int k = 0; k < 4; ++k) { const float t1l = bflo(C.a[k]), t1h = bfhi(C.a[k]), t2l = bflo(C.b[k]), t2h = bfhi(C.b[k]);
                    oa[k] = pk2(t1l * cj[2 * k] - t2l * sj[2 * k], t1h * cj[2 * k + 1] - t2h * sj[2 * k + 1]);
                    ob[k] = pk2(t2l * cj[2 * k] + t1l * sj[2 * k], t2h * cj[2 * k + 1] + t1h * sj[2 * k + 1]); }
                qp[0] = oa; qp[1] = ob; }
        }
    }
}
__device__ __forceinline__ void dil_attn_coop(Frame& F) {
    LAS char* lds = (LAS char*)(F.lds + RING_OFF);
    const dil2::bf16_t* DQ = (const dil2::bf16_t*)(F.ws + WS_DQKV);
    const int per = (dil2::NSTEPS + F.G - 1) / F.G; const int s0 = F.vcu * per, s1 = (s0 + per < dil2::NSTEPS) ? s0 + per : dil2::NSTEPS;
    dil2::KV R;
    if (s0 < s1) { const dil2::Step S = dil2::decode(s0); dil2::kv_load(R, DQ, S, F.tid); }
    for (int si = s0; si < s1; ++si) {
        const dil2::Step S = dil2::decode(si);
        dil2::kv_write(R, lds, F.tid);
        __syncthreads();
        if (si + 1 < s1) { const dil2::Step N = dil2::decode(si + 1); dil2::kv_load(R, DQ, N, F.tid); }
        LAS unsigned* redo = (LAS unsigned*)(F.lds + DIL_REDO_OFF);
        if (!dil2::block<false>(DQ, (dil2::bf16_t*)F.part, F.lse, S, F.wave, lds, F.lane)) { if (F.lane == 0) redo[0] = 1u; }
        asm volatile("s_waitcnt lgkmcnt(0)" ::: "memory");
        __syncthreads();
        if (redo[0] != 0u) {
            const dil2::bf16_t* DQ2 = DQ; int ln = F.lane; asm volatile("" : "+s"(DQ2), "+v"(ln));
            dil2::block<true>(DQ2, (dil2::bf16_t*)F.part, F.lse, S, F.wave, lds, ln);
            __syncthreads(); if (F.tid == 0) redo[0] = 0u; asm volatile("s_waitcnt lgkmcnt(0)" ::: "memory"); __syncthreads(); }
    }
}
__device__ __forceinline__ void dil_combine(Frame& F) {
    const bf16* PART = (const bf16*)F.part; const float* LSE = F.lse; bf16* OB = (bf16*)(F.ws + WS_O) + K_OM;
    const int gw = F.vcu * NWAVES + F.wave, NGW = F.G * NWAVES, lane = F.lane, hs = lane >> 4;
    float nl[3]; v2u nw[3];
#define DC_LOAD(mm) do { _Pragma("unroll") for (int g = 0; g < 3; ++g) { nl[g] = LSE[((size_t)g * M + (mm)) * 4 + hs]; nw[g] = *(const GAS v2u*)(PART + ((size_t)g * M + (mm)) * 256 + 4 * lane); } } while (0)
    if (gw < M) DC_LOAD(gw);
    for (int m = gw; m < M; m += NGW) {
        float l[3]; v2u w[3];
#pragma unroll
        for (int g = 0; g < 3; ++g) { l[g] = nl[g]; w[g] = nw[g]; }
        if (m + NGW < M) DC_LOAD(m + NGW);
        const float mx = fmaxf(l[0], fmaxf(l[1], l[2]));
        const float e0 = exp2f(l[0] - mx), e1 = exp2f(l[1] - mx), e2 = exp2f(l[2] - mx), inv = 1.0f / (e0 + e1 + e2);
        const float a0 = e0 * inv, a1 = e1 * inv, a2 = e2 * inv;
        v2u o;
        o.x = pk2(a0 * bflo(w[0].x) + a1 * bflo(w[1].x) + a2 * bflo(w[2].x), a0 * bfhi(w[0].x) + a1 * bfhi(w[1].x) + a2 * bfhi(w[2].x));
        o.y = pk2(a0 * bflo(w[0].y) + a1 * bflo(w[1].y) + a2 * bflo(w[2].y), a0 * bfhi(w[0].y) + a1 * bfhi(w[1].y) + a2 * bfhi(w[2].y));
        *(GAS v2u*)(OB + (size_t)m * K_OMD + 4 * lane) = o;
    }
#undef DC_LOAD
}

__global__ void __launch_bounds__(NWAVES * 64, 2) mk_fwd(Args args) {
    extern __shared__ __attribute__((aligned(16))) unsigned char lds[];
    Frame F;
    F.lds = (LAS unsigned char*)lds;
    F.MISC = (volatile LAS unsigned*)(F.lds + MISC_OFF);
    F.tid = threadIdx.x; F.lane = F.tid & 63; F.wave = __builtin_amdgcn_readfirstlane(F.tid >> 6);
    F.G = gridDim.x; { const int bx = blockIdx.x; F.vcu = (F.G % 8 == 0) ? (bx % 8) * (F.G / 8) + bx / 8 : bx; }
    F.ws = args.ws; F.ctl = (gu32*)(args.ws + WS_CTL);
    F.part = (bf16*)((unsigned char*)args.out + (size_t)64 * MiB); F.lse = (float*)((unsigned char*)args.out + (size_t)64 * MiB + (size_t)3 * M * 256 * 2);
    for (int u = F.tid; u < (LDS_BYTES - LDSCTL_OFF) / 4; u += NWAVES * 64) ((LAS unsigned*)(F.lds + LDSCTL_OFF))[u] = 0u;
    __syncthreads();
    XcdBarrier bar; bar.bar = (unsigned*)(F.ctl + CW_BAR); bar.x = 0; bar.st = nullptr;
    if (!MK_PER_PHASE) bar = xcd_barrier_post((unsigned*)(F.ctl + CW_BAR), F.MISC + 8);
#define GRID_BAR() do { if (!MK_PER_PHASE) xcd_barrier(bar); } while (0)
    const int lo = args.ph_lo, hi = args.ph_hi;
#define IN(k) (lo <= (k) && (k) < hi)
#define BOTH(k) (IN(k) && IN((k) + 1))
    const float* x = (const float*)args.in[I_X]; float* out = args.out;
    const float* ada = (const float*)(F.ws + WS_ADA);
    bf16* XN = (bf16*)(F.ws + WS_XN); bf16* HID = (bf16*)(F.ws + WS_HID); bf16* Y = (bf16*)(F.ws + WS_Y);
    typedef pg8::bf16_t pb;

    if (IN(0)) REP(0) { p0_prologue(F, args); if (BOTH(0)) GRID_BAR(); }
    if (IN(1)) REP(1) {
        const float inv = F.lane < 16 ? exp2f(-(float)F.lane * (13.287712379549449f / 16.0f)) : exp2f(-(float)(F.lane & 7) * (18.931568569324174f / 8.0f));
        const RopeTab RT{(const int*)args.in[I_POS], (float*)(F.ws + WS_ROPEM), (float*)(F.ws + WS_ROPED), inv};
        row_pass<0>(F, x, nullptr, nullptr, XN, nullptr, nullptr, 0.f, (const float*)args.in[I_GPRE1], ada + 0 * D, ada + 1 * D, RT); if (BOTH(1)) GRID_BAR(); }
    if (IN(2)) REP(2) { pg8::Gemm g{(const pb*)XN, (const pb*)(F.ws + WS_WGU1), M, 2 * FF, D}; pg8::StaticOrder S; S.init(M, 2 * FF, F.G, (int)blockIdx.x);
        pg8::EpiSwiGLU E{(pb*)HID, FF}; pg8::gemm_phase<pg8::EpiSwiGLU, pg8::StaticOrder, PG8_ALIGN, PG8_SP2>(F.lds + RING_OFF, g, S, E); if (BOTH(2)) GRID_BAR(); }
    if (IN(3)) REP(3) { pg8::Gemm g{(const pb*)HID, (const pb*)(F.ws + WS_WD1), M, D, FF}; pg8::StaticOrder S; S.init(M, D, F.G, (int)blockIdx.x);
        pg8::EpiBf16 E{(pb*)Y, D}; pg8::gemm_phase<pg8::EpiBf16, pg8::StaticOrder, PG8_ALIGN, PG8_SP2>(F.lds + RING_OFF, g, S, E); if (BOTH(3)) GRID_BAR(); }
    if (IN(4)) { row_pass<1, false, true>(F, x, Y, out  , XN, (const float*)args.in[I_GPOST1], ada + 2 * D, 0.5f, (const float*)args.in[I_GPREM], ada + 3 * D, ada + 4 * D); if (BOTH(4)) GRID_BAR(); }
    if (IN(5)) REP(5) { pg8::Gemm g{(const pb*)XN, (const pb*)(F.ws + WS_WINA), M, N_IN, D}; pg8::StaticOrder S; S.init(M, N_IN, F.G, (int)blockIdx.x);
        pg8::EpiIn E{(pb*)(F.ws + WS_CN), (pb*)(F.ws + WS_KR), (pb*)(F.ws + WS_DQKV), (pb*)(F.ws + WS_GATES), (const float*)args.in[I_GCQ], (const float*)args.in[I_GCKV],
                     (const float*)(F.ws + WS_ROPEM), (const float*)(F.ws + WS_ROPED), (LAS float*)(F.lds + EPI_RED_OFF), EPS};
        pg8::gemm_phase<pg8::EpiIn, pg8::StaticOrder, PG8_ALIGN, PG8_SP2>(F.lds + RING_OFF, g, S, E); if (IN(5) && IN(7)) GRID_BAR(); }
    if (IN(10)) REP(10) { dil_attn_coop(F); __syncthreads(); }
    if (IN(7)) REP(7) { pg8::Gemm g{(const pb*)(F.ws + WS_CN), (const pb*)(F.ws + WS_WUP), M, N_UP, K_UP}; pg8::UpOrder S; S.init(M, N_UP, F.G, (int)blockIdx.x);
        pg8::EpiBf16 E{(pb*)(F.ws + WS_QKVM), N_UP}; pg8::gemm_phase<pg8::EpiBf16, pg8::UpOrder, PG8_ALIGN, PG8_SP2, true>(F.lds + RING_OFF, g, S, E); if (BOTH(7)) GRID_BAR(); }
    if (IN(9)) REP(9) {
        const int NU = BATCH * 8 * (SEQ / 256), per = NU / F.G; const bool even = (NU % F.G) == 0;
        for (int i = 0;; ++i) { int un; if (even) { if (i >= per) break; un = F.vcu * per + i; } else { un = F.vcu + i * F.G; if (un >= NU) break; }
            const int bh = un >> 4, qb = un & 15;
            const mla::bf16_t* qkvm = (const mla::bf16_t*)(F.ws + WS_QKVM); const mla::bf16_t* krp = (const mla::bf16_t*)(F.ws + WS_KR); mla::bf16_t* op = (mla::bf16_t*)(F.ws + WS_O); const float* ropem = (const float*)(F.ws + WS_ROPEM);
            if (!mla::attn_unit_stag<true>(qkvm, krp, op, ropem, bh >> 3, bh & 7, qb * 256, (LAS char*)(F.lds + RING_OFF))) {
                __syncthreads();
                mla::attn_unit_stag<false>(qkvm, krp, op, ropem, bh >> 3, bh & 7, qb * 256, (LAS char*)(F.lds + RING_OFF)); } }
        __syncthreads(); }
    if (IN(11)) REP(11) { dil_combine(F); if (BOTH(11)) GRID_BAR(); }
    if (IN(12)) REP(12) {
        { pg8::Gemm g{(const pb*)(F.ws + WS_O), (const pb*)(F.ws + WS_WOM), M, D, K_OMD}; pg8::StaticOrder S; S.init(M, D, F.G, (int)blockIdx.x);
          pg8::EpiGate2 E{(pb*)(F.ws + WS_MG), D, (const pb*)(F.ws + WS_GATES), N_GATES, D}; pg8::gemm_phase<pg8::EpiGate2, pg8::StaticOrder, PG8_ALIGN, PG8_SP2, true>(F.lds + RING_OFF, g, S, E); }
        if (BOTH(12)) GRID_BAR(); }
    if (IN(13)) REP(13) { pg8::Gemm g{(const pb*)(F.ws + WS_MG), (const pb*)(F.ws + WS_WOUT), M, D, D}; pg8::StaticOrder S; S.init(M, D, F.G, (int)blockIdx.x);
        pg8::EpiBf16 E{(pb*)Y, D}; pg8::gemm_phase<pg8::EpiBf16, pg8::StaticOrder, PG8_ALIGN, PG8_SP2>(F.lds + RING_OFF, g, S, E); if (BOTH(13)) GRID_BAR(); }
    if (IN(14)) { row_pass<1, true, true>(F, out, Y, F.ws + WS_X2  , XN, (const float*)args.in[I_GPOSTM], ada + 5 * D, 1.0f, (const float*)args.in[I_GPRE2], ada + 6 * D, ada + 7 * D); if (BOTH(14)) GRID_BAR(); }
    if (IN(15)) REP(15) { pg8::Gemm g{(const pb*)XN, (const pb*)(F.ws + WS_WGU2), M, 2 * FF, D}; pg8::StaticOrder S; S.init(M, 2 * FF, F.G, (int)blockIdx.x);
        pg8::EpiSwiGLU E{(pb*)HID, FF}; pg8::gemm_phase<pg8::EpiSwiGLU, pg8::StaticOrder, PG8_ALIGN, PG8_SP2>(F.lds + RING_OFF, g, S, E); if (BOTH(15)) GRID_BAR(); }
    if (IN(16)) REP(16) { pg8::Gemm g{(const pb*)HID, (const pb*)(F.ws + WS_WD2), M, D, FF}; pg8::StaticOrder S; S.init(M, D, F.G, (int)blockIdx.x);
        pg8::EpiBf16 E{(pb*)Y, D}; pg8::gemm_phase<pg8::EpiBf16, pg8::StaticOrder, PG8_ALIGN, PG8_SP2>(F.lds + RING_OFF, g, S, E); if (BOTH(16)) GRID_BAR(); }
    if (IN(17)) { row_pass<2, true, false>(F, F.ws + WS_X2, Y, out, nullptr, (const float*)args.in[I_GPOST2], ada + 8 * D, 0.5f, nullptr, nullptr, nullptr); }
#undef IN
#undef BOTH
#undef GRID_BAR
}

extern "C" void kernel_launch(void* const* d_in, const int* in_sizes, int n_in, void* d_out, int out_size, void* d_ws, size_t ws_size, hipStream_t stream) {
    static int grid = 0;
    if (grid == 0) {
        if (n_in != 25 || in_sizes[0] != M * D || out_size != M * D || ws_size < WS_END) { fprintf(stderr, "kernel_launch: shape mismatch: n_in %d in0 %d out %d ws %zu (need >= %zu)\n", n_in, n_in > 0 ? in_sizes[0] : -1, out_size, ws_size, (size_t)WS_END); grid = -1; return; }
        int dev = 0, cus = 0, per_cu = 0;
        if (hipGetDevice(&dev) != hipSuccess || hipDeviceGetAttribute(&cus, hipDeviceAttributeMultiprocessorCount, dev) != hipSuccess) { fprintf(stderr, "kernel_launch: device query failed\n"); grid = -1; return; }
        if (hipFuncSetAttribute((const void*)mk_fwd, hipFuncAttributeMaxDynamicSharedMemorySize, LDS_BYTES) != hipSuccess) { fprintf(stderr, "kernel_launch: hipFuncSetAttribute failed\n"); grid = -1; return; }
        if (hipOccupancyMaxActiveBlocksPerMultiprocessor(&per_cu, (const void*)mk_fwd, NWAVES * 64, LDS_BYTES) != hipSuccess || per_cu < 1) { fprintf(stderr, "kernel_launch: occupancy query reports %d workgroups per CU\n", per_cu); (void)hipGetLastError(); grid = -1; return; }
        grid = cus;
    }
    if (grid < 0) return;
    if (hipMemsetAsync((char*)d_ws + WS_CTL, 0, CTL_ZERO_BYTES, stream) != hipSuccess) { fprintf(stderr, "kernel_launch: hipMemsetAsync failed\n"); return; }
    Args a{};
    for (int i = 0; i < 25; ++i) a.in[i] = d_in[i];
    a.out = (float*)d_out; a.ws = (unsigned char*)d_ws;
#if MK_PER_PHASE
    for (int p = 0; p < NPH; ++p) { a.ph_lo = p; a.ph_hi = p + 1; a.li = p;
        hipLaunchKernelGGL(mk_fwd, dim3(grid), dim3(NWAVES * 64), LDS_BYTES, stream, a); }
#else
    a.ph_lo = 0; a.ph_hi = NPH; a.li = 0;
    void* kargs[] = {&a};
    hipError_t e = hipLaunchCooperativeKernel((const void*)mk_fwd, dim3(grid), dim3(NWAVES * 64), kargs, LDS_BYTES, stream);
    if (e != hipSuccess) fprintf(stderr, "kernel_launch: cooperative launch failed: %s (grid %d)\n", hipGetErrorString(e), grid);
#endif
    const hipError_t le = hipPeekAtLastError();
    if (le != hipSuccess) fprintf(stderr, "kernel_launch: launch failed: %s\n", hipGetErrorName(le));
}
```

```cpp
#include <hip/hip_runtime.h>
#ifndef PROBE_EPI2
#define PROBE_EPI2 0
#endif
#include <hip/hip_bf16.h>
#include <cstdio>
#include <cstdint>
#include <cmath>
namespace pg8 {
#define PG8_LAS __attribute__((address_space(3)))
typedef unsigned short bf16_t;
typedef short bf16x8 __attribute__((ext_vector_type(8)));
typedef float f32x4 __attribute__((ext_vector_type(4)));
typedef unsigned u32x4 __attribute__((ext_vector_type(4)));
constexpr int BM = 256, BK = 64, HALF = 128, HTB = HALF * BK * 2  , STAGE_BYTES = 8 * HTB, NXCD = 8, WGM = 4;

__host__ __device__ __forceinline__ int lds_byte(int r, int c) { const int st = (r >> 4) * 2 + (c >> 5), rr = r & 15, cc = c & 31, ob = rr * 64 + cc * 2; return st * 1024 + (ob ^ (((ob >> 9) & 1) << 5)); }
__host__ __device__ __forceinline__ void stage_rc(int b, int& R, int& C) { const int st = b / 1024, sb = b % 1024, swz = sb ^ (((sb >> 9) & 1) << 5); R = (st >> 1) * 16 + swz / 64; C = (st & 1) * 32 + (swz % 64) / 2; }
__host__ __device__ __forceinline__ int perm32(int rho) { const int n = rho >> 4, i = rho & 15; return 8 * (i >> 2) + 4 * n + (i & 3); }

struct Unit { int pm, pn; };
struct Gemm { const bf16_t* A; const bf16_t* Bt; int M, N, K; };

struct StaticOrder {
    int nM, nN, nwg, G, c;
    __host__ __device__ void init(int M, int N, int G_, int c_) { nM = M / BM; nN = N / BM; nwg = nM * nN; G = G_; c = c_; }
    __host__ __device__ bool next(int i, Unit& u) const {
        const long L = (long)i * G + c; if (L >= nwg) return false;
        int wgid = (int)L; { const int q = nwg / NXCD, r = nwg % NXCD, xcd = wgid % NXCD, off = wgid / NXCD; wgid = (xcd < r ? xcd * (q + 1) : r * (q + 1) + (xcd - r) * q) + off; }
        const int nig = WGM * nN, gid = wgid / nig, fm = gid * WGM, gsz = (nM - fm) < WGM ? (nM - fm) : WGM;
        u.pm = fm + ((wgid % nig) % gsz); u.pn = (wgid % nig) / gsz; return true;
    }
    __device__ __forceinline__ void a_ready(const Unit&) const {}
    __device__ __forceinline__ void done(const Unit&) const {}
    __device__ __forceinline__ void krange(const Unit&, int nt_all, int& k0, int& nt) const { k0 = 0; nt = nt_all; }
};
struct UpOrder : StaticOrder {
    __device__ __forceinline__ void krange(const Unit& u, int, int& k0, int& nt) const { if (u.pn < 3) { k0 = 0; nt = 4; } else { k0 = 4; nt = 2; } }
};

__device__ __forceinline__ unsigned cvt_pk_bf16(float lo, float hi) { unsigned r; asm volatile("v_cvt_pk_bf16_f32 %0, %1, %2" : "=v"(r) : "v"(lo), "v"(hi)); return r; }
__device__ __forceinline__ float bf_lo(unsigned w) { return __uint_as_float(w << 16); }
__device__ __forceinline__ float bf_hi(unsigned w) { return __uint_as_float(w & 0xffff0000u); }
__device__ __forceinline__ float sigmoid_f(float x) { return __builtin_amdgcn_rcpf(1.0f + __builtin_amdgcn_exp2f(-1.4426950408889634f * x)); }

struct EpiBf16 {
    static constexpr bool PERM = true, AFTER_DRAIN = false, IDEMP = true; static constexpr int MID_T = 0; static constexpr bool ADJ = true;
    bf16_t* O; int ldc;
    static __device__ __forceinline__ unsigned ror8(unsigned v) { return (unsigned)__builtin_amdgcn_update_dpp(0, (int)v, 0x128  , 0xf, 0xf, true); }
    __device__ __forceinline__ void operator()(const f32x4 (&acc)[2][2][4][2], const Unit& u, int wr, int wc, int fr, int fq) const {
        const bool lo = fr < 8;
        const int rbase = u.pm * BM + wr * 64 + (fr & 7); const int col = u.pn * BM + wc * 64 + 8 * fq + (lo ? 0 : 32);
#pragma unroll
        for (int ai = 0; ai < 2; ++ai)
#pragma unroll
            for (int m = 0; m < 4; ++m) { bf16_t* rowp = O + (size_t)(rbase + ai * HALF + m * 16) * ldc + col;
                u32x4 w0, w1;
                { const f32x4 v0 = acc[ai][0][m][0], v1 = acc[ai][0][m][1]; w0.x = cvt_pk_bf16(v0[0], v0[1]); w0.y = cvt_pk_bf16(v0[2], v0[3]); w0.z = cvt_pk_bf16(v1[0], v1[1]); w0.w = cvt_pk_bf16(v1[2], v1[3]); }
                { const f32x4 v0 = acc[ai][1][m][0], v1 = acc[ai][1][m][1]; w1.x = cvt_pk_bf16(v0[0], v0[1]); w1.y = cvt_pk_bf16(v0[2], v0[3]); w1.z = cvt_pk_bf16(v1[0], v1[1]); w1.w = cvt_pk_bf16(v1[2], v1[3]); }
                u32x4 dA, dB;
#pragma unroll
                for (int q = 0; q < 4; ++q) { const unsigned t1 = ror8(w1[q]), t0 = ror8(w0[q]); dA[q] = lo ? w0[q] : t1; dB[q] = lo ? t0 : w1[q]; }
                *(u32x4*)rowp = dA; *(u32x4*)(rowp + (size_t)8 * ldc) = dB; }
    }
};
struct EpiSwiGLU {
    static constexpr bool PERM = true, AFTER_DRAIN = false, IDEMP = true; static constexpr int MID_T = 0; static constexpr bool ADJ = false;
    bf16_t* O; int ldc;
    __device__ __forceinline__ void operator()(const f32x4 (&acc)[2][2][4][2], const Unit& u, int wr, int wc, int fr, int fq) const {
        typedef float f32x2 __attribute__((ext_vector_type(2)));
        const int row0 = u.pm * BM + wr * 64 + fr; const int col0 = u.pn * HALF + wc * 32 + 8 * fq;
#pragma unroll
        for (int ai = 0; ai < 2; ++ai)
#pragma unroll
            for (int m = 0; m < 4; ++m) { bf16_t* rowp = O + ((size_t)((u.pm * BM + wr * 64 + ai * HALF + m * 16) >> 4) * (ldc >> 5) + (u.pn * 4 + wc)) * 512 + fq * 128 + fr * 8;
                f32x2 h[4];
#pragma unroll
                for (int q = 0; q < 4; ++q) { const int n = q >> 1, j = (q & 1) * 2;
                    const f32x2 g = {acc[ai][0][m][n][j], acc[ai][0][m][n][j + 1]}, up = {acc[ai][1][m][n][j], acc[ai][1][m][n][j + 1]};
                    f32x2 e; e.x = __builtin_amdgcn_exp2f(g.x); e.y = __builtin_amdgcn_exp2f(g.y);
                    const f32x2 d = e + 1.0f; f32x2 r; r.x = __builtin_amdgcn_rcpf(d.x); r.y = __builtin_amdgcn_rcpf(d.y);
                    h[q] = (g * up) * r; }
                u32x4 w; w.x = cvt_pk_bf16(h[0].x, h[0].y); w.y = cvt_pk_bf16(h[1].x, h[1].y); w.z = cvt_pk_bf16(h[2].x, h[2].y); w.w = cvt_pk_bf16(h[3].x, h[3].y);
                *(u32x4*)rowp = w; }
    }
};
template <bool ACCUM> struct EpiGate {
    static constexpr bool PERM = true, AFTER_DRAIN = false, IDEMP = !ACCUM; static constexpr int MID_T = 0; static constexpr bool ADJ = false;
    bf16_t* O; int ldc; const bf16_t* G; int ldg; int goff;
    __device__ __forceinline__ void operator()(const f32x4 (&acc)[2][2][4][2], const Unit& u, int wr, int wc, int fr, int fq) const {
        const int row0 = u.pm * BM + wr * 64 + fr; const int col0 = u.pn * BM + wc * 32 + 8 * fq;
#pragma unroll
        for (int ai = 0; ai < 2; ++ai)
#pragma unroll
            for (int m = 0; m < 4; ++m) { const size_t row = (size_t)(row0 + ai * HALF + m * 16);
#pragma unroll
                for (int bj = 0; bj < 2; ++bj) { const int col = col0 + bj * HALF;
                    const u32x4 gv = *(const u32x4*)(G + row * ldg + goff + col);
                    u32x4 prev = {0u, 0u, 0u, 0u}; if (ACCUM) prev = *(const u32x4*)(O + row * ldc + col);
                    float h[8];
#pragma unroll
                    for (int q = 0; q < 4; ++q) { const int n = q >> 1, j = (q & 1) * 2;
                        h[2 * q]     = sigmoid_f(bf_lo(gv[q])) * acc[ai][bj][m][n][j];
                        h[2 * q + 1] = sigmoid_f(bf_hi(gv[q])) * acc[ai][bj][m][n][j + 1];
                        if (ACCUM) { h[2 * q] += bf_lo(prev[q]); h[2 * q + 1] += bf_hi(prev[q]); } }
                    u32x4 w; w.x = cvt_pk_bf16(h[0], h[1]); w.y = cvt_pk_bf16(h[2], h[3]); w.z = cvt_pk_bf16(h[4], h[5]); w.w = cvt_pk_bf16(h[6], h[7]);
                    *(u32x4*)(O + row * ldc + col) = w; } }
    }
};
struct EpiGate2 {
    static constexpr bool PERM = true, AFTER_DRAIN = false, IDEMP = true; static constexpr int MID_T = 8; static constexpr bool ADJ = false;
    bf16_t* O; int ldc; const bf16_t* G; int ldg; int goff;
    static __device__ __forceinline__ float dbf(float gb) { return fminf(1.0f + __builtin_amdgcn_exp2f(-1.4426950408889634f * gb), 1e30f); }
    __device__ __forceinline__ void mid(f32x4 (&acc)[2][2][4][2], const Unit& u, int wr, int wc, int fr, int fq) const {
        const int row0 = u.pm * BM + wr * 64 + fr; const int col0 = u.pn * BM + wc * 32 + 8 * fq;
#pragma unroll
        for (int ai = 0; ai < 2; ++ai)
#pragma unroll
            for (int m = 0; m < 4; ++m) { const size_t row = (size_t)(row0 + ai * HALF + m * 16);
#pragma unroll
                for (int bj = 0; bj < 2; ++bj) { const int col = col0 + bj * HALF;
                    const u32x4 ga = *(const u32x4*)(G + row * ldg + col), gb = *(const u32x4*)(G + row * ldg + goff + col);
#pragma unroll
                    for (int q = 0; q < 4; ++q) { const int n = q >> 1, j = (q & 1) * 2;
                        acc[ai][bj][m][n][j]     *= dbf(bf_lo(gb[q])) * sigmoid_f(bf_lo(ga[q]));
                        acc[ai][bj][m][n][j + 1] *= dbf(bf_hi(gb[q])) * sigmoid_f(bf_hi(ga[q])); } } }
    }
    __device__ __forceinline__ void operator()(const f32x4 (&acc)[2][2][4][2], const Unit& u, int wr, int wc, int fr, int fq) const {
        const int row0 = u.pm * BM + wr * 64 + fr; const int col0 = u.pn * BM + wc * 32 + 8 * fq;
#pragma unroll
        for (int ai = 0; ai < 2; ++ai)
#pragma unroll
            for (int m = 0; m < 4; ++m) { const size_t row = (size_t)(row0 + ai * HALF + m * 16);
#pragma unroll
                for (int bj = 0; bj < 2; ++bj) { const int col = col0 + bj * HALF;
                    const u32x4 gb = *(const u32x4*)(G + row * ldg + goff + col);
                    float h[8];
#pragma unroll
                    for (int q = 0; q < 4; ++q) { const int n = q >> 1, j = (q & 1) * 2;
                        h[2 * q]     = __builtin_amdgcn_rcpf(dbf(bf_lo(gb[q]))) * acc[ai][bj][m][n][j];
                        h[2 * q + 1] = __builtin_amdgcn_rcpf(dbf(bf_hi(gb[q]))) * acc[ai][bj][m][n][j + 1]; }
                    u32x4 w; w.x = cvt_pk_bf16(h[0], h[1]); w.y = cvt_pk_bf16(h[2], h[3]); w.z = cvt_pk_bf16(h[4], h[5]); w.w = cvt_pk_bf16(h[6], h[7]);
                    *(u32x4*)(O + row * ldc + col) = w; } }
    }
};
struct EpiRoute3 {
    static constexpr bool PERM = true, AFTER_DRAIN = false, IDEMP = true; static constexpr int MID_T = 0; static constexpr bool ADJ = false;
    bf16_t* O0; int ld0; int t1; bf16_t* O1; int ld1; int t2; bf16_t* O2; int ld2;
    __device__ __forceinline__ void operator()(const f32x4 (&acc)[2][2][4][2], const Unit& u, int wr, int wc, int fr, int fq) const {
        bf16_t* base; int ldc, colt;
        if (u.pn < t1) { base = O0; ldc = ld0; colt = u.pn * BM; } else if (u.pn < t2) { base = O1; ldc = ld1; colt = (u.pn - t1) * BM; } else { base = O2; ldc = ld2; colt = (u.pn - t2) * BM; }
        const int row0 = u.pm * BM + wr * 64 + fr; const int col0 = colt + wc * 32 + 8 * fq;
#pragma unroll
        for (int ai = 0; ai < 2; ++ai)
#pragma unroll
            for (int m = 0; m < 4; ++m) { bf16_t* rowp = base + (size_t)(row0 + ai * HALF + m * 16) * ldc + col0;
#pragma unroll
                for (int bj = 0; bj < 2; ++bj) { const f32x4 v0 = acc[ai][bj][m][0], v1 = acc[ai][bj][m][1];
                    u32x4 w; w.x = cvt_pk_bf16(v0[0], v0[1]); w.y = cvt_pk_bf16(v0[2], v0[3]); w.z = cvt_pk_bf16(v1[0], v1[1]); w.w = cvt_pk_bf16(v1[2], v1[3]);
                    *(u32x4*)(rowp + bj * HALF) = w; } }
    }
};

struct EpiIn {
    static constexpr bool PERM = true, AFTER_DRAIN = false, IDEMP = true; static constexpr int MID_T = 0; static constexpr bool ADJ = false;
    bf16_t* CN; bf16_t* KR; bf16_t* DQ; bf16_t* GT; const float* g_cq; const float* g_ckv; const float* ropem; const float* roped; PG8_LAS float* red; float eps;
    static __device__ __forceinline__ void st8(bf16_t* p, const float (&h)[8]) { u32x4 w; w.x = cvt_pk_bf16(h[0], h[1]); w.y = cvt_pk_bf16(h[2], h[3]); w.z = cvt_pk_bf16(h[4], h[5]); w.w = cvt_pk_bf16(h[6], h[7]); *(u32x4*)p = w; }
    __device__ __forceinline__ void operator()(const f32x4 (&acc)[2][2][4][2], const Unit& u, int wr, int wc, int fr, int fq) const {
        const int row0 = u.pm * BM + wr * 64 + fr, rl0 = wr * 64 + fr, cl = wc * 32 + 8 * fq;
        if (u.pn >= 4) {
            bf16_t* base; int ldc, colt; if (u.pn < 11) { base = DQ; ldc = 2304; colt = (u.pn - 2) * BM; } else { base = GT; ldc = 2048; colt = (u.pn - 11) * BM; }
#pragma unroll
            for (int ai = 0; ai < 2; ++ai)
#pragma unroll
                for (int m = 0; m < 4; ++m) { bf16_t* rowp = base + (size_t)(row0 + ai * HALF + m * 16) * ldc + colt + cl;
#pragma unroll
                    for (int bj = 0; bj < 2; ++bj) { const f32x4 v0 = acc[ai][bj][m][0], v1 = acc[ai][bj][m][1]; const float h[8] = {v0[0], v0[1], v0[2], v0[3], v1[0], v1[1], v1[2], v1[3]}; st8(rowp + bj * HALF, h); } }
            return; }
        if (u.pn <= 1) {
            const int nbj = (u.pn == 0) ? 2 : 1;
#pragma unroll
            for (int ai = 0; ai < 2; ++ai)
#pragma unroll
                for (int m = 0; m < 4; ++m) { float sq = 0.f;
#pragma unroll
                    for (int bj = 0; bj < 2; ++bj) if (bj < nbj) {
#pragma unroll
                        for (int n = 0; n < 2; ++n) { const f32x4 v = acc[ai][bj][m][n]; sq += (v[0] * v[0] + v[1] * v[1]) + (v[2] * v[2] + v[3] * v[3]); } }
                    sq += __shfl_xor(sq, 16); sq += __shfl_xor(sq, 32);
                    if (fq == 0) red[(ai * HALF + rl0 + m * 16) * 4 + wc] = sq; }
            asm volatile("s_waitcnt lgkmcnt(0)" ::: "memory"); __builtin_amdgcn_s_barrier(); asm volatile("" ::: "memory");
            const float invn = (u.pn == 0) ? (1.0f / 256.0f) : (1.0f / 128.0f); const float* gv = (u.pn == 0) ? g_cq : g_ckv; const int cbase = (u.pn == 0) ? 0 : 256;
#pragma unroll
            for (int ai = 0; ai < 2; ++ai)
#pragma unroll
                for (int m = 0; m < 4; ++m) { const f32x4 pr = *(const PG8_LAS f32x4*)(red + (ai * HALF + rl0 + m * 16) * 4);
                    const float rstd = 1.0f / sqrtf(((pr[0] + pr[1]) + (pr[2] + pr[3])) * invn + eps); const size_t row = (size_t)(row0 + ai * HALF + m * 16);
#pragma unroll
                    for (int bj = 0; bj < 2; ++bj) if (bj < nbj) { const int col = bj * HALF + cl; const f32x4 g0 = *(const f32x4*)(gv + col), g1 = *(const f32x4*)(gv + col + 4);
                        const f32x4 v0 = acc[ai][bj][m][0], v1 = acc[ai][bj][m][1];
                        const float h[8] = {v0[0] * rstd * g0[0], v0[1] * rstd * g0[1], v0[2] * rstd * g0[2], v0[3] * rstd * g0[3], v1[0] * rstd * g1[0], v1[1] * rstd * g1[1], v1[2] * rstd * g1[2], v1[3] * rstd * g1[3]};
                        st8(CN + row * 384 + cbase + col, h); } }
            if (u.pn == 1 && wc == 0) {
                const bool hiH = fq >= 2;
#pragma unroll
                for (int ai = 0; ai < 2; ++ai)
#pragma unroll
                    for (int m = 0; m < 4; ++m) { const size_t row = (size_t)(row0 + ai * HALF + m * 16); const float* rp = ropem + row * 32 + 8 * (fq & 1);
                        const f32x4 c0 = *(const f32x4*)rp, c1 = *(const f32x4*)(rp + 4), s0 = *(const f32x4*)(rp + 16), s1 = *(const f32x4*)(rp + 20);
                        float h[8];
#pragma unroll
                        for (int i = 0; i < 8; ++i) { const float own = acc[ai][1][m][i >> 2][i & 3];
                            const auto rr = __builtin_amdgcn_permlane32_swap(__float_as_uint(own), __float_as_uint(own), false, false);
                            const float oth = __uint_as_float(hiH ? rr[0] : rr[1]); const float cs = (i < 4) ? c0[i & 3] : c1[i & 3], sn = (i < 4) ? s0[i & 3] : s1[i & 3];
                            h[i] = hiH ? (own * cs + oth * sn) : (own * cs - oth * sn); }
                        st8(KR + row * 32 + (hiH ? 16 : 0) + 8 * (fq & 1), h); } }
            return; }
        const int colt = (u.pn - 2) * BM; const bool odd = (fq & 1) != 0;
#pragma unroll
        for (int ai = 0; ai < 2; ++ai)
#pragma unroll
            for (int m = 0; m < 4; ++m) { const size_t row = (size_t)(row0 + ai * HALF + m * 16); const float* rp = roped + row * 16;
                const f32x4 c0 = *(const f32x4*)rp, c1 = *(const f32x4*)(rp + 4), s0 = *(const f32x4*)(rp + 8), s1 = *(const f32x4*)(rp + 12);
#pragma unroll
                for (int bj = 0; bj < 2; ++bj) { const int col = colt + bj * HALF + cl; float h[8];
                    if (colt + bj * HALF < 384) {
#pragma unroll
                        for (int i = 0; i < 8; ++i) { const float own = acc[ai][bj][m][i >> 2][i & 3];
                            const auto rr = __builtin_amdgcn_permlane16_swap(__float_as_uint(own), __float_as_uint(own), false, false);
                            const float oth = __uint_as_float(odd ? rr[0] : rr[1]); const float cs = (i < 4) ? c0[i & 3] : c1[i & 3], sn = (i < 4) ? s0[i & 3] : s1[i & 3];
                            h[i] = odd ? (own * cs + oth * sn) : (own * cs - oth * sn); }
                    } else {
#pragma unroll
                        for (int i = 0; i < 8; ++i) h[i] = acc[ai][bj][m][i >> 2][i & 3]; }
                    st8(DQ + row * 2304 + col, h); } }
    }
};

template <class Epi, class Sched, bool ALIGN_EPI = false, bool SP2 = false, bool OPAQUE_K = false, bool BLKA = false>
__device__ __forceinline__ void gemm_phase(PG8_LAS unsigned char* lds, const Gemm g, const Sched& S, const Epi& E) {
    const int tid = threadIdx.x, wid = __builtin_amdgcn_readfirstlane(tid >> 6), lane = tid & 63, wr = wid >> 2, wc = wid & 3, fr = lane & 15, fq = lane >> 4;
    int K_ = g.K; if constexpr (OPAQUE_K) asm volatile("" : "+s"(K_));
    const int K = K_, nt_all = K / BK;
    unsigned voffA[2], voffB[2];
#pragma unroll
    for (int i = 0; i < 2; ++i) { int R, C; stage_rc(tid * 16 + i * 8192, R, C); int RA = R, CA = C;
        if (BLKA) { const int b_ = tid * 16 + i * 8192, st_ = b_ / 1024, sb_ = b_ % 1024; RA = (st_ >> 1) * 16 + ((sb_ >> 4) & 15); CA = (st_ & 1) * 32 + (sb_ >> 8) * 8; }
        const int b2_ = tid * 16 + i * 8192, st2_ = b2_ / 1024, sb2_ = b2_ % 1024, RS = (st2_ >> 1) * 16 + ((sb2_ >> 4) & 15), CS = (st2_ & 1) * 32 + (sb2_ >> 8) * 8;
        voffA[i] = BLKA ? (unsigned)(((RA >> 4) * (K >> 5) + (CA >> 5)) * 1024 + ((CA >> 3) & 3) * 256 + (RA & 15) * 16) : (unsigned)(R * K + C) * 2u; voffB[i] = (unsigned)(((RS >> 4) * (K >> 5) + (CS >> 5)) * 1024 + ((CS >> 3) & 3) * 256 + (RS & 15) * 16); }
    const size_t kstep = (size_t)(BK * 2);
    const size_t kstepA = BLKA ? (size_t)2048 : kstep;
    const size_t hstep = (size_t)HALF * K * 2;
    const size_t tstep = 2 * hstep;
    const size_t kstepB = 2048;
    const size_t bh1 = hstep;
    const unsigned ldsw = (unsigned)wid * 1024u;
    const int aoff = BLKA ? ((wr * 4) * 2048 + fq * 256 + fr * 16) : lds_byte(wr * 64 + fr, fq * 8), boff = (wc * 2) * 2048 + fq * 256 + fr * 16;
#define PG8_SA(b, h) (((b) * 2 + (h)) * HTB)
#define PG8_SB(b, h) ((4 + (b) * 2 + (h)) * HTB)
#define PG8_STAGE(bufoff, gbase, voff) do { _Pragma("unroll") for (int _i = 0; _i < 2; ++_i) \
        __builtin_amdgcn_global_load_lds((const unsigned*)((const char*)(gbase) + (voff)[_i]), (PG8_LAS unsigned*)(lds + (bufoff) + ldsw + _i * 8192), 16, 0, 0); } while (0)
#define PG8_LDA(dst, b, h) do { _Pragma("unroll") for (int m = 0; m < 4; ++m) _Pragma("unroll") for (int k = 0; k < 2; ++k) dst[m][k] = *(const PG8_LAS bf16x8*)(lds + PG8_SA(b, h) + aoff + m * 2048 + k * 1024); } while (0)
#define PG8_LDB(dst, b, h) do { _Pragma("unroll") for (int n = 0; n < 2; ++n) _Pragma("unroll") for (int k = 0; k < 2; ++k) dst[n][k] = *(const PG8_LAS bf16x8*)(lds + PG8_SB(b, h) + boff + n * 2048 + k * 1024); } while (0)
#define PG8_MMA(ai, bj, At, Bt) do { __builtin_amdgcn_s_setprio(1); _Pragma("unroll") for (int m = 0; m < 4; ++m) _Pragma("unroll") for (int n = 0; n < 2; ++n) _Pragma("unroll") for (int k = 0; k < 2; ++k) \
        acc[ai][bj][m][n] = __builtin_amdgcn_mfma_f32_16x16x32_bf16(Bt[n][k], At[m][k], acc[ai][bj][m][n], 0, 0, 0); __builtin_amdgcn_s_setprio(0); } while (0)
#define PG8_WAIT_V(n) asm volatile("s_waitcnt vmcnt(" #n ")" ::: "memory")
#define PG8_WAIT_L(n) asm volatile("s_waitcnt lgkmcnt(" #n ")" ::: "memory")
#define PG8_BAR __builtin_amdgcn_s_barrier()
#define PG8_SCHED __builtin_amdgcn_sched_barrier(0)
    Unit cur, nxt; int ui = 0;
    if (!S.next(0, cur)) return;
    f32x4 acc[2][2][4][2];
#pragma unroll
    for (int a = 0; a < 2; ++a)
#pragma unroll
        for (int b = 0; b < 2; ++b)
#pragma unroll
            for (int m = 0; m < 4; ++m)
#pragma unroll
                for (int n = 0; n < 2; ++n) acc[a][b][m][n] = (f32x4){0.f, 0.f, 0.f, 0.f};
    bf16x8 At[4][2], B0[2][2], B1[2][2];
    int k0c, nt; S.krange(cur, nt_all, k0c, nt);
    const char* cA = (const char*)g.A + (size_t)cur.pm * tstep + (size_t)k0c * kstepA; const char* cB = (const char*)g.Bt + (size_t)cur.pn * tstep + (size_t)k0c * kstepB;
    S.a_ready(cur);
    if constexpr (SP2) {
        PG8_STAGE(PG8_SB(0, 0), cB, voffB); PG8_STAGE(PG8_SB(0, 1), cB + bh1, voffB); PG8_STAGE(PG8_SA(0, 0), cA, voffA); PG8_STAGE(PG8_SA(0, 1), cA + hstep, voffA);
        if (wr == 1) PG8_BAR;
        PG8_WAIT_V(2); PG8_BAR;
        PG8_STAGE(PG8_SB(1, 0), cB + kstepB, voffB); PG8_STAGE(PG8_SA(1, 0), cA + kstepA, voffA); PG8_STAGE(PG8_SB(1, 1), cB + bh1 + kstepB, voffB);
        PG8_WAIT_V(6); PG8_BAR;
    } else {
        PG8_STAGE(PG8_SB(0, 0), cB, voffB); PG8_STAGE(PG8_SA(0, 0), cA, voffA); PG8_STAGE(PG8_SB(0, 1), cB + bh1, voffB); PG8_STAGE(PG8_SA(0, 1), cA + hstep, voffA);
        if (wr == 1) PG8_BAR;
        PG8_WAIT_V(4); PG8_BAR;
        PG8_STAGE(PG8_SB(1, 0), cB + kstepB, voffB); PG8_STAGE(PG8_SA(1, 0), cA + kstepA, voffA); PG8_STAGE(PG8_SB(1, 1), cB + bh1 + kstepB, voffB);
        PG8_WAIT_V(6); PG8_BAR;
    }
    for (;;) {
        const bool has_next = S.next(ui + 1, nxt);
        int k0n = 0, ntn = nt; if (has_next) S.krange(nxt, nt_all, k0n, ntn);
        const char* nA = has_next ? (const char*)g.A + (size_t)nxt.pm * tstep + (size_t)k0n * kstepA : cA; const char* nB = has_next ? (const char*)g.Bt + (size_t)nxt.pn * tstep + (size_t)k0n * kstepB : cB;
        for (int t = 0; t < nt; t += 2) {
            if constexpr (Epi::MID_T > 0) { if (t == Epi::MID_T) E.mid(acc, cur, wr, wc, fr, fq); }
            const bool last = (t == nt - 2);
            const char* a1 = cA + (size_t)(t + 1) * kstepA;
            const char* a2 = last ? nA : cA + (size_t)(t + 2) * kstepA; const char* b2 = last ? nB : cB + (size_t)(t + 2) * kstepB;
            const char* a3 = a2 + kstepA; const char* b3 = b2 + kstepB;
            if (last && has_next) S.a_ready(nxt);
            if constexpr (SP2) {
            PG8_LDB(B0, 0, 0); PG8_LDB(B1, 0, 1); PG8_SCHED; PG8_LDA(At, 0, 0); PG8_STAGE(PG8_SA(1, 1), a1 + hstep, voffA);
            PG8_WAIT_V(8); PG8_WAIT_L(0); PG8_BAR; PG8_MMA(0, 0, At, B0); PG8_MMA(0, 1, At, B1); PG8_BAR; PG8_SCHED;
            PG8_LDA(At, 0, 1); PG8_STAGE(PG8_SB(0, 0), b2, voffB); PG8_STAGE(PG8_SB(0, 1), b2 + bh1, voffB); PG8_STAGE(PG8_SA(0, 0), a2, voffA);
            PG8_WAIT_V(8); PG8_WAIT_L(0); PG8_BAR; PG8_MMA(1, 0, At, B0); PG8_MMA(1, 1, At, B1); PG8_BAR; PG8_SCHED;
            PG8_LDB(B0, 1, 0); PG8_LDB(B1, 1, 1); PG8_SCHED; PG8_LDA(At, 1, 0); PG8_STAGE(PG8_SA(0, 1), a2 + hstep, voffA);
            PG8_WAIT_V(8); PG8_WAIT_L(0); PG8_BAR; PG8_MMA(0, 0, At, B0); PG8_MMA(0, 1, At, B1); PG8_BAR; PG8_SCHED;
            PG8_LDA(At, 1, 1); PG8_STAGE(PG8_SB(1, 0), b3, voffB); PG8_STAGE(PG8_SB(1, 1), b3 + bh1, voffB); PG8_STAGE(PG8_SA(1, 0), a3, voffA);
            PG8_WAIT_V(8); PG8_WAIT_L(0); PG8_BAR; PG8_MMA(1, 0, At, B0); PG8_MMA(1, 1, At, B1); PG8_BAR; PG8_SCHED;
            } else {
            PG8_LDB(B0, 0, 0); PG8_SCHED; PG8_LDA(At, 0, 0); PG8_STAGE(PG8_SA(1, 1), a1 + hstep, voffA);
            PG8_WAIT_L(8); PG8_BAR; PG8_WAIT_L(0); PG8_MMA(0, 0, At, B0); PG8_BAR; PG8_SCHED;
            PG8_LDB(B1, 0, 1); PG8_STAGE(PG8_SB(0, 0), b2, voffB);
            PG8_BAR; PG8_WAIT_L(0); PG8_MMA(0, 1, At, B1); PG8_BAR;
            PG8_LDA(At, 0, 1); PG8_STAGE(PG8_SA(0, 0), a2, voffA);
            PG8_BAR; PG8_WAIT_L(0); PG8_MMA(1, 0, At, B0); PG8_BAR; PG8_SCHED;
            PG8_STAGE(PG8_SB(0, 1), b2 + bh1, voffB);
            PG8_WAIT_V(6); PG8_BAR; PG8_MMA(1, 1, At, B1); PG8_BAR;
            PG8_LDB(B0, 1, 0); PG8_SCHED; PG8_LDA(At, 1, 0); PG8_STAGE(PG8_SA(0, 1), a2 + hstep, voffA);
            PG8_WAIT_L(8); PG8_BAR; PG8_WAIT_L(0); PG8_MMA(0, 0, At, B0); PG8_BAR; PG8_SCHED;
            PG8_LDB(B1, 1, 1); PG8_STAGE(PG8_SB(1, 0), b3, voffB);
            PG8_BAR; PG8_WAIT_L(0); PG8_MMA(0, 1, At, B1); PG8_BAR;
            PG8_LDA(At, 1, 1); PG8_STAGE(PG8_SA(1, 0), a3, voffA);
            PG8_BAR; PG8_WAIT_L(0); PG8_MMA(1, 0, At, B0); PG8_BAR; PG8_SCHED;
            PG8_STAGE(PG8_SB(1, 1), b3 + bh1, voffB);
            PG8_WAIT_V(6); PG8_BAR; PG8_MMA(1, 1, At, B1); PG8_BAR;
            }
        }
        if constexpr (ALIGN_EPI) { if (wr == 0) PG8_BAR; }
        if constexpr (!Epi::AFTER_DRAIN) { E(acc, cur, wr, wc, fr, fq);
#if defined(PROBE_EPI2) && PROBE_EPI2
            if constexpr (Epi::IDEMP) { asm volatile("" ::: "memory"); E(acc, cur, wr, wc, fr, fq); }
#endif
            S.done(cur); }
        if (!has_next) break;
#pragma unroll
        for (int a = 0; a < 2; ++a)
#pragma unroll
            for (int b = 0; b < 2; ++b)
#pragma unroll
                for (int m = 0; m < 4; ++m)
#pragma unroll
                    for (int n = 0; n < 2; ++n) acc[a][b][m][n] = (f32x4){0.f, 0.f, 0.f, 0.f};
        cur = nxt; cA = nA; cB = nB; nt = ntn; ++ui;
        if constexpr (ALIGN_EPI) { if (wr == 1) PG8_BAR; }
    }
    PG8_WAIT_V(0);
    if constexpr (!ALIGN_EPI) { if (wr == 0) PG8_BAR; }
    PG8_BAR;
    if constexpr (Epi::AFTER_DRAIN) { E.fused(acc, cur, wr, wc, fr, fq, lds, wid, lane); S.done(cur); }
#undef PG8_SA
#undef PG8_SB
#undef PG8_STAGE
#undef PG8_LDA
#undef PG8_LDB
#undef PG8_MMA
#undef PG8_WAIT_V
#undef PG8_WAIT_L
#undef PG8_BAR
#undef PG8_SCHED
}
}

#ifndef PG8_SP2
#define PG8_SP2 true
#endif
#ifndef PG8_ALIGN
#define PG8_ALIGN true
#endif
namespace mla {
#define MLA_LAS __attribute__((address_space(3)))
using bf16x8 = __attribute__((ext_vector_type(8))) short;
using s16x4  = __attribute__((ext_vector_type(4))) short;
using f32x16 = __attribute__((ext_vector_type(16))) float;
using u32x4  = __attribute__((ext_vector_type(4))) unsigned;
using u32x2  = __attribute__((ext_vector_type(2))) unsigned;
using f32x4v = __attribute__((ext_vector_type(4))) float;
typedef unsigned short bf16_t;
constexpr int NW = 8, QBLK = 32, KVBLK = 64, DQK = 96, DV = 64, SEQ = 4096, NHEAD = 8;
constexpr int LDQ = 1792, LDO = 768, LDKR = 32, KOFF = 768, HSTRIDE = 128;
constexpr float SCALE = 0.10206207261596575f;
constexpr float THR = 8.f;
constexpr int SHM_V = KVBLK * DV * 2, SHM_K = KVBLK * 256, SHM_ATTN = 2 * SHM_V + 2 * SHM_K + NW * 64 * 4;
#define MLA_KSWZ(row, colB) ((row) * 256 + ((colB) ^ (((row) & 15) << 4)))
#define MLA_SBAR() __builtin_amdgcn_sched_barrier(0)
__device__ __forceinline__ int crow(int r, int hi) { return (r & 3) + 8 * (r >> 2) + 4 * hi; }
__device__ __forceinline__ unsigned cvtpk(float lo, float hi) { unsigned r; asm volatile("v_cvt_pk_bf16_f32 %0, %1, %2" : "=v"(r) : "v"(lo), "v"(hi)); return r; }
__device__ __forceinline__ unsigned pair_pack(float e, float f, bool odd) {
  const float send = odd ? e : f;
  const float recv = __uint_as_float((unsigned)__builtin_amdgcn_update_dpp(0, (int)__float_as_uint(send), 0xB1  , 0xf, 0xf, true));
  return odd ? cvtpk(recv, f) : cvtpk(e, recv);
}

constexpr float THR2 = THR * 1.4426950408889634f, THR0 = 16.0f;
template <bool FIRST>
__device__ __forceinline__ void partialSM(f32x16& p0, f32x16& p1, float& m_reg, bool& zref, float& alpha, float& l_reg) {
  if (!FIRST && !zref) {
#pragma unroll
    for (int r = 0; r < 16; ++r) { p0[r] -= m_reg; p1[r] -= m_reg; } }
  float pmax = p0[0];
#pragma unroll
  for (int r = 1; r < 16; ++r) pmax = fmaxf(pmax, p0[r]);
#pragma unroll
  for (int r = 0; r < 16; ++r) pmax = fmaxf(pmax, p1[r]);
  { auto rr = __builtin_amdgcn_permlane32_swap(__float_as_uint(pmax), __float_as_uint(pmax), false, false);
    pmax = fmaxf(__uint_as_float(rr[0]), __uint_as_float(rr[1])); }
  alpha = 1.f;
  if (FIRST ? !__builtin_expect(__all(fabsf(pmax) <= THR0), 1) : !__builtin_expect(__all(pmax <= THR2), 1)) {
    const float dl = FIRST ? pmax : fmaxf(pmax, 0.f);
    m_reg += dl; alpha = FIRST ? 1.f : __builtin_amdgcn_exp2f(-dl);
    l_reg *= alpha;
#pragma unroll
    for (int r = 0; r < 16; ++r) { p0[r] -= dl; p1[r] -= dl; }
    zref = zref && __all(m_reg == 0.f);
  }
#pragma unroll
  for (int r = 0; r < 16; ++r) p0[r] = __builtin_amdgcn_exp2f(p0[r]);
}
__device__ __forceinline__ void finishSM(f32x16& p0, f32x16& p1, float& l_reg, bf16x8& pa0, bf16x8& pa1, bf16x8& pa2, bf16x8& pa3) {
#pragma unroll
  for (int r = 0; r < 16; ++r) p1[r] = __builtin_amdgcn_exp2f(p1[r]);
  typedef float f32x2s __attribute__((ext_vector_type(2)));
  f32x2s sa = {0.f, 0.f}, sb = {0.f, 0.f};
#pragma unroll
  for (int r = 0; r < 16; r += 4) { sa += (f32x2s){p0[r], p0[r + 1]}; sb += (f32x2s){p0[r + 2], p0[r + 3]}; }
#pragma unroll
  for (int r = 0; r < 16; r += 4) { sa += (f32x2s){p1[r], p1[r + 1]}; sb += (f32x2s){p1[r + 2], p1[r + 3]}; }
  sa += sb; l_reg += sa.x + sa.y;
#define MLA_PK4(P, BASE, OUT) do { unsigned a0 = cvtpk(P[BASE + 0], P[BASE + 1]), a1 = cvtpk(P[BASE + 2], P[BASE + 3]);   \
    unsigned b0 = cvtpk(P[BASE + 4], P[BASE + 5]), b1 = cvtpk(P[BASE + 6], P[BASE + 7]);                              \
    u32x4 w = {a0, a1, b0, b1}; OUT = __builtin_bit_cast(bf16x8, w); } while (0)
  MLA_PK4(p0, 0, pa0); MLA_PK4(p0, 8, pa1); MLA_PK4(p1, 0, pa2); MLA_PK4(p1, 8, pa3);
#undef MLA_PK4
}
__device__ __forceinline__ void qkt(f32x16& p0, f32x16& p1, const MLA_LAS char* Ks, const bf16x8* qr, int r32, int hi) {
#pragma unroll
  for (int d0 = 0; d0 < DQK / 16; ++d0) { const int cb = (d0 * 16 + hi * 8) * 2;
    const bf16x8 b0 = *reinterpret_cast<const MLA_LAS bf16x8*>(Ks + MLA_KSWZ(r32, cb));
    const bf16x8 b1 = *reinterpret_cast<const MLA_LAS bf16x8*>(Ks + MLA_KSWZ(32 + r32, cb));
    if (d0 == 0) { p0 = __builtin_amdgcn_mfma_f32_32x32x16_bf16(b0, qr[0], f32x16{}, 0, 0, 0); p1 = __builtin_amdgcn_mfma_f32_32x32x16_bf16(b1, qr[0], f32x16{}, 0, 0, 0); }
    else { p0 = __builtin_amdgcn_mfma_f32_32x32x16_bf16(b0, qr[d0], p0, 0, 0, 0); p1 = __builtin_amdgcn_mfma_f32_32x32x16_bf16(b1, qr[d0], p1, 0, 0, 0); }
  }
}
struct KPre { bf16x8 f[6]; };
__device__ __forceinline__ void kpre_load(KPre& kp, const MLA_LAS char* Ks, int r32, int hi) {
#pragma unroll
  for (int d0 = 0; d0 < 6; ++d0) kp.f[d0] = *reinterpret_cast<const MLA_LAS bf16x8*>(Ks + MLA_KSWZ(32 + r32, (d0 * 16 + hi * 8) * 2));
}
__device__ __forceinline__ void qkt_pre(f32x16& p0, f32x16& p1, const MLA_LAS char* Ks, const bf16x8* qr, int r32, int hi, const KPre& kp) {
#define MLA_KF(row, d0) (*reinterpret_cast<const MLA_LAS bf16x8*>(Ks + MLA_KSWZ((row) + r32, ((d0) * 16 + hi * 8) * 2)))
#define MLA_PIN() __builtin_amdgcn_sched_barrier(0x6)
  const bf16x8 a0 = MLA_KF(0, 0), a1 = MLA_KF(0, 1), a2 = MLA_KF(0, 2), a3 = MLA_KF(0, 3);
  MLA_PIN();
  p1 = __builtin_amdgcn_mfma_f32_32x32x16_bf16(kp.f[0], qr[0], f32x16{}, 0, 0, 0);
  p1 = __builtin_amdgcn_mfma_f32_32x32x16_bf16(kp.f[1], qr[1], p1, 0, 0, 0);
  p1 = __builtin_amdgcn_mfma_f32_32x32x16_bf16(kp.f[2], qr[2], p1, 0, 0, 0);
  p1 = __builtin_amdgcn_mfma_f32_32x32x16_bf16(kp.f[3], qr[3], p1, 0, 0, 0);
  p1 = __builtin_amdgcn_mfma_f32_32x32x16_bf16(kp.f[4], qr[4], p1, 0, 0, 0);
  p1 = __builtin_amdgcn_mfma_f32_32x32x16_bf16(kp.f[5], qr[5], p1, 0, 0, 0);
  MLA_PIN();
  const bf16x8 a4 = MLA_KF(0, 4), a5 = MLA_KF(0, 5);
  MLA_PIN();
  p0 = __builtin_amdgcn_mfma_f32_32x32x16_bf16(a0, qr[0], f32x16{}, 0, 0, 0);
  p0 = __builtin_amdgcn_mfma_f32_32x32x16_bf16(a1, qr[1], p0, 0, 0, 0);
  p0 = __builtin_amdgcn_mfma_f32_32x32x16_bf16(a2, qr[2], p0, 0, 0, 0);
  p0 = __builtin_amdgcn_mfma_f32_32x32x16_bf16(a3, qr[3], p0, 0, 0, 0);
  p0 = __builtin_amdgcn_mfma_f32_32x32x16_bf16(a4, qr[4], p0, 0, 0, 0);
  p0 = __builtin_amdgcn_mfma_f32_32x32x16_bf16(a5, qr[5], p0, 0, 0, 0);
#undef MLA_KF
#undef MLA_PIN
}
__device__ __forceinline__ int v_st(int k, int c) { const int kk = k; return ((kk >> 3) * 2 + (c >> 5)) * 512 + ((kk & 7) * 32 + (c & 31)) * 2; }
__device__ __forceinline__ int v_rd_base(int lane) { return ((lane & 3) << 3) | (((lane >> 2) & 3) << 6) | (((lane >> 4) & 1) << 5) | (((lane >> 5) & 1) << 8); }
constexpr int v_rd_off(int d0, int ks, int half) { return d0 * 512 + ks * 2048 + half * 1024; }
typedef short v4i16_t __attribute__((ext_vector_type(4)));
__device__ __forceinline__ s16x4 vtr(const MLA_LAS char* p) { return __builtin_bit_cast(s16x4, __builtin_amdgcn_ds_read_tr16_b64_v4i16((MLA_LAS v4i16_t*)p)); }
template <int D0> __device__ __forceinline__ void pv_one_b(f32x16& od, const MLA_LAS char* vp, bf16x8 pa0, bf16x8 pa1, bf16x8 pa2, bf16x8 pa3) {
  const s16x4 l0 = vtr(vp + v_rd_off(D0, 0, 0)), h0 = vtr(vp + v_rd_off(D0, 0, 1)), l1 = vtr(vp + v_rd_off(D0, 1, 0)), h1 = vtr(vp + v_rd_off(D0, 1, 1));
  const s16x4 l2 = vtr(vp + v_rd_off(D0, 2, 0)), h2 = vtr(vp + v_rd_off(D0, 2, 1)), l3 = vtr(vp + v_rd_off(D0, 3, 0)), h3 = vtr(vp + v_rd_off(D0, 3, 1));
#define MLA_PKB(L, H) (bf16x8){L[0], L[1], L[2], L[3], H[0], H[1], H[2], H[3]}
  od = __builtin_amdgcn_mfma_f32_32x32x16_bf16(pa0, MLA_PKB(l0, h0), od, 0, 0, 0);
  od = __builtin_amdgcn_mfma_f32_32x32x16_bf16(pa1, MLA_PKB(l1, h1), od, 0, 0, 0);
  od = __builtin_amdgcn_mfma_f32_32x32x16_bf16(pa2, MLA_PKB(l2, h2), od, 0, 0, 0);
  od = __builtin_amdgcn_mfma_f32_32x32x16_bf16(pa3, MLA_PKB(l3, h3), od, 0, 0, 0);
#undef MLA_PKB
}
__device__ __forceinline__ void pv_d0_b(f32x16* o, const MLA_LAS char* vp, bf16x8 pa0, bf16x8 pa1, bf16x8 pa2, bf16x8 pa3) {
  pv_one_b<0>(o[0], vp, pa0, pa1, pa2, pa3); pv_one_b<1>(o[1], vp, pa0, pa1, pa2, pa3);
}
__device__ __forceinline__ unsigned short f2bf_rne(float f) { unsigned u = __builtin_bit_cast(unsigned, f); return (unsigned short)((u + 0x7fffu + ((u >> 16) & 1u)) >> 16); }

#ifndef MLA_FORCE_SAFE
#define MLA_FORCE_SAFE 0
#endif
template <bool FAST>
__device__ __forceinline__ bool attn_unit_stag(const bf16_t* __restrict__ QKVM, const bf16_t* __restrict__ KR, bf16_t* __restrict__ OB, const float* __restrict__ ROPEM, int b, int h, int q0, MLA_LAS char* lds) {
  const int tid = threadIdx.x, wid = __builtin_amdgcn_readfirstlane(tid >> 6), lane = tid & 63, r32 = lane & 31, hi = lane >> 5, grp = wid >> 2;
  MLA_LAS char* V_lds = lds; MLA_LAS char* K_lds = lds + 2 * SHM_V;
  MLA_LAS float* ws = (MLA_LAS float*)(lds + 2 * SHM_V + 2 * SHM_K) + wid * 64; MLA_LAS float* li_l = ws; MLA_LAS float* al_l = ws + 32;
  const long tok0 = (long)b * SEQ;
  float m_reg = 0.f, l_reg = 0; f32x16 o[2] = {}; bf16x8 qr[6];
  const bf16_t* Qw = QKVM + (tok0 + q0 + wid * QBLK + r32) * LDQ + h * DQK + hi * 8;
#pragma unroll
  for (int d0 = 0; d0 < 6; ++d0) qr[d0] = *reinterpret_cast<const bf16x8*>(Qw + d0 * 16);
  { const float* rp = ROPEM + (tok0 + q0 + wid * QBLK + r32) * 32 + 8 * hi;
    const f32x4v c0 = *reinterpret_cast<const f32x4v*>(rp), c1 = *reinterpret_cast<const f32x4v*>(rp + 4), s0 = *reinterpret_cast<const f32x4v*>(rp + 16), s1 = *reinterpret_cast<const f32x4v*>(rp + 20);
#pragma unroll
    for (int j = 0; j < 8; ++j) { const float cs = j < 4 ? c0[j & 3] : c1[j & 3], sn = j < 4 ? s0[j & 3] : s1[j & 3];
      const float t1 = __uint_as_float((unsigned)(unsigned short)qr[4][j] << 16), t2 = __uint_as_float((unsigned)(unsigned short)qr[5][j] << 16);
      qr[4][j] = (short)f2bf_rne(t1 * cs - t2 * sn); qr[5][j] = (short)f2bf_rne(t2 * cs + t1 * sn); } }
  const int sr = tid >> 3, sc8 = tid & 7;
  const int vst = v_st(sr, sc8 * 8), kst = MLA_KSWZ(sr, sc8 * 16), krst = MLA_KSWZ(sr, 128 + sc8 * 8);
  const bf16_t* Kg = QKVM + (tok0 + sr) * LDQ + KOFF + h * HSTRIDE + sc8 * 8;
  const bf16_t* KRg = KR + (tok0 + sr) * LDKR + sc8 * 4;
  const int vrb = v_rd_base(lane);
  constexpr int NT = SEQ / KVBLK;
  struct StageSet { bf16x8 ks, vs; u32x2 kr; };
  StageSet sE, sO;
  sE.ks = bf16x8{}; sE.vs = bf16x8{}; sE.kr = u32x2{}; sO = sE;
#define STG_LOAD(S, w) do { if ((w) < NT) { S.ks = *reinterpret_cast<const bf16x8*>(Kg + (long)(w) * KVBLK * LDQ); S.kr = *reinterpret_cast<const u32x2*>(KRg + (long)(w) * KVBLK * LDKR); } \
    if ((w) >= 1) S.vs = *reinterpret_cast<const bf16x8*>(Kg + (long)((w) - 1) * KVBLK * LDQ + 64); } while (0)
#define STG_WRITE(S, w) do { const int sl_ = (w) & 1; if ((w) < NT) { *(MLA_LAS bf16x8*)(K_lds + sl_ * SHM_K + kst) = S.ks; *(MLA_LAS u32x2*)(K_lds + sl_ * SHM_K + krst) = S.kr; } \
    if ((w) >= 1) *(MLA_LAS bf16x8*)(V_lds + sl_ * SHM_V + vst) = S.vs; } while (0)
#define STG_RESC(a) do { if (__any((a) < 1.f)) { if (hi == 0) al_l[r32] = (a); asm volatile("s_waitcnt lgkmcnt(0)" ::: "memory"); \
    _Pragma("unroll") for (int d = 0; d < 2; ++d) _Pragma("unroll") for (int r = 0; r < 16; ++r) o[d][r] *= al_l[crow(r, hi)]; } } while (0)
  f32x16 pA0 = f32x16{}, pA1 = f32x16{}, pB0 = f32x16{}, pB1 = f32x16{};
  float alpha = 1.f; bf16x8 pa0 = bf16x8{}, pa1 = bf16x8{}, pa2 = bf16x8{}, pa3 = bf16x8{};
  KPre kp;
  bool zref = true;
#define STG_XQ(u, C0, C1) do { __builtin_amdgcn_s_setprio(1); qkt(C0, C1, K_lds + ((u) & 1) * SHM_K, qr, r32, hi); __builtin_amdgcn_s_setprio(0); } while (0)
#define STG_XQF(u, C0, C1, P0, P1) do { __builtin_amdgcn_s_setprio(1); qkt_pre(C0, C1, K_lds + ((u) & 1) * SHM_K, qr, r32, hi, kp); \
    finishSM(P0, P1, l_reg, pa0, pa1, pa2, pa3); pv_d0_b(o, V_lds + ((u) & 1) * SHM_V + vrb, pa0, pa1, pa2, pa3); __builtin_amdgcn_s_setprio(0); } while (0)
#define STG_XF(u, P0, P1) do { __builtin_amdgcn_s_setprio(1); finishSM(P0, P1, l_reg, pa0, pa1, pa2, pa3); pv_d0_b(o, V_lds + ((u) & 1) * SHM_V + vrb, pa0, pa1, pa2, pa3); __builtin_amdgcn_s_setprio(0); } while (0)
#define STG_STAGE(S, w) do { STG_WRITE(S, w); if ((w) + 2 <= NT) STG_LOAD(S, (w) + 2); } while (0)
#define STG_STAGE_U(S, w) do { const int sl_ = (w) & 1; *(MLA_LAS bf16x8*)(K_lds + sl_ * SHM_K + kst) = S.ks; *(MLA_LAS u32x2*)(K_lds + sl_ * SHM_K + krst) = S.kr; *(MLA_LAS bf16x8*)(V_lds + sl_ * SHM_V + vst) = S.vs; \
    S.ks = *reinterpret_cast<const bf16x8*>(Kg + (long)((w) + 2) * KVBLK * LDQ); S.kr = *reinterpret_cast<const u32x2*>(KRg + (long)((w) + 2) * KVBLK * LDKR); S.vs = *reinterpret_cast<const bf16x8*>(Kg + (long)((w) + 1) * KVBLK * LDQ + 64); } while (0)
#define STG_SM(FIRST, P0, P1, un) do { if constexpr (FAST) { _Pragma("unroll") for (int r_ = 0; r_ < 16; ++r_) P0[r_] = __builtin_amdgcn_exp2f(P0[r_]); } \
    else { partialSM<FIRST>(P0, P1, m_reg, zref, alpha, l_reg); STG_RESC(alpha); } kpre_load(kp, K_lds + ((un) & 1) * SHM_K, r32, hi); } while (0)
  STG_LOAD(sE, 0); STG_WRITE(sE, 0); STG_LOAD(sO, 1); STG_LOAD(sE, 2); __syncthreads();
  if (grp == 0) {
    STG_XQ(0, pA0, pA1);                                     __syncthreads();
    STG_STAGE(sO, 1); STG_SM(true, pA0, pA1, 1);             __syncthreads();
    STG_XQF(1, pB0, pB1, pA0, pA1);                          __syncthreads();
    STG_STAGE(sE, 2); STG_SM(false, pB0, pB1, 2);            __syncthreads();
#define STG_IT0(i, STAGE) do { STG_XQF(i, pA0, pA1, pB0, pB1); __syncthreads(); STAGE(sO, (i) + 1); STG_SM(false, pA0, pA1, (i) + 1); __syncthreads(); \
      STG_XQF((i) + 1, pB0, pB1, pA0, pA1); __syncthreads(); STAGE(sE, (i) + 2); STG_SM(false, pB0, pB1, (i) + 2); __syncthreads(); } while (0)
#pragma unroll 1
    for (int i = 2; i < NT - 4; i += 2) STG_IT0(i, STG_STAGE_U);
    STG_IT0(NT - 4, STG_STAGE); STG_IT0(NT - 2, STG_STAGE);
#undef STG_IT0
    STG_XF(NT, pB0, pB1);                                    __syncthreads();
                                                             __syncthreads();
  } else {
    STG_STAGE(sO, 1);                                        __syncthreads();
    STG_XQ(0, pA0, pA1);                                     __syncthreads();
    STG_STAGE(sE, 2); STG_SM(true, pA0, pA1, 1);             __syncthreads();
    STG_XQF(1, pB0, pB1, pA0, pA1);                          __syncthreads();
#define STG_IT1(i, STAGE) do { STAGE(sO, (i) + 1); STG_SM(false, pB0, pB1, (i)); __syncthreads(); STG_XQF(i, pA0, pA1, pB0, pB1); __syncthreads(); \
      STAGE(sE, (i) + 2); STG_SM(false, pA0, pA1, (i) + 1); __syncthreads(); STG_XQF((i) + 1, pB0, pB1, pA0, pA1); __syncthreads(); } while (0)
#pragma unroll 1
    for (int i = 2; i < NT - 4; i += 2) STG_IT1(i, STG_STAGE_U);
    STG_IT1(NT - 4, STG_STAGE); STG_IT1(NT - 2, STG_STAGE);
#undef STG_IT1
    STG_SM(false, pB0, pB1, NT);                             __syncthreads();
    STG_XF(NT, pB0, pB1);                                    __syncthreads();
  }
  { auto rr = __builtin_amdgcn_permlane32_swap(__float_as_uint(l_reg), __float_as_uint(l_reg), false, false); l_reg = __uint_as_float(rr[0]) + __uint_as_float(rr[1]); }
  bool unit_ok = true;
  if constexpr (FAST) {
    MLA_LAS unsigned* okf = (MLA_LAS unsigned*)(lds + SHM_ATTN);
    const bool okw = !MLA_FORCE_SAFE && __all(l_reg >= 0x1p-80f && l_reg <= 0x1p80f);
    if (lane == 0) okf[wid] = okw ? 1u : 0u;
    asm volatile("s_waitcnt lgkmcnt(0)" ::: "memory"); __syncthreads();
    unsigned acc_ok = 1u;
#pragma unroll
    for (int w = 0; w < NW; ++w) acc_ok &= okf[w];
    unit_ok = __builtin_amdgcn_readfirstlane(acc_ok) != 0u;
  }
  if (hi == 0) li_l[r32] = l_reg; asm volatile("s_waitcnt lgkmcnt(0)" ::: "memory");
  float rli[16];
#pragma unroll
  for (int r = 0; r < 16; ++r) rli[r] = __builtin_amdgcn_rcpf(li_l[crow(r, hi)]);
  bf16_t* Ow = OB + (tok0 + q0 + wid * QBLK) * LDO + h * DV;
#pragma unroll
  for (int r = 0; r < 16; r += 2) { const bool odd = (r32 & 1) != 0; const int orow = crow(r, hi) + (odd ? 1 : 0);
#pragma unroll
    for (int d0 = 0; d0 < 2; ++d0) *reinterpret_cast<unsigned*>(Ow + (long)orow * LDO + d0 * 32 + (r32 & ~1)) = pair_pack(o[d0][r] * rli[r], o[d0][r + 1] * rli[r + 1], odd); }
#undef STG_LOAD
#undef STG_WRITE
#undef STG_RESC
#undef STG_XQ
#undef STG_XQF
#undef STG_XF
#undef STG_STAGE
#undef STG_STAGE_U
#undef STG_SM
  return unit_ok;
}
}


#ifndef DIL_FORCE_SAFE
#define DIL_FORCE_SAFE 0
#endif
namespace dil2 {
using mla::bf16x8; using mla::s16x4; using mla::f32x16; using mla::u32x4; using mla::crow; using mla::cvtpk; using mla::v_st; using mla::v_rd_base; using mla::v_rd_off;
typedef unsigned short bf16_t;
constexpr int LDD = 2304, SEQ = 4096, MTOK = 8 * 4096;
constexpr float C = 0.125f * 1.4426950408889634f;
constexpr int NKT = 12, TB = 4096, LDS_K = 0, LDS_V = NKT * TB, LDS_SCR = 2 * NKT * TB, LDS_BYTES = LDS_SCR + 8 * 256;
constexpr int NSTEPS = 8 * 3 * 4 * 16;
struct Step { int b, g, hs, r, i0; };
__device__ __forceinline__ Step decode(int sidx) { Step S; const int st = sidx & 15; S.hs = (sidx >> 4) & 3; const int bg = sidx >> 6; S.g = bg % 3; S.b = bg / 3;
  const int sh = 2 * S.g; S.r = st >> (4 - sh); S.i0 = 8 * (st & ((16 >> sh) - 1)); return S; }
struct KV { u32x4 k[6], v[6]; };
__device__ __forceinline__ void kv_load(KV& R, const bf16_t* __restrict__ DQ, const Step& S, int tid) {
  const int sh = 2 * S.g, dil = 1 << sh, nb32 = (SEQ >> sh) >> 5;
  const int row = (tid >> 3) & 31, chunk = tid & 7; const long rowbase = (long)S.b * SEQ;
  const int hk = 12 + S.g * 4 + S.hs;
  const int kcol = chunk < 2 ? 16 * hk + 8 * chunk : 384 + 48 * hk + 8 * (chunk - 2), vcol = 1536 + (S.g * 4 + S.hs) * 64 + chunk * 8;
#pragma unroll
  for (int j = 0; j < 6; ++j) { const int kt = 2 * j + (tid >> 8); int ti = S.i0 - 2 + kt; ti = ti < 0 ? 0 : (ti >= nb32 ? nb32 - 1 : ti);
    const bf16_t* p = DQ + (rowbase + S.r + (long)dil * (32 * ti + row)) * LDD;
    R.k[j] = *reinterpret_cast<const u32x4*>(p + kcol); R.v[j] = *reinterpret_cast<const u32x4*>(p + vcol); }
}
__device__ __forceinline__ void kv_write(const KV& R, MLA_LAS char* lds, int tid) {
  const int row = (tid >> 3) & 31, chunk = tid & 7;
  const int ko = row * 128 + ((chunk ^ ((row >> 1) & 7)) << 4), vo = v_st(row, chunk * 8);
#pragma unroll
  for (int j = 0; j < 6; ++j) { const int kt = 2 * j + (tid >> 8);
    *(MLA_LAS u32x4*)(lds + LDS_K + kt * TB + ko) = R.k[j]; *(MLA_LAS u32x4*)(lds + LDS_V + kt * TB + vo) = R.v[j]; }
}
template <bool USE_MAX>
__device__ __forceinline__ bool block(const bf16_t* __restrict__ DQ, bf16_t* __restrict__ PART, float* __restrict__ LSE, const Step& S, int w, MLA_LAS char* lds, int lane) {
  const int r32 = lane & 31, hi = lane >> 5;
  const int sh = 2 * S.g, dil = 1 << sh, nb32 = (SEQ >> sh) >> 5;
  const int i = S.i0 + w; const long rowbase = (long)S.b * SEQ;
  const long tq = rowbase + S.r + (long)dil * (32 * i + r32);
  const int hq = S.g * 4 + S.hs; const bf16_t* Qrow = DQ + tq * LDD + hi * 8;
  bf16x8 qf[4];
  qf[0] = *reinterpret_cast<const bf16x8*>(Qrow + 16 * hq);
#pragma unroll
  for (int d0 = 1; d0 < 4; ++d0) qf[d0] = *reinterpret_cast<const bf16x8*>(Qrow + 384 + 48 * hq + 16 * (d0 - 1));
  MLA_LAS float* scr = (MLA_LAS float*)(lds + LDS_SCR + w * 256);
  const int ksw = (r32 >> 1) & 7;
  f32x16 p[5]; bool vld[5]; float mx = 0.f, ls = 0.f;
  { constexpr bool use_max = USE_MAX;
#pragma unroll
    for (int kb = 0; kb < 5; ++kb) { const int ti = i - 2 + kb; vld[kb] = (ti >= 0) && (ti < nb32);
      const MLA_LAS char* kt = lds + LDS_K + (w + kb) * TB + r32 * 128;
      p[kb] = f32x16{};
#pragma unroll
      for (int d0 = 0; d0 < 4; ++d0) { const bf16x8 kf = *reinterpret_cast<const MLA_LAS bf16x8*>(kt + (((2 * d0 + hi) ^ ksw) << 4));
        p[kb] = __builtin_amdgcn_mfma_f32_32x32x16_bf16(kf, qf[d0], p[kb], 0, 0, 0); } }
#pragma unroll
    for (int kb = 0; kb < 5; ++kb)
#pragma unroll
      for (int rr = 0; rr < 16; ++rr) { bool ok = vld[kb]; if (kb == 0) ok = ok && (crow(rr, hi) >= r32); if (kb == 4) ok = ok && (crow(rr, hi) <= r32);
        p[kb][rr] = ok ? p[kb][rr] : -1e30f; }
    mx = 0.f;
    if constexpr (use_max) {
      mx = -1e30f;
#pragma unroll
      for (int kb = 0; kb < 5; ++kb)
#pragma unroll
        for (int rr = 0; rr < 16; ++rr) mx = fmaxf(mx, p[kb][rr]);
      { auto sw = __builtin_amdgcn_permlane32_swap(__float_as_uint(mx), __float_as_uint(mx), false, false); mx = fmaxf(__uint_as_float(sw[0]), __uint_as_float(sw[1])); }
#pragma unroll
      for (int kb = 0; kb < 5; ++kb)
#pragma unroll
        for (int rr = 0; rr < 16; ++rr) p[kb][rr] -= mx;
    }
    ls = 0.f;
#pragma unroll
    for (int kb = 0; kb < 5; ++kb)
#pragma unroll
      for (int rr = 0; rr < 16; ++rr) { const float e = __builtin_amdgcn_exp2f(p[kb][rr]); p[kb][rr] = e; ls += e; }
    { auto sw = __builtin_amdgcn_permlane32_swap(__float_as_uint(ls), __float_as_uint(ls), false, false); ls = __uint_as_float(sw[0]) + __uint_as_float(sw[1]); }
  }
  if (!USE_MAX) { if (DIL_FORCE_SAFE || !__all(ls >= 0x1p-80f && ls <= 0x1p80f)) return false; }
  bf16x8 pa[10];
#define DIL2_PK4(P, BASE, OUT) do { unsigned a0 = cvtpk(P[BASE + 0], P[BASE + 1]), a1 = cvtpk(P[BASE + 2], P[BASE + 3]);   \
    unsigned b0 = cvtpk(P[BASE + 4], P[BASE + 5]), b1 = cvtpk(P[BASE + 6], P[BASE + 7]);                              \
    u32x4 wv = {a0, a1, b0, b1}; OUT = __builtin_bit_cast(bf16x8, wv); } while (0)
#pragma unroll
  for (int kb = 0; kb < 5; ++kb) { DIL2_PK4(p[kb], 0, pa[2 * kb]); DIL2_PK4(p[kb], 8, pa[2 * kb + 1]); }
#undef DIL2_PK4
  f32x16 od[2] = {};
  const MLA_LAS char* vbase = lds + LDS_V + v_rd_base(lane);
#pragma unroll
  for (int kb = 0; kb < 5; ++kb) { const MLA_LAS char* vb = vbase + (w + kb) * TB;
#define DIL2_PK(L_, H_) (bf16x8){L_[0], L_[1], L_[2], L_[3], H_[0], H_[1], H_[2], H_[3]}
    const s16x4 l0 = mla::vtr(vb + v_rd_off(0, 0, 0)), h0 = mla::vtr(vb + v_rd_off(0, 0, 1)), l1 = mla::vtr(vb + v_rd_off(0, 1, 0)), h1 = mla::vtr(vb + v_rd_off(0, 1, 1));
    const s16x4 l2 = mla::vtr(vb + v_rd_off(1, 0, 0)), h2 = mla::vtr(vb + v_rd_off(1, 0, 1)), l3 = mla::vtr(vb + v_rd_off(1, 1, 0)), h3 = mla::vtr(vb + v_rd_off(1, 1, 1));
    od[0] = __builtin_amdgcn_mfma_f32_32x32x16_bf16(pa[2 * kb], DIL2_PK(l0, h0), od[0], 0, 0, 0);
    od[0] = __builtin_amdgcn_mfma_f32_32x32x16_bf16(pa[2 * kb + 1], DIL2_PK(l1, h1), od[0], 0, 0, 0);
    od[1] = __builtin_amdgcn_mfma_f32_32x32x16_bf16(pa[2 * kb], DIL2_PK(l2, h2), od[1], 0, 0, 0);
    od[1] = __builtin_amdgcn_mfma_f32_32x32x16_bf16(pa[2 * kb + 1], DIL2_PK(l3, h3), od[1], 0, 0, 0);
#undef DIL2_PK
  }
  if (hi == 0) { scr[r32] = ls; LSE[((long)S.g * MTOK + tq) * 4 + S.hs] = mx + __builtin_amdgcn_logf(ls); }
  asm volatile("s_waitcnt lgkmcnt(0)" ::: "memory");
  float rli[16];
#pragma unroll
  for (int rr = 0; rr < 16; ++rr) rli[rr] = __builtin_amdgcn_rcpf(scr[crow(rr, hi)]);
  bf16_t* Pw = PART + ((long)S.g * MTOK + rowbase + S.r + (long)dil * (32 * i)) * 256 + S.hs * 64 + r32;
#pragma unroll
  for (int rr = 0; rr < 16; rr += 2) { const bool odd = (r32 & 1) != 0; const long ro = (long)dil * (crow(rr, hi) + (odd ? 1 : 0)) * 256 - (odd ? 1 : 0);
#pragma unroll
    for (int d0 = 0; d0 < 2; ++d0) *reinterpret_cast<unsigned*>(Pw + ro + d0 * 32) = mla::pair_pack(od[d0][rr] * rli[rr], od[d0][rr + 1] * rli[rr + 1], odd); }
  return true;
}
}

#define GAS __attribute__((address_space(1)))
#define LAS __attribute__((address_space(3)))
typedef unsigned short bf16;
typedef unsigned v4u __attribute__((ext_vector_type(4)));
typedef float f32x4 __attribute__((ext_vector_type(4)));
typedef short bf16x8 __attribute__((ext_vector_type(8)));
typedef GAS unsigned gu32;
typedef GAS unsigned long long gu64;
#define RLX_AGENT __ATOMIC_RELAXED, __HIP_MEMORY_SCOPE_AGENT
#define LDS_WAIT() asm volatile("s_waitcnt lgkmcnt(0)" ::: "memory")
#define VM_WAIT() asm volatile("s_waitcnt vmcnt(0)" ::: "memory")
__device__ __forceinline__ unsigned long long rt() { return __builtin_amdgcn_s_memrealtime(); }
__device__ __forceinline__ unsigned f2bf(float f) { unsigned u = __builtin_bit_cast(unsigned, f); return (u + 0x7fffu + ((u >> 16) & 1u)) >> 16; }
__device__ __forceinline__ unsigned pk2(float lo, float hi) { return f2bf(lo) | (f2bf(hi) << 16); }

#define XB_TMO      128
#define XB_XCNT(j)  (256  + 64 * (j))
#define XB_XSUB(j)  (1280 + 64 * (j))
#define XB_XGEN(j)  (2304 + 64 * (j))
#define XB_TOP      3328
#define XB_TOPGEN   3392
#define XCD_BAR_WORDS 3456
#define XB_SPIN_CAP (1u << 18)

__device__ __forceinline__ unsigned xb_ld(unsigned* p)              { return __hip_atomic_load(p, __ATOMIC_RELAXED, __HIP_MEMORY_SCOPE_AGENT); }
__device__ __forceinline__ unsigned xb_add(unsigned* p, unsigned v) { return __hip_atomic_fetch_add(p, v, __ATOMIC_RELAXED, __HIP_MEMORY_SCOPE_AGENT); }
__device__ __forceinline__ unsigned xb_xcc_id() { return (unsigned)__builtin_amdgcn_s_getreg((3 << 11) | 20) & 0xFu; }
#define XB_SPIN(cond, bar) do { unsigned _sp = 0; while (cond) { __builtin_amdgcn_s_sleep(1); \
    if ((++_sp & 255u) == 0u) { if (xb_ld(&(bar)[XB_TMO])) break; if (_sp > XB_SPIN_CAP) { atomicAdd(&(bar)[XB_TMO], 1u); break; } } } } while (0)

struct XcdBarrier {
    unsigned* bar; unsigned x;
    volatile LAS unsigned* st;
};

__device__ __forceinline__ XcdBarrier xcd_barrier_post(unsigned* bar, volatile LAS unsigned* st) {
    XcdBarrier b; b.bar = bar; b.x = xb_xcc_id(); b.st = st;
    if (threadIdx.x == 0) (void)xb_add(&bar[XB_XCNT(b.x)], 1u);
    return b;
}
__device__ __forceinline__ void xcd_barrier_complete(unsigned* bar, unsigned x, unsigned& nloc, unsigned& nx) {
    const unsigned G = gridDim.x * gridDim.y * gridDim.z;
    unsigned sum, cnt, mine, sp = 0u;
    for (;;) {
        sum = 0u; cnt = 0u; mine = 0u;
#pragma unroll
        for (unsigned j = 0; j < 16; ++j) { const unsigned c = xb_ld(&bar[XB_XCNT(j)]); sum += c; cnt += (c > 0u) ? 1u : 0u; mine = (j == x) ? c : mine; }
        if (sum == G) break;
        __builtin_amdgcn_s_sleep(1);
        if ((++sp & 255u) == 0u) { if (xb_ld(&bar[XB_TMO])) break; if (sp > XB_SPIN_CAP) { atomicAdd(&bar[XB_TMO], 1u); break; } }
    }
    nloc = mine > 0u ? mine : 1u; nx = cnt > 0u ? cnt : 1u;
}

__device__ __forceinline__ void xcd_barrier(const XcdBarrier& b) {
    asm volatile("s_waitcnt vmcnt(0)" ::: "memory");
    __syncthreads();
    if (threadIdx.x == 0) {
        unsigned* bar = b.bar;
        __builtin_amdgcn_s_waitcnt(0);
        unsigned nloc = b.st[0], nx = b.st[1];
        if (nloc == 0u) { xcd_barrier_complete(bar, b.x, nloc, nx); b.st[0] = nloc; b.st[1] = nx; }
        const unsigned old = xb_add(&bar[XB_XSUB(b.x)], 1u);
        const unsigned gen = old / nloc;
        if (old + 1u == (gen + 1u) * nloc) {
            __builtin_amdgcn_fence(__ATOMIC_RELEASE, "agent");
            asm volatile("s_waitcnt vmcnt(0)" ::: "memory");
            const unsigned og = xb_add(&bar[XB_TOP], 1u);
            const unsigned tg = og / nx;
            if (og + 1u == (tg + 1u) * nx) xb_add(&bar[XB_TOPGEN], 1u);
            else XB_SPIN(xb_ld(&bar[XB_TOPGEN]) == tg, bar);
            __builtin_amdgcn_fence(__ATOMIC_ACQUIRE, "agent");
            xb_add(&bar[XB_XGEN(b.x)], 1u);
            asm volatile("s_waitcnt vmcnt(0)" ::: "memory");
        } else {
            XB_SPIN(xb_ld(&bar[XB_XGEN(b.x)]) == gen, bar);
            __builtin_amdgcn_fence(__ATOMIC_ACQUIRE, "agent");
            asm volatile("s_waitcnt vmcnt(0)" ::: "memory");
        }
    }
    __syncthreads();
}


constexpr int NWAVES = 8;
#ifndef MK_PER_PHASE
#define MK_PER_PHASE 0
#endif
#ifndef PROBE_REPEAT
#define PROBE_REPEAT -1
#endif
#define REP(k) for (int rep_ = 0; rep_ < ((PROBE_REPEAT) == (k) ? 2 : 1); ++rep_)
constexpr int NPH = 18;

constexpr int BATCH = 8, SEQ = 4096, D = 1024, M = BATCH * SEQ, FF = 2816;
constexpr int NADA = 9216;
constexpr int N_CKV = 512, N_DQKV = 2304, N_GATES = 2048, N_IN = N_CKV + N_DQKV + N_GATES, K_UP = 384, N_UP = 1792, K_OM = 512, K_ODL = 256, K_OMD = K_OM + K_ODL;
constexpr float EPS = 1e-6f;

constexpr size_t MiB = 1u << 20;
constexpr size_t WS_CTL = 0, CTL_ZERO_BYTES = 64 * 1024;
constexpr size_t WS_WGU1 = 1 * MiB, WS_WD1 = WS_WGU1 + (size_t)2 * FF * D * 2, WS_WGU2 = WS_WD1 + (size_t)D * FF * 2, WS_WD2 = WS_WGU2 + (size_t)2 * FF * D * 2,
                 WS_WINA = WS_WD2 + (size_t)D * FF * 2, WS_WINB = WS_WINA + (size_t)512 * 1024 * 2, WS_WINC = WS_WINB + (size_t)2304 * 1024 * 2,
                 WS_WUP = WS_WINC + (size_t)2048 * 1024 * 2, WS_WOM = WS_WUP + (size_t)1792 * 384 * 2, WS_WODL = WS_WOM + (size_t)1024 * 512 * 2, WS_WOUT = WS_WODL + (size_t)1024 * 256 * 2,
                 WS_ADA = WS_WOUT + (size_t)1024 * 1024 * 2, WS_KR = WS_ADA + (size_t)8 * 9216 * 4, WS_ROPEM = WS_KR + (size_t)32768 * 32 * 2, WS_WEND = WS_ROPEM + (size_t)32768 * 32 * 4;
static_assert(WS_WEND <= 56 * MiB && (WS_WD1 % 256) == 0 && (WS_WINA % 256) == 0 && (WS_WUP % 256) == 0 && (WS_WOM % 256) == 0 && (WS_ADA % 256) == 0 && (WS_KR % 256) == 0 && (WS_ROPEM % 256) == 0, "weight area");
constexpr size_t WS_GATES = 56 * MiB, WS_HID = 56 * MiB, WS_DQKV = 184 * MiB, WS_MG = 184 * MiB, WS_X2 = 232 * MiB  , WS_XN = 328 * MiB, WS_Y = 392 * MiB, WS_QKVM = 328 * MiB,
                 WS_PART = 328 * MiB, WS_LSE = 376 * MiB, WS_O = 440 * MiB, WS_ODIL = 472 * MiB, WS_CKV = 456 * MiB, WS_ROPED = 456 * MiB  , WS_CN = 488 * MiB, WS_END = 512 * MiB;
static_assert(WS_HID + (size_t)M * FF * 2 <= WS_XN && WS_GATES + (size_t)M * N_GATES * 2 <= WS_DQKV && WS_DQKV + (size_t)M * N_DQKV * 2 <= WS_XN && WS_XN + (size_t)M * D * 2 <= WS_Y && WS_Y + (size_t)M * D * 2 <= WS_CKV, "ws map 4");
static_assert(WS_QKVM + (size_t)M * N_UP * 2 <= WS_O && WS_O + (size_t)M * K_OMD * 2 <= WS_CN && WS_CKV + (size_t)M * N_CKV * 2 <= WS_CN && WS_CN + (size_t)M * K_UP * 2 <= WS_END && WS_MG + (size_t)M * D * 2 <= WS_XN, "ws map 5");
constexpr int CW_BAR = 4096;
static_assert((CW_BAR + XCD_BAR_WORDS) * 4 <= (int)CTL_ZERO_BYTES, "barrier words inside the memset region");

constexpr int RING_OFF = 0, RING_BYTES = 131072;
constexpr int LDSCTL_OFF = RING_BYTES, MISC_OFF = LDSCTL_OFF + 320, EPI_RED_OFF = RING_BYTES + 4096, DIL_REDO_OFF = EPI_RED_OFF + 4096;
constexpr int LDS_BYTES = 147456;
static_assert(MISC_OFF + 128 <= EPI_RED_OFF && DIL_REDO_OFF + 64 <= LDS_BYTES && mla::SHM_ATTN <= RING_BYTES && dil2::LDS_BYTES <= RING_BYTES, "LDS map");
static_assert(WS_PART + (size_t)3 * M * 256 * 2 <= WS_LSE && WS_LSE + (size_t)3 * M * 4 * 4 <= WS_O, "ws map 6");

typedef unsigned v2u __attribute__((ext_vector_type(2)));
struct Frame {
    LAS unsigned char* lds;
    volatile LAS unsigned* MISC;
    gu32* ctl;
    int tid, lane, wave;
    int vcu, G;
    unsigned char* ws;
    bf16* part; float* lse;
};
__device__ __forceinline__ float wave_sum(float v) {
#pragma unroll
    for (int o = 1; o < 64; o <<= 1) v += __shfl_xor(v, o);
    return v;
}
__device__ __forceinline__ float bflo(unsigned w) { return __uint_as_float(w << 16); }
__device__ __forceinline__ float bfhi(unsigned w) { return __uint_as_float(w & 0xffff0000u); }
__device__ __forceinline__ float bf1(bf16 h) { return __uint_as_float((unsigned)h << 16); }

__device__ __forceinline__ int wslot(int n, int adj) { const int r = n & 31, inv = 16 * ((r >> 2) & 1) + 4 * (r >> 3) + (r & 3);
    if (!adj) return (n & ~31) + inv;
    const int t = n & 255; return (n & ~255) + ((t >> 5) & 1) * 128 + (t >> 6) * 32 + inv; }
__device__ __forceinline__ size_t wblk(int R, int k, int K) { return ((size_t)(R >> 4) * (K >> 5) + (k >> 5)) * 512 + ((k >> 3) & 3) * 128 + (R & 15) * 8; }
__device__ __forceinline__ void transpose_item(const float* W, int N, int k0, int n0, bf16* WT, int ldk, int drow0, int kd0, LAS float* scr, int lane, float wscale = 1.0f, int srow = -1, int adj = 0) {
#pragma unroll 8
    for (int i = 0; i < 32; ++i) { const int kk = 2 * i + (lane >> 5); scr[kk * 33 + (lane & 31)] = W[(size_t)(k0 + kk) * N + n0 + (lane & 31)] * wscale; }
    LDS_WAIT(); asm volatile("" ::: "memory");
    const int c = lane & 7;
#pragma unroll
    for (int j = 0; j < 4; ++j) { const int n = (lane >> 3) + 8 * j; const LAS float* s = scr + (8 * c) * 33 + n;
        v4u o; o.x = pk2(s[0 * 33], s[1 * 33]); o.y = pk2(s[2 * 33], s[3 * 33]); o.z = pk2(s[4 * 33], s[5 * 33]); o.w = pk2(s[6 * 33], s[7 * 33]);
        const int drow = (srow >= 0 && n >= 16) ? srow + n - 16 : drow0 + n;
        *(GAS v4u*)(WT + wblk(wslot(drow, adj), kd0 + 8 * c, ldk)) = o; }
    LDS_WAIT(); asm volatile("" ::: "memory");
}
__device__ __forceinline__ void zero_bytes(unsigned char* p, int nbytes, int lane) {
    const v4u z = {0u, 0u, 0u, 0u};
    for (int o = lane * 16; o < nbytes; o += 1024) *(GAS v4u*)(p + o) = z;
}
__device__ __forceinline__ int pair_row(int n0) { return 256 * (n0 >> 7) + (n0 & 127); }

struct Args { const void* in[25]; float* out; unsigned char* ws; int ph_lo, ph_hi, li, pad; };
enum { I_X = 0, I_C, I_POS, I_WADA, I_BADA, I_GPRE1, I_WG1, I_WU1, I_WD1, I_GPOST1, I_GPREM, I_WIN, I_GCQ, I_WUQ, I_GCKV, I_WUKV, I_WOMLA, I_WODIL, I_WOUT, I_GPOSTM, I_GPRE2, I_WG2, I_WU2, I_WD2, I_GPOST2 };

__device__ __forceinline__ void p0_prologue(Frame& F, const Args& A) {
    const float* c = (const float*)A.in[I_C]; const float* w_ada = (const float*)A.in[I_WADA]; const float* b_ada = (const float*)A.in[I_BADA];
    float* ada = (float*)(F.ws + WS_ADA);
    for (int g = F.vcu; g < NADA / 64; g += F.G) {
        LAS float* sc = (LAS float*)(F.lds + RING_OFF); LAS float* red = (LAS float*)(F.lds + RING_OFF + 32768);
        for (int i = F.tid; i < BATCH * D; i += NWAVES * 64) { const float v = c[i]; sc[i] = v / (1.0f + __expf(-v)); }
        __syncthreads();
        float acc[BATCH];
#pragma unroll
        for (int b = 0; b < BATCH; ++b) acc[b] = 0.f;
        const int col = 64 * g + F.lane;
#pragma unroll 1
        for (int k0 = 0; k0 < 128; k0 += 32) {
            float w[32];
#pragma unroll
            for (int j = 0; j < 32; ++j) w[j] = w_ada[(size_t)(128 * F.wave + k0 + j) * NADA + col];
#pragma unroll
            for (int j = 0; j < 32; ++j) { const int k = 128 * F.wave + k0 + j;
#pragma unroll
                for (int b = 0; b < BATCH; ++b) acc[b] += sc[b * D + k] * w[j]; } }
#pragma unroll
        for (int b = 0; b < BATCH; ++b) red[(F.wave * BATCH + b) * 64 + F.lane] = acc[b];
        __syncthreads();
        { const int b = F.tid >> 6; float s = 0.f;
#pragma unroll
          for (int w8 = 0; w8 < NWAVES; ++w8) s += red[(w8 * BATCH + b) * 64 + F.lane];
          ada[(size_t)b * NADA + col] = s + b_ada[col]; }
        __syncthreads();
    }
    LAS float* scr = (LAS float*)(F.lds + RING_OFF + F.wave * 16384);
    const int gw = F.vcu * NWAVES + F.wave, NGW = F.G * NWAVES;
    bf16* WGU1 = (bf16*)(F.ws + WS_WGU1); bf16* WD1 = (bf16*)(F.ws + WS_WD1); bf16* WGU2 = (bf16*)(F.ws + WS_WGU2); bf16* WD2 = (bf16*)(F.ws + WS_WD2);
    bf16* WINA = (bf16*)(F.ws + WS_WINA); bf16* WINB = (bf16*)(F.ws + WS_WINB); bf16* WINC = (bf16*)(F.ws + WS_WINC);
    bf16* WUP = (bf16*)(F.ws + WS_WUP); bf16* WOM = (bf16*)(F.ws + WS_WOM); bf16* WODL = (bf16*)(F.ws + WS_WODL); bf16* WOUT = (bf16*)(F.ws + WS_WOUT);
    constexpr int I_GU = (D / 64) * (FF / 32);
    constexpr int I_DN = (FF / 64) * (D / 32);
    constexpr int I_IN = (D / 64) * (4768 / 32);
    constexpr int I_UQ = (256 / 64) * (768 / 32);
    constexpr int I_UKV = (128 / 64) * (1024 / 32);
    constexpr int I_OM = (512 / 64) * (D / 32);
    constexpr int I_ODL = (256 / 64) * (D / 32);
    constexpr int I_OUT = (D / 64) * (D / 32);
    constexpr int Z_A = 0, Z_UP = 0;
    constexpr int NITEMS = 4 * I_GU + 2 * I_DN + I_IN + I_UQ + I_UKV + I_OM + I_ODL + I_OUT + Z_A + Z_UP;
    for (int it = gw; it < NITEMS; it += NGW) {
        int r = it;
        if (r < 4 * I_GU) {
            const int which = r / I_GU; r -= which * I_GU; const int nblk = FF / 32, kb = r / nblk, nb = r % nblk, n0 = 32 * nb;
            const float* W = which == 0 ? (const float*)A.in[I_WG1] : which == 1 ? (const float*)A.in[I_WU1] : which == 2 ? (const float*)A.in[I_WG2] : (const float*)A.in[I_WU2];
            transpose_item(W, FF, 64 * kb, n0, which < 2 ? WGU1 : WGU2, D, pair_row(n0) + (which & 1) * 128, 64 * kb, scr, F.lane, (which & 1) ? -0.6931471805599453f : -1.4426950408889634f); continue; }
        r -= 4 * I_GU;
        if (r < 2 * I_DN) { const int which = r / I_DN; r -= which * I_DN; const int nblk = D / 32, kb = r / nblk, nb = r % nblk;
            transpose_item(which ? (const float*)A.in[I_WD2] : (const float*)A.in[I_WD1], D, 64 * kb, 32 * nb, which ? WD2 : WD1, FF, 32 * nb, 64 * kb, scr, F.lane, 1.0f, -1, 1); continue; }
        r -= 2 * I_DN;
        if (r < I_IN) { const int nblk = 4768 / 32, kb = r / nblk, nb = r % nblk, n0 = 32 * nb;
            bf16* dst; int drow, srow = -1;
            if (n0 < 416) { dst = WINA; drow = n0; } else if (n0 < 2720) { dst = WINB; const int q = n0 - 416;
                if (q < 1536) { const int h = q >> 6; if ((q & 63) == 0) { drow = 16 * h; srow = 384 + 48 * h; } else drow = 384 + 48 * h + 16; } else drow = q; }
            else { dst = WINC; drow = n0 - 2720; }
            const float wsc = (n0 >= 416 && n0 < 416 + 768) ? dil2::C : 1.0f;
            transpose_item((const float*)A.in[I_WIN], 4768, 64 * kb, n0, dst, D, drow, 64 * kb, scr, F.lane, wsc, srow); continue; }
        r -= I_IN;
        if (r < I_UQ) { const int nblk = 768 / 32, kb = r / nblk, nb = r % nblk;
            transpose_item((const float*)A.in[I_WUQ], 768, 64 * kb, 32 * nb, WUP, K_UP, 32 * nb, 64 * kb, scr, F.lane, mla::SCALE * 1.4426950408889634f, -1, 1); continue; }
        r -= I_UQ;
        if (r < I_UKV) { const int nblk = 1024 / 32, kb = r / nblk, nb = r % nblk;
            transpose_item((const float*)A.in[I_WUKV], 1024, 64 * kb, 32 * nb, WUP, K_UP, 768 + 32 * nb, 256 + 64 * kb, scr, F.lane, 1.0f, -1, 1); continue; }
        r -= I_UKV;
        if (r < I_OM) { const int nblk = D / 32, kb = r / nblk, nb = r % nblk;
            transpose_item((const float*)A.in[I_WOMLA], D, 64 * kb, 32 * nb, WOM, K_OMD, 32 * nb, 64 * kb, scr, F.lane); continue; }
        r -= I_OM;
        if (r < I_ODL) { const int nblk = D / 32, kb = r / nblk, nb = r % nblk;
            transpose_item((const float*)A.in[I_WODIL], D, 64 * kb, 32 * nb, WOM, K_OMD, 32 * nb, K_OM + 64 * kb, scr, F.lane); continue; }
        r -= I_ODL;
        if (r < I_OUT) { const int nblk = D / 32, kb = r / nblk, nb = r % nblk;
            transpose_item((const float*)A.in[I_WOUT], D, 64 * kb, 32 * nb, WOUT, D, 32 * nb, 64 * kb, scr, F.lane, 1.0f, -1, 1); continue; }
        r -= I_OUT;
        if (r < Z_A) { zero_bytes((unsigned char*)(WINA + (size_t)(416 + r) * D), D * 2, F.lane); continue; }
        r -= Z_A;
        { unsigned char* row = (unsigned char*)(WUP + (size_t)r * K_UP); if (r < 768) zero_bytes(row + 512, 256, F.lane); else zero_bytes(row, 512, F.lane); }
    }
}

struct RowBuf { f32x4 x[4]; v2u xb[4]; v2u y[4]; int pos; };
struct RopeTab { const int* positions; float* ropem; float* roped; float inv; };
template <int MODE, bool XI_BF>
__device__ __forceinline__ void rp_load(RowBuf& B, const float* xi, const bf16* xib, const bf16* y, int m, int lane, const RopeTab& RT) {
    if (MODE == 0) B.pos = RT.positions[m];
#pragma unroll
    for (int j = 0; j < 4; ++j) {
        if (XI_BF) B.xb[j] = *(const GAS v2u*)(xib + (size_t)m * D + 256 * j + 4 * lane); else B.x[j] = *(const GAS f32x4*)(xi + (size_t)m * D + 256 * j + 4 * lane);
        if (MODE != 0) B.y[j] = *(const GAS v2u*)(y + (size_t)m * D + 256 * j + 4 * lane); }
}
template <int MODE, bool XI_BF, bool XO_BF>
__device__ __forceinline__ void rp_process(int m, int lane, f32x4 (&v)[4], const v2u (&yw)[4], float* xo, bf16* xob, bf16* XN, const float* g_post, const float* gate, float cg,
                                           const float* g_pre, const float* shift, const float* scale, int pos, const RopeTab& RT) {
    const int b = m >> 12;
    if (MODE == 0) {
        float sn, cs; sincosf((float)pos * RT.inv, &sn, &cs);
        if (lane < 16) { RT.ropem[(size_t)m * 32 + lane] = cs; RT.ropem[(size_t)m * 32 + 16 + lane] = sn; }
        else if (lane < 24) { RT.roped[(size_t)m * 16 + (lane - 16)] = cs; RT.roped[(size_t)m * 16 + 8 + (lane - 16)] = sn; }
    }
    if (MODE != 0) {
        f32x4 yv[4]; float s = 0.f;
#pragma unroll
        for (int j = 0; j < 4; ++j) { const v2u w = yw[j];
            yv[j] = (f32x4){bflo(w.x), bfhi(w.x), bflo(w.y), bfhi(w.y)}; s += (yv[j].x * yv[j].x + yv[j].y * yv[j].y) + (yv[j].z * yv[j].z + yv[j].w * yv[j].w); }
        const float rstd = 1.0f / sqrtf(wave_sum(s) * (1.0f / D) + EPS);
#pragma unroll
        for (int j = 0; j < 4; ++j) { const int col = 256 * j + 4 * lane;
            const f32x4 gp = *(const GAS f32x4*)(g_post + col), gt = *(const GAS f32x4*)(gate + (size_t)b * NADA + col);
            v[j] = v[j] + (gt * cg) * (yv[j] * rstd * gp);
            if (XO_BF) { v2u o; o.x = pk2(v[j].x, v[j].y); o.y = pk2(v[j].z, v[j].w); *(GAS v2u*)(xob + (size_t)m * D + col) = o; }
            else *(GAS f32x4*)(xo + (size_t)m * D + col) = v[j]; }
    }
    if (MODE != 2) {
        float s = 0.f;
#pragma unroll
        for (int j = 0; j < 4; ++j) s += (v[j].x * v[j].x + v[j].y * v[j].y) + (v[j].z * v[j].z + v[j].w * v[j].w);
        const float rstd = 1.0f / sqrtf(wave_sum(s) * (1.0f / D) + EPS);
#pragma unroll
        for (int j = 0; j < 4; ++j) { const int col = 256 * j + 4 * lane;
            const f32x4 gp = *(const GAS f32x4*)(g_pre + col), sh = *(const GAS f32x4*)(shift + (size_t)b * NADA + col), sc = *(const GAS f32x4*)(scale + (size_t)b * NADA + col);
            const f32x4 h = (v[j] * rstd * gp) * (sc + 1.0f) + sh;
            v2u o; o.x = pk2(h.x, h.y); o.y = pk2(h.z, h.w);
            *(GAS v2u*)(XN + (size_t)m * D + col) = o; }
    }
}
template <int MODE, bool XI_BF = false, bool XO_BF = false>
__device__ __forceinline__ void row_pass(Frame& F, const void* xi_, const bf16* y, void* xo_, bf16* XN, const float* g_post, const float* gate, float cg,
                                         const float* g_pre, const float* shift, const float* scale, const RopeTab RT = RopeTab{nullptr, nullptr, nullptr, 0.f}) {
    const float* xi = (const float*)xi_; const bf16* xib = (const bf16*)xi_; float* xo = (float*)xo_; bf16* xob = (bf16*)xo_;
    int gw = F.vcu * NWAVES + F.wave, lane = F.lane; const int NGW = F.G * NWAVES;
    asm volatile("" : "+s"(gw), "+v"(lane));
    RowBuf A, B;
    if (gw < M) rp_load<MODE, XI_BF>(A, xi, xib, y, gw, lane, RT);
    if (gw + NGW < M) rp_load<MODE, XI_BF>(B, xi, xib, y, gw + NGW, lane, RT);
    for (int m = gw; m < M; m += 2 * NGW) {
        { f32x4 v[4]; v2u yw[4];
#pragma unroll
          for (int j = 0; j < 4; ++j) { if (XI_BF) v[j] = (f32x4){bflo(A.xb[j].x), bfhi(A.xb[j].x), bflo(A.xb[j].y), bfhi(A.xb[j].y)}; else v[j] = A.x[j]; yw[j] = A.y[j]; }
          const int posA = (MODE == 0) ? A.pos : 0;
          if (m + 2 * NGW < M) rp_load<MODE, XI_BF>(A, xi, xib, y, m + 2 * NGW, lane, RT);
          rp_process<MODE, XI_BF, XO_BF>(m, lane, v, yw, xo, xob, XN, g_post, gate, cg, g_pre, shift, scale, posA, RT); }
        if (m + NGW < M) { f32x4 v[4]; v2u yw[4];
#pragma unroll
          for (int j = 0; j < 4; ++j) { if (XI_BF) v[j] = (f32x4){bflo(B.xb[j].x), bfhi(B.xb[j].x), bflo(B.xb[j].y), bfhi(B.xb[j].y)}; else v[j] = B.x[j]; yw[j] = B.y[j]; }
          const int posB = (MODE == 0) ? B.pos : 0;
          if (m + 3 * NGW < M) rp_load<MODE, XI_BF>(B, xi, xib, y, m + 3 * NGW, lane, RT);
          rp_process<MODE, XI_BF, XO_BF>(m + NGW, lane, v, yw, xo, xob, XN, g_post, gate, cg, g_pre, shift, scale, posB, RT); }
    }
}


struct PrepBuf { int pos; v2u cq; unsigned ckv; unsigned short t1, t2; v4u a, b; };
__device__ __forceinline__ void prep_load(PrepBuf& P, const int* positions, const bf16* CKV, const bf16* DQ, int m, int lane) {
    P.pos = positions[m];
    P.cq = *(const GAS v2u*)(CKV + (size_t)m * N_CKV + 4 * lane);
    P.ckv = *(const GAS unsigned*)(CKV + (size_t)m * N_CKV + 256 + 2 * lane);
    P.t1 = 0; P.t2 = 0; if (lane < 16) { P.t1 = CKV[(size_t)m * N_CKV + 384 + lane]; P.t2 = CKV[(size_t)m * N_CKV + 400 + lane]; }
    P.a = (v4u){0u, 0u, 0u, 0u}; P.b = P.a; if (lane < 24) { const GAS v4u* qp = (const GAS v4u*)(DQ + (size_t)m * N_DQKV + lane * 16); P.a = qp[0]; P.b = qp[1]; }
}
__device__ __forceinline__ void mix_prep(Frame& F, const Args& A) {
    const bf16* CKV = (const bf16*)(F.ws + WS_CKV); bf16* CN = (bf16*)(F.ws + WS_CN); bf16* KR = (bf16*)(F.ws + WS_KR); bf16* DQ = (bf16*)(F.ws + WS_DQKV); float* ROPEM = (float*)(F.ws + WS_ROPEM);
    const float* g_cq = (const float*)A.in[I_GCQ]; const float* g_ckv = (const float*)A.in[I_GCKV]; const int* positions = (const int*)A.in[I_POS];
    const int gw = F.vcu * NWAVES + F.wave, NGW = F.G * NWAVES, lane = F.lane;
    const f32x4 gq = *(const GAS f32x4*)(g_cq + 4 * lane); const float gk0 = g_ckv[2 * lane], gk1 = g_ckv[2 * lane + 1];
    const float inv = lane < 16 ? exp2f(-(float)lane * (13.287712379549449f / 16.0f)) : exp2f(-(float)(lane & 7) * (18.931568569324174f / 8.0f));
    PrepBuf N; if (gw < M) prep_load(N, positions, CKV, DQ, gw, lane);
    for (int m = gw; m < M; m += NGW) {
        const PrepBuf C = N;
        if (m + NGW < M) prep_load(N, positions, CKV, DQ, m + NGW, lane);
        const float pos = (float)C.pos;
        float sn, cs; sincosf(pos * inv, &sn, &cs);
        { const float a0 = bflo(C.cq.x), a1 = bfhi(C.cq.x), a2 = bflo(C.cq.y), a3 = bfhi(C.cq.y);
          const float rstd = 1.0f / sqrtf(wave_sum((a0 * a0 + a1 * a1) + (a2 * a2 + a3 * a3)) * (1.0f / 256.0f) + EPS);
          v2u o; o.x = pk2(a0 * rstd * gq.x, a1 * rstd * gq.y); o.y = pk2(a2 * rstd * gq.z, a3 * rstd * gq.w);
          *(GAS v2u*)(CN + (size_t)m * K_UP + 4 * lane) = o; }
        { const float a0 = bflo(C.ckv), a1 = bfhi(C.ckv);
          const float rstd = 1.0f / sqrtf(wave_sum(a0 * a0 + a1 * a1) * (1.0f / 128.0f) + EPS);
          *(GAS unsigned*)(CN + (size_t)m * K_UP + 256 + 2 * lane) = pk2(a0 * rstd * gk0, a1 * rstd * gk1); }
        if (lane < 16) {
            const float t1 = bf1(C.t1), t2 = bf1(C.t2);
            KR[(size_t)m * 32 + lane] = (bf16)f2bf(t1 * cs - t2 * sn); KR[(size_t)m * 32 + 16 + lane] = (bf16)f2bf(t2 * cs + t1 * sn);
            ROPEM[(size_t)m * 32 + lane] = cs; ROPEM[(size_t)m * 32 + 16 + lane] = sn;
        }
        {
            float cj[8], sj[8];
#pragma unroll
            for (int j = 0; j < 8; ++j) { cj[j] = __shfl(cs, 16 + j); sj[j] = __shfl(sn, 16 + j); }
            if (lane < 24) { GAS v4u* qp = (GAS v4u*)(DQ + (size_t)m * N_DQKV + lane * 16);
                v4u oa, ob;
#pragma unroll
                for (int k = 0; k < 4; ++k) { const float t1l = bflo(C.a[k]), t1h = bfhi(C.a[k]), t2l = bflo(C.b[k]), t2h = bfhi(C.b[k]);
                    oa[k] = pk2(t1l * cj[2 * k] - t2l * sj[2 * k], t1h * cj[2 * k + 1] - t2h * sj[2 * k + 1]);
                    ob[k] = pk2(t2l * cj[2 * k] + t1l * sj[2 * k], t2h * cj[2 * k + 1] + t1h * sj[2 * k + 1]); }
                qp[0] = oa; qp[1] = ob; }
        }
    }
}
__device__ __forceinline__ void dil_attn_coop(Frame& F) {
    LAS char* lds = (LAS char*)(F.lds + RING_OFF);
    const dil2::bf16_t* DQ = (const dil2::bf16_t*)(F.ws + WS_DQKV);
    const int per = (dil2::NSTEPS + F.G - 1) / F.G; const int s0 = F.vcu * per, s1 = (s0 + per < dil2::NSTEPS) ? s0 + per : dil2::NSTEPS;
    dil2::KV R;
    if (s0 < s1) { const dil2::Step S = dil2::decode(s0); dil2::kv_load(R, DQ, S, F.tid); }
    for (int si = s0; si < s1; ++si) {
        const dil2::Step S = dil2::decode(si);
        dil2::kv_write(R, lds, F.tid);
        __syncthreads();
        if (si + 1 < s1) { const dil2::Step N = dil2::decode(si + 1); dil2::kv_load(R, DQ, N, F.tid); }
        LAS unsigned* redo = (LAS unsigned*)(F.lds + DIL_REDO_OFF);
        if (!dil2::block<false>(DQ, (dil2::bf16_t*)F.part, F.lse, S, F.wave, lds, F.lane)) { if (F.lane == 0) redo[0] = 1u; }
        asm volatile("s_waitcnt lgkmcnt(0)" ::: "memory");
        __syncthreads();
        if (redo[0] != 0u) {
            const dil2::bf16_t* DQ2 = DQ; int ln = F.lane; asm volatile("" : "+s"(DQ2), "+v"(ln));
            dil2::block<true>(DQ2, (dil2::bf16_t*)F.part, F.lse, S, F.wave, lds, ln);
            __syncthreads(); if (F.tid == 0) redo[0] = 0u; asm volatile("s_waitcnt lgkmcnt(0)" ::: "memory"); __syncthreads(); }
    }
}
__device__ __forceinline__ void dil_combine(Frame& F) {
    const bf16* PART = (const bf16*)F.part; const float* LSE = F.lse; bf16* OB = (bf16*)(F.ws + WS_O) + K_OM;
    const int gw = F.vcu * NWAVES + F.wave, NGW = F.G * NWAVES, lane = F.lane, hs = lane >> 4;
    float nl[3]; v2u nw[3];
#define DC_LOAD(mm) do { _Pragma("unroll") for (int g = 0; g < 3; ++g) { nl[g] = LSE[((size_t)g * M + (mm)) * 4 + hs]; nw[g] = *(const GAS v2u*)(PART + ((size_t)g * M + (mm)) * 256 + 4 * lane); } } while (0)
    if (gw < M) DC_LOAD(gw);
    for (int m = gw; m < M; m += NGW) {
        float l[3]; v2u w[3];
#pragma unroll
        for (int g = 0; g < 3; ++g) { l[g] = nl[g]; w[g] = nw[g]; }
        if (m + NGW < M) DC_LOAD(m + NGW);
        const float mx = fmaxf(l[0], fmaxf(l[1], l[2]));
        const float e0 = exp2f(l[0] - mx), e1 = exp2f(l[1] - mx), e2 = exp2f(l[2] - mx), inv = 1.0f / (e0 + e1 + e2);
        const float a0 = e0 * inv, a1 = e1 * inv, a2 = e2 * inv;
        v2u o;
        o.x = pk2(a0 * bflo(w[0].x) + a1 * bflo(w[1].x) + a2 * bflo(w[2].x), a0 * bfhi(w[0].x) + a1 * bfhi(w[1].x) + a2 * bfhi(w[2].x));
        o.y = pk2(a0 * bflo(w[0].y) + a1 * bflo(w[1].y) + a2 * bflo(w[2].y), a0 * bfhi(w[0].y) + a1 * bfhi(w[1].y) + a2 * bfhi(w[2].y));
        *(GAS v2u*)(OB + (size_t)m * K_OMD + 4 * lane) = o;
    }
#undef DC_LOAD
}

__global__ void __launch_bounds__(NWAVES * 64, 2) mk_fwd(Args args) {
    extern __shared__ __attribute__((aligned(16))) unsigned char lds[];
    Frame F;
    F.lds = (LAS unsigned char*)lds;
    F.MISC = (volatile LAS unsigned*)(F.lds + MISC_OFF);
    F.tid = threadIdx.x; F.lane = F.tid & 63; F.wave = __builtin_amdgcn_readfirstlane(F.tid >> 6);
    F.G = gridDim.x; { const int bx = blockIdx.x; F.vcu = (F.G % 8 == 0) ? (bx % 8) * (F.G / 8) + bx / 8 : bx; }
    F.ws = args.ws; F.ctl = (gu32*)(args.ws + WS_CTL);
    F.part = (bf16*)((unsigned char*)args.out + (size_t)64 * MiB); F.lse = (float*)((unsigned char*)args.out + (size_t)64 * MiB + (size_t)3 * M * 256 * 2);
    for (int u = F.tid; u < (LDS_BYTES - LDSCTL_OFF) / 4; u += NWAVES * 64) ((LAS unsigned*)(F.lds + LDSCTL_OFF))[u] = 0u;
    __syncthreads();
    XcdBarrier bar; bar.bar = (unsigned*)(F.ctl + CW_BAR); bar.x = 0; bar.st = nullptr;
    if (!MK_PER_PHASE) bar = xcd_barrier_post((unsigned*)(F.ctl + CW_BAR), F.MISC + 8);
#define GRID_BAR() do { if (!MK_PER_PHASE) xcd_barrier(bar); } while (0)
    const int lo = args.ph_lo, hi = args.ph_hi;
#define IN(k) (lo <= (k) && (k) < hi)
#define BOTH(k) (IN(k) && IN((k) + 1))
    const float* x = (const float*)args.in[I_X]; float* out = args.out;
    const float* ada = (const float*)(F.ws + WS_ADA);
    bf16* XN = (bf16*)(F.ws + WS_XN); bf16* HID = (bf16*)(F.ws + WS_HID); bf16* Y = (bf16*)(F.ws + WS_Y);
    typedef pg8::bf16_t pb;

    if (IN(0)) REP(0) { p0_prologue(F, args); if (BOTH(0)) GRID_BAR(); }
    if (IN(1)) REP(1) {
        const float inv = F.lane < 16 ? exp2f(-(float)F.lane * (13.287712379549449f / 16.0f)) : exp2f(-(float)(F.lane & 7) * (18.931568569324174f / 8.0f));
        const RopeTab RT{(const int*)args.in[I_POS], (float*)(F.ws + WS_ROPEM), (float*)(F.ws + WS_ROPED), inv};
        row_pass<0>(F, x, nullptr, nullptr, XN, nullptr, nullptr, 0.f, (const float*)args.in[I_GPRE1], ada + 0 * D, ada + 1 * D, RT); if (BOTH(1)) GRID_BAR(); }
    if (IN(2)) REP(2) { pg8::Gemm g{(const pb*)XN, (const pb*)(F.ws + WS_WGU1), M, 2 * FF, D}; pg8::StaticOrder S; S.init(M, 2 * FF, F.G, (int)blockIdx.x);
        pg8::EpiSwiGLU E{(pb*)HID, FF}; pg8::gemm_phase<pg8::EpiSwiGLU, pg8::StaticOrder, PG8_ALIGN, PG8_SP2>(F.lds + RING_OFF, g, S, E); if (BOTH(2)) GRID_BAR(); }
    if (IN(3)) REP(3) { pg8::Gemm g{(const pb*)HID, (const pb*)(F.ws + WS_WD1), M, D, FF}; pg8::StaticOrder S; S.init(M, D, F.G, (int)blockIdx.x);
        pg8::EpiBf16 E{(pb*)Y, D}; pg8::gemm_phase<pg8::EpiBf16, pg8::StaticOrder, PG8_ALIGN, PG8_SP2, false, true>(F.lds + RING_OFF, g, S, E);     if (BOTH(3)) GRID_BAR(); }
    if (IN(4)) { row_pass<1, false, true>(F, x, Y, out  , XN, (const float*)args.in[I_GPOST1], ada + 2 * D, 0.5f, (const float*)args.in[I_GPREM], ada + 3 * D, ada + 4 * D); if (BOTH(4)) GRID_BAR(); }
    if (IN(5)) REP(5) { pg8::Gemm g{(const pb*)XN, (const pb*)(F.ws + WS_WINA), M, N_IN, D}; pg8::StaticOrder S; S.init(M, N_IN, F.G, (int)blockIdx.x);
        pg8::EpiIn E{(pb*)(F.ws + WS_CN), (pb*)(F.ws + WS_KR), (pb*)(F.ws + WS_DQKV), (pb*)(F.ws + WS_GATES), (const float*)args.in[I_GCQ], (const float*)args.in[I_GCKV],
                     (const float*)(F.ws + WS_ROPEM), (const float*)(F.ws + WS_ROPED), (LAS float*)(F.lds + EPI_RED_OFF), EPS};
        pg8::gemm_phase<pg8::EpiIn, pg8::StaticOrder, PG8_ALIGN, PG8_SP2>(F.lds + RING_OFF, g, S, E); if (IN(5) && IN(7)) GRID_BAR(); }
    if (IN(7)) REP(7) { pg8::Gemm g{(const pb*)(F.ws + WS_CN), (const pb*)(F.ws + WS_WUP), M, N_UP, K_UP}; pg8::UpOrder S; S.init(M, N_UP, F.G, (int)blockIdx.x);
        pg8::EpiBf16 E{(pb*)(F.ws + WS_QKVM), N_UP}; pg8::gemm_phase<pg8::EpiBf16, pg8::UpOrder, PG8_ALIGN, PG8_SP2, true>(F.lds + RING_OFF, g, S, E); if (BOTH(7)) GRID_BAR(); }
    if (IN(9)) REP(9) {
        const int NU = BATCH * 8 * (SEQ / 256), per = NU / F.G; const bool even = (NU % F.G) == 0;
        for (int i = 0;; ++i) { int un; if (even) { if (i >= per) break; un = F.vcu * per + i; } else { un = F.vcu + i * F.G; if (un >= NU) break; }
            const int bh = un >> 4, qb = un & 15;
            const mla::bf16_t* qkvm = (const mla::bf16_t*)(F.ws + WS_QKVM); const mla::bf16_t* krp = (const mla::bf16_t*)(F.ws + WS_KR); mla::bf16_t* op = (mla::bf16_t*)(F.ws + WS_O); const float* ropem = (const float*)(F.ws + WS_ROPEM);
            if (!mla::attn_unit_stag<true>(qkvm, krp, op, ropem, bh >> 3, bh & 7, qb * 256, (LAS char*)(F.lds + RING_OFF))) {
                __syncthreads();
                mla::attn_unit_stag<false>(qkvm, krp, op, ropem, bh >> 3, bh & 7, qb * 256, (LAS char*)(F.lds + RING_OFF)); } }
        __syncthreads(); }
    if (IN(10)) REP(10) { dil_attn_coop(F); if (BOTH(10)) GRID_BAR(); }
    if (IN(11)) REP(11) { dil_combine(F); if (BOTH(11)) GRID_BAR(); }
    if (IN(12)) REP(12) {
        { pg8::Gemm g{(const pb*)(F.ws + WS_O), (const pb*)(F.ws + WS_WOM), M, D, K_OMD}; pg8::StaticOrder S; S.init(M, D, F.G, (int)blockIdx.x);
          pg8::EpiGate2 E{(pb*)(F.ws + WS_MG), D, (const pb*)(F.ws + WS_GATES), N_GATES, D}; pg8::gemm_phase<pg8::EpiGate2, pg8::StaticOrder, PG8_ALIGN, PG8_SP2, true>(F.lds + RING_OFF, g, S, E); }
        if (BOTH(12)) GRID_BAR(); }
    if (IN(13)) REP(13) { pg8::Gemm g{(const pb*)(F.ws + WS_MG), (const pb*)(F.ws + WS_WOUT), M, D, D}; pg8::StaticOrder S; S.init(M, D, F.G, (int)blockIdx.x);
        pg8::EpiBf16 E{(pb*)Y, D}; pg8::gemm_phase<pg8::EpiBf16, pg8::StaticOrder, PG8_ALIGN, PG8_SP2>(F.lds + RING_OFF, g, S, E); if (BOTH(13)) GRID_BAR(); }
    if (IN(14)) { row_pass<1, true, true>(F, out, Y, F.ws + WS_X2  , XN, (const float*)args.in[I_GPOSTM], ada + 5 * D, 1.0f, (const float*)args.in[I_GPRE2], ada + 6 * D, ada + 7 * D); if (BOTH(14)) GRID_BAR(); }
    if (IN(15)) REP(15) { pg8::Gemm g{(const pb*)XN, (const pb*)(F.ws + WS_WGU2), M, 2 * FF, D}; pg8::StaticOrder S; S.init(M, 2 * FF, F.G, (int)blockIdx.x);
        pg8::EpiSwiGLU E{(pb*)HID, FF}; pg8::gemm_phase<pg8::EpiSwiGLU, pg8::StaticOrder, PG8_ALIGN, PG8_SP2>(F.lds + RING_OFF, g, S, E); if (BOTH(15)) GRID_BAR(); }
    if (IN(16)) REP(16) { pg8::Gemm g{(const pb*)HID, (const pb*)(F.ws + WS_WD2), M, D, FF}; pg8::StaticOrder S; S.init(M, D, F.G, (int)blockIdx.x);
        pg8::EpiBf16 E{(pb*)Y, D}; pg8::gemm_phase<pg8::EpiBf16, pg8::StaticOrder, PG8_ALIGN, PG8_SP2, false, true>(F.lds + RING_OFF, g, S, E);     if (BOTH(16)) GRID_BAR(); }
    if (IN(17)) { row_pass<2, true, false>(F, F.ws + WS_X2, Y, out, nullptr, (const float*)args.in[I_GPOST2], ada + 8 * D, 0.5f, nullptr, nullptr, nullptr); }
#undef IN
#undef BOTH
#undef GRID_BAR
}

extern "C" void kernel_launch(void* const* d_in, const int* in_sizes, int n_in, void* d_out, int out_size, void* d_ws, size_t ws_size, hipStream_t stream) {
    static int grid = 0;
    if (grid == 0) {
        if (n_in != 25 || in_sizes[0] != M * D || out_size != M * D || ws_size < WS_END) { fprintf(stderr, "kernel_launch: shape mismatch: n_in %d in0 %d out %d ws %zu (need >= %zu)\n", n_in, n_in > 0 ? in_sizes[0] : -1, out_size, ws_size, (size_t)WS_END); grid = -1; return; }
        int dev = 0, cus = 0, per_cu = 0;
        if (hipGetDevice(&dev) != hipSuccess || hipDeviceGetAttribute(&cus, hipDeviceAttributeMultiprocessorCount, dev) != hipSuccess) { fprintf(stderr, "kernel_launch: device query failed\n"); grid = -1; return; }
        if (hipFuncSetAttribute((const void*)mk_fwd, hipFuncAttributeMaxDynamicSharedMemorySize, LDS_BYTES) != hipSuccess) { fprintf(stderr, "kernel_launch: hipFuncSetAttribute failed\n"); grid = -1; return; }
        if (hipOccupancyMaxActiveBlocksPerMultiprocessor(&per_cu, (const void*)mk_fwd, NWAVES * 64, LDS_BYTES) != hipSuccess || per_cu < 1) { fprintf(stderr, "kernel_launch: occupancy query reports %d workgroups per CU\n", per_cu); (void)hipGetLastError(); grid = -1; return; }
        grid = cus;
    }
    if (grid < 0) return;
    if (hipMemsetAsync((char*)d_ws + WS_CTL, 0, CTL_ZERO_BYTES, stream) != hipSuccess) { fprintf(stderr, "kernel_launch: hipMemsetAsync failed\n"); return; }
    Args a{};
    for (int i = 0; i < 25; ++i) a.in[i] = d_in[i];
    a.out = (float*)d_out; a.ws = (unsigned char*)d_ws;
#if MK_PER_PHASE
    for (int p = 0; p < NPH; ++p) { a.ph_lo = p; a.ph_hi = p + 1; a.li = p;
        hipLaunchKernelGGL(mk_fwd, dim3(grid), dim3(NWAVES * 64), LDS_BYTES, stream, a); }
#else
    a.ph_lo = 0; a.ph_hi = NPH; a.li = 0;
    void* kargs[] = {&a};
    hipError_t e = hipLaunchCooperativeKernel((const void*)mk_fwd, dim3(grid), dim3(NWAVES * 64), kargs, LDS_BYTES, stream);
    if (e != hipSuccess) fprintf(stderr, "kernel_launch: cooperative launch failed: %s (grid %d)\n", hipGetErrorString(e), grid);
#endif
    const hipError_t le = hipPeekAtLastError();
    if (le != hipSuccess) fprintf(stderr, "kernel_launch: launch failed: %s\n", hipGetErrorName(le));
}
```
